# Optimizing an MI355X kernel written in HIP

```python
import math
import jax, jax.numpy as jnp
from jax import lax
import numpy as np

D_MODEL = 2048
BATCH = 4
SEQ = 8192
DEPTH = 1

MIX_WIDTH = D_MODEL
CONV_WIDTH = MIX_WIDTH // 2
CONV_GROUPS = 8
CONV_K = 3
ATTN_WIDTH = MIX_WIDTH - CONV_WIDTH
N_DIFF_HEADS = 8
DIFF_DK = ATTN_WIDTH // N_DIFF_HEADS // 2
DIFF_DV = 2 * DIFF_DK
FFN_DIM = 5632
Q_BLOCK = 128
EPS = 1e-6
IN_COLS = 3 * CONV_WIDTH + 3 * ATTN_WIDTH

kernel_name = "hybrid_conv_diffattn_macaron_block"


def rms_norm(x, g):
    xf = x.astype(jnp.float32)
    y = xf * lax.rsqrt(jnp.mean(xf * xf, axis=-1, keepdims=True) + EPS)
    return (y * g.astype(jnp.float32)).astype(x.dtype)


def swiglu(x, w_gate, w_up, w_down):
    return (jax.nn.silu(x @ w_gate) * (x @ w_up)) @ w_down


def causal_depthwise_conv(u, w):
    s = u.shape[1]
    u_pad = jnp.pad(u, ((0, 0), (CONV_K - 1, 0), (0, 0)))
    return sum(w[k] * u_pad[:, k:k + s] for k in range(CONV_K))


def short_conv_mixer(b_gate, c_gate, xv, conv_w):
    return b_gate * causal_depthwise_conv(c_gate * xv, conv_w)


def diff_attention(q, k, v, lam):
    bsz, s = q.shape[0], q.shape[1]
    nb = s // Q_BLOCK
    scale = 1.0 / math.sqrt(DIFF_DK)
    qb = q.reshape(bsz, nb, Q_BLOCK, N_DIFF_HEADS, 2, DIFF_DK).transpose(1, 0, 3, 4, 2, 5)
    kt = k.transpose(0, 2, 3, 1, 4)
    vt = v.transpose(0, 2, 1, 3)
    key_pos = jnp.arange(s)

    def block(args):
        q_blk, i = args
        scores = jnp.einsum('bhcqd,bhckd->bhcqk', q_blk, kt).astype(jnp.float32) * scale
        q_pos = i * Q_BLOCK + jnp.arange(Q_BLOCK)
        mask = key_pos[None, :] <= q_pos[:, None]
        scores = jnp.where(mask, scores, -jnp.inf)
        p = jax.nn.softmax(scores, axis=-1)
        a = p[:, :, 0] - lam * p[:, :, 1]
        return jnp.einsum('bhqk,bhkd->bhqd', a.astype(vt.dtype), vt)

    o = lax.map(block, (qb, jnp.arange(nb)))
    return o.transpose(1, 0, 3, 2, 4).reshape(bsz, s, N_DIFF_HEADS, DIFF_DV)


def setup_inputs(seed: int = 0) -> dict:
    key = jax.random.key(seed)
    ks = jax.random.split(key, 20)
    f32 = jnp.float32

    def w(k, shape, fan_in):
        return jax.random.normal(k, shape, f32) * fan_in ** -0.5

    def gain(k, shape):
        return 1.0 + 0.05 * jax.random.normal(k, shape, f32)

    return {
        "x": jax.random.normal(ks[0], (BATCH, SEQ, D_MODEL), f32),
        "ffn1_norm": gain(ks[1], (DEPTH, D_MODEL)),
        "ffn1_w_gate": w(ks[2], (DEPTH, D_MODEL, FFN_DIM), D_MODEL),
        "ffn1_w_up": w(ks[3], (DEPTH, D_MODEL, FFN_DIM), D_MODEL),
        "ffn1_w_down": w(ks[4], (DEPTH, FFN_DIM, D_MODEL), FFN_DIM),
        "mix_norm": gain(ks[5], (DEPTH, D_MODEL)),
        "w_in": w(ks[6], (DEPTH, D_MODEL, IN_COLS), D_MODEL),
        "conv_w": w(ks[7], (DEPTH, CONV_K, CONV_WIDTH), CONV_K),
        "lambda_q1": 0.1 * jax.random.normal(ks[8], (DEPTH, DIFF_DK), f32),
        "lambda_k1": 0.1 * jax.random.normal(ks[9], (DEPTH, DIFF_DK), f32),
        "lambda_q2": 0.1 * jax.random.normal(ks[10], (DEPTH, DIFF_DK), f32),
        "lambda_k2": 0.1 * jax.random.normal(ks[11], (DEPTH, DIFF_DK), f32),
        "subln_w": gain(ks[12], (DEPTH, DIFF_DV)),
        "w_out": w(ks[13], (DEPTH, MIX_WIDTH, D_MODEL), MIX_WIDTH),
        "ffn2_norm": gain(ks[14], (DEPTH, D_MODEL)),
        "ffn2_w_gate": w(ks[15], (DEPTH, D_MODEL, FFN_DIM), D_MODEL),
        "ffn2_w_up": w(ks[16], (DEPTH, D_MODEL, FFN_DIM), D_MODEL),
        "ffn2_w_down": w(ks[17], (DEPTH, FFN_DIM, D_MODEL), FFN_DIM),
        "final_norm": gain(ks[18], (D_MODEL,)),
    }


def reference(x, ffn1_norm, ffn1_w_gate, ffn1_w_up, ffn1_w_down, mix_norm, w_in,
              conv_w, lambda_q1, lambda_k1, lambda_q2, lambda_k2, subln_w, w_out,
              ffn2_norm, ffn2_w_gate, ffn2_w_up, ffn2_w_down, final_norm):
    bsz, s, _ = x.shape
    for l in range(DEPTH):
        x = x + 0.5 * swiglu(rms_norm(x, ffn1_norm[l]), ffn1_w_gate[l], ffn1_w_up[l], ffn1_w_down[l])

        h = rms_norm(x, mix_norm[l])
        proj = h @ w_in[l]
        b_gate, c_gate, xv, q, k, v = jnp.split(
            proj, np.cumsum([CONV_WIDTH] * 3 + [ATTN_WIDTH] * 2).tolist(), axis=-1)

        y_conv = short_conv_mixer(b_gate, c_gate, xv, conv_w[l])

        lambda_init = 0.8 - 0.6 * math.exp(-0.3 * l)
        lam = (jnp.exp(jnp.sum(lambda_q1[l].astype(jnp.float32) * lambda_k1[l].astype(jnp.float32)))
               - jnp.exp(jnp.sum(lambda_q2[l].astype(jnp.float32) * lambda_k2[l].astype(jnp.float32)))
               + lambda_init)
        q = q.reshape(bsz, s, N_DIFF_HEADS, 2, DIFF_DK)
        k = k.reshape(bsz, s, N_DIFF_HEADS, 2, DIFF_DK)
        v = v.reshape(bsz, s, N_DIFF_HEADS, DIFF_DV)
        o = diff_attention(q, k, v, lam)
        o = rms_norm(o, subln_w[l]) * (1.0 - lambda_init)
        y_attn = o.reshape(bsz, s, ATTN_WIDTH)

        x = x + jnp.concatenate([y_conv, y_attn], axis=-1) @ w_out[l]

        x = x + 0.5 * swiglu(rms_norm(x, ffn2_norm[l]), ffn2_w_gate[l], ffn2_w_up[l], ffn2_w_down[l])

    return rms_norm(x, final_norm)
```

```cpp
#include <hip/hip_runtime.h>
#include <hip/hip_cooperative_groups.h>
#include <cstdio>
#include <cstdint>

namespace pg8 {
#define PG8_LAS __attribute__((address_space(3)))
typedef unsigned short bf16_t;
typedef short bf16x8 __attribute__((ext_vector_type(8)));
typedef float f32x4 __attribute__((ext_vector_type(4)));
typedef unsigned u32x4 __attribute__((ext_vector_type(4)));
constexpr int BM = 256, BK = 64, HALF = 128, HTB = HALF * BK * 2  , STAGE_BYTES = 8 * HTB, NXCD = 8, WGM = 8;

__host__ __device__ __forceinline__ int lds_byte(int r, int c) { const int st = (r >> 4) * 2 + (c >> 5), rr = r & 15, cc = c & 31, ob = rr * 64 + cc * 2; return st * 1024 + (ob ^ (((ob >> 9) & 1) << 5)); }
__host__ __device__ __forceinline__ void stage_rc(int b, int& R, int& C) { const int st = b / 1024, sb = b % 1024, swz = sb ^ (((sb >> 9) & 1) << 5); R = (st >> 1) * 16 + swz / 64; C = (st & 1) * 32 + (swz % 64) / 2; }
__host__ __device__ __forceinline__ int perm32(int rho) { const int n = rho >> 4, i = rho & 15; return 8 * (i >> 2) + 4 * n + (i & 3); }

struct Unit { int pm, pn, par; };
struct Gemm { const bf16_t* A; const bf16_t* Bt; int M, N, K; };

struct StaticOrder {
    int nM, nN, nwg, G, c;
    __host__ __device__ void init(int M, int N, int G_, int c_) { nM = M / BM; nN = N / BM; nwg = nM * nN; G = G_; c = c_; }
    __host__ __device__ bool next(int i, Unit& u) const {
        const long L = (long)i * G + c; if (L >= nwg) return false;
        int wgid = (int)L; { const int q = nwg / NXCD, r = nwg % NXCD, xcd = wgid % NXCD, off = wgid / NXCD; wgid = (xcd < r ? xcd * (q + 1) : r * (q + 1) + (xcd - r) * q) + off; }
        const int nig = WGM * nN, gid = wgid / nig, fm = gid * WGM, gsz = (nM - fm) < WGM ? (nM - fm) : WGM;
        u.pm = fm + ((wgid % nig) % gsz); u.pn = (wgid % nig) / gsz; return true;
    }
    __device__ __forceinline__ void a_ready(const Unit&) const {}
    __device__ __forceinline__ void done(const Unit&) const {}
};

__device__ __forceinline__ unsigned cvt_pk_bf16(float lo, float hi) { unsigned r; asm volatile("v_cvt_pk_bf16_f32 %0, %1, %2" : "=v"(r) : "v"(lo), "v"(hi)); return r; }
typedef float f32x2 __attribute__((ext_vector_type(2)));
__device__ __forceinline__ f32x2 gelu_pk(f32x2 v) {
    const f32x2 av = __builtin_elementwise_abs(v), d = av * 0.2316418882f + 1.0f;
    f32x2 t; t.x = __builtin_amdgcn_rcpf(d.x); t.y = __builtin_amdgcn_rcpf(d.y);
    f32x2 q = t * 0.5307027145f + (-0.7265760135f); q = q * t + 0.7107068705f; q = q * t + (-0.142248368f); q = q * t + 0.127414796f; q = q * t;
    const f32x2 s = (v * v) * (-0.72134752044f);
    f32x2 e; e.x = __builtin_amdgcn_exp2f(s.x); e.y = __builtin_amdgcn_exp2f(s.y);
    const f32x2 m = v * (q * e), r = v - m;
    f32x2 o; o.x = v.x < 0.f ? m.x : r.x; o.y = v.y < 0.f ? m.y : r.y; return o;
}

template <int ACT  > struct EpiBf16 {
    static constexpr bool PERM = true, AFTER_DRAIN = false; static_assert(ACT == 0 || ACT == 1, "EpiBf16: ACT is 0 (none) or 1 (gelu_pk)");
    bf16_t* O; int ldc; const float* bias; int split_cols; size_t split_stride; float scale0;
    __device__ __forceinline__ void operator()(const f32x4 (&acc)[2][2][4][2], const Unit& u, int wr, int wc, int fr, int fq) const {
        const int row0 = u.pm * BM + wr * 64 + fr; int colt = u.pn * BM; bf16_t* base = O;
        float sc = 1.f; if (split_cols) { const int t = colt / split_cols; base += (size_t)t * split_stride; colt -= t * split_cols; if (t == 0) sc = scale0; }
        const int col0 = colt + wc * 32 + 8 * fq, bcol0 = u.pn * BM + wc * 32 + 8 * fq;
        f32x4 bv[2][2];
#pragma unroll
        for (int bj = 0; bj < 2; ++bj)
#pragma unroll
            for (int n = 0; n < 2; ++n) bv[bj][n] = bias ? *(const f32x4*)(bias + bcol0 + bj * HALF + 4 * n) : (f32x4){0.f, 0.f, 0.f, 0.f};
#pragma unroll
        for (int ai = 0; ai < 2; ++ai)
#pragma unroll
            for (int m = 0; m < 4; ++m) { bf16_t* rowp = base + (size_t)(row0 + ai * HALF + m * 16) * ldc + col0;
#pragma unroll
                for (int bj = 0; bj < 2; ++bj) { f32x4 v0 = acc[ai][bj][m][0] + bv[bj][0], v1 = acc[ai][bj][m][1] + bv[bj][1];
                    if (ACT == 1) { f32x2 a = gelu_pk((f32x2){v0[0], v0[1]}), b = gelu_pk((f32x2){v0[2], v0[3]}), c = gelu_pk((f32x2){v1[0], v1[1]}), d = gelu_pk((f32x2){v1[2], v1[3]});
                        v0 = (f32x4){a.x, a.y, b.x, b.y}; v1 = (f32x4){c.x, c.y, d.x, d.y}; }
                    v0 = v0 * sc; v1 = v1 * sc; u32x4 w; w.x = cvt_pk_bf16(v0[0], v0[1]); w.y = cvt_pk_bf16(v0[2], v0[3]); w.z = cvt_pk_bf16(v1[0], v1[1]); w.w = cvt_pk_bf16(v1[2], v1[3]);
                    *(u32x4*)(rowp + bj * HALF) = w; } }
    }
};
template <int W> struct StaticOrderW : StaticOrder {
    __host__ __device__ bool next(int i, Unit& u) const {
        const long L = (long)i * G + c; if (L >= nwg) return false;
        int wgid = (int)L; { const int q = nwg / NXCD, r = nwg % NXCD, xcd = wgid % NXCD, off = wgid / NXCD; wgid = (xcd < r ? xcd * (q + 1) : r * (q + 1) + (xcd - r) * q) + off; }
        const int nig = W * nN, gid = wgid / nig, fm = gid * W, gsz = (nM - fm) < W ? (nM - fm) : W;
        u.pm = fm + ((wgid % nig) % gsz); u.pn = (wgid % nig) / gsz; return true;
    }
};
struct EpiSwiGLU {
    static constexpr bool PERM = true, AFTER_DRAIN = false;
    bf16_t* O; int ldc; const float* ssq;
    __device__ __forceinline__ static float sg(float g, float up) { return g * __builtin_amdgcn_rcpf(1.0f + __builtin_amdgcn_exp2f(-1.4426950408889634f * g)) * up; }
    __device__ __forceinline__ void operator()(const f32x4 (&acc)[2][2][4][2], const Unit& u, int wr, int wc, int fr, int fq) const {
        const int row0 = u.pm * BM + wr * 64 + fr, col0 = u.pn * HALF + wc * 32 + 8 * fq;
        float rsv[2][4];
#pragma unroll
        for (int ai = 0; ai < 2; ++ai)
#pragma unroll
            for (int m = 0; m < 4; ++m) rsv[ai][m] = ssq[row0 + ai * HALF + m * 16];
        asm volatile("" ::: "memory");
#pragma unroll
        for (int ai = 0; ai < 2; ++ai)
#pragma unroll
            for (int m = 0; m < 4; ++m) {
                bf16_t* rowp = O + (size_t)(row0 + ai * HALF + m * 16) * ldc + col0;
                const float rs = __builtin_amdgcn_rsqf(rsv[ai][m] * (1.0f / 2048.0f) + 1e-6f);
                const f32x4 g0 = acc[ai][0][m][0] * rs, g1 = acc[ai][0][m][1] * rs, u0 = acc[ai][1][m][0] * rs, u1 = acc[ai][1][m][1] * rs;
                u32x4 w; w.x = cvt_pk_bf16(sg(g0[0], u0[0]), sg(g0[1], u0[1])); w.y = cvt_pk_bf16(sg(g0[2], u0[2]), sg(g0[3], u0[3]));
                w.z = cvt_pk_bf16(sg(g1[0], u1[0]), sg(g1[1], u1[1])); w.w = cvt_pk_bf16(sg(g1[2], u1[2]), sg(g1[3], u1[3]));
                *(u32x4*)rowp = w; }
    }
};
template <int MODE> struct EpiRes {
    static constexpr bool PERM = true, AFTER_DRAIN = false;
    const void* base; void* out; int ldc; float s; float* ssq; unsigned* cnt; const float* gain;
    __device__ __forceinline__ static f32x4 lo4(unsigned a, unsigned b) { return (f32x4){__uint_as_float(a << 16), __uint_as_float(a & 0xffff0000u), __uint_as_float(b << 16), __uint_as_float(b & 0xffff0000u)}; }
    __device__ __forceinline__ void operator()(const f32x4 (&acc)[2][2][4][2], const Unit& u, int wr, int wc, int fr, int fq) const {
        const int col0 = u.pn * BM + wc * 32 + 8 * fq;
        if constexpr (MODE == 0) {
            const float* bs = (const float*)base; bf16_t* o = (bf16_t*)out;
#pragma unroll
            for (int ai = 0; ai < 2; ++ai) {
                f32x4 pre[4][2][2];
#pragma unroll
                for (int m = 0; m < 4; ++m) { const size_t off = (size_t)(u.pm * BM + ai * HALF + wr * 64 + m * 16 + fr) * ldc + col0;
#pragma unroll
                    for (int bj = 0; bj < 2; ++bj) { pre[m][bj][0] = *(const f32x4*)(bs + off + bj * HALF); pre[m][bj][1] = *(const f32x4*)(bs + off + bj * HALF + 4); } }
                asm volatile("" ::: "memory");
#pragma unroll
                for (int m = 0; m < 4; ++m) { const int row = u.pm * BM + ai * HALF + wr * 64 + m * 16 + fr; const size_t off = (size_t)row * ldc + col0; float ss = 0.f;
#pragma unroll
                    for (int bj = 0; bj < 2; ++bj) { const f32x4 v0 = pre[m][bj][0] + acc[ai][bj][m][0] * s, v1 = pre[m][bj][1] + acc[ai][bj][m][1] * s;
                        ss += (v0[0] * v0[0] + v0[1] * v0[1]) + (v0[2] * v0[2] + v0[3] * v0[3]) + (v1[0] * v1[0] + v1[1] * v1[1]) + (v1[2] * v1[2] + v1[3] * v1[3]);
                        u32x4 w; w.x = cvt_pk_bf16(v0[0], v0[1]); w.y = cvt_pk_bf16(v0[2], v0[3]); w.z = cvt_pk_bf16(v1[0], v1[1]); w.w = cvt_pk_bf16(v1[2], v1[3]);
                        *(u32x4*)(o + off + bj * HALF) = w; }
                    ss += __shfl_xor(ss, 16); ss += __shfl_xor(ss, 32); if (fq == 0) atomicAdd(ssq + row, ss); }
            }
        } else if constexpr (MODE == 3) {
            auto& A = const_cast<f32x4 (&)[2][2][4][2]>(acc);
            const bf16_t* bs = (const bf16_t*)base;
            { u32x4 pre[2][4][2];
#pragma unroll
              for (int ai = 0; ai < 2; ++ai)
#pragma unroll
                for (int m = 0; m < 4; ++m) { const size_t off = (size_t)(u.pm * BM + ai * HALF + wr * 64 + m * 16 + fr) * ldc + col0;
#pragma unroll
                    for (int bj = 0; bj < 2; ++bj) pre[ai][m][bj] = *(const u32x4*)(bs + off + bj * HALF); }
              asm volatile("" ::: "memory");
#pragma unroll
              for (int ai = 0; ai < 2; ++ai)
#pragma unroll
                for (int m = 0; m < 4; ++m) { const int row = u.pm * BM + ai * HALF + wr * 64 + m * 16 + fr; float ss = 0.f;
#pragma unroll
                    for (int bj = 0; bj < 2; ++bj) { const u32x4 pb = pre[ai][m][bj];
                        const f32x4 v0 = lo4(pb.x, pb.y) + acc[ai][bj][m][0] * s, v1 = lo4(pb.z, pb.w) + acc[ai][bj][m][1] * s;
                        ss += (v0[0] * v0[0] + v0[1] * v0[1]) + (v0[2] * v0[2] + v0[3] * v0[3]) + (v1[0] * v1[0] + v1[1] * v1[1]) + (v1[2] * v1[2] + v1[3] * v1[3]);
                        A[ai][bj][m][0] = v0; A[ai][bj][m][1] = v1; }
                    ss += __shfl_xor(ss, 16); ss += __shfl_xor(ss, 32); if (fq == 0) atomicAdd(ssq + row, ss); } }
            asm volatile("s_waitcnt vmcnt(0)" ::: "memory");
            unsigned* c = cnt + 64 * u.pm;
            if ((threadIdx.x & 63) == 0) __hip_atomic_fetch_add(c, 1u, __ATOMIC_RELAXED, __HIP_MEMORY_SCOPE_AGENT);
            { unsigned spins = 0;
              while ((unsigned)__builtin_amdgcn_readfirstlane(__hip_atomic_load(c, __ATOMIC_RELAXED, __HIP_MEMORY_SCOPE_AGENT)) < 64u) { __builtin_amdgcn_s_sleep(4); if (++spins > (1u << 22)) break; } }
            float rsv[2][4];
#pragma unroll
            for (int ai = 0; ai < 2; ++ai)
#pragma unroll
                for (int m = 0; m < 4; ++m) rsv[ai][m] = __hip_atomic_load(ssq + u.pm * BM + ai * HALF + wr * 64 + m * 16 + fr, __ATOMIC_RELAXED, __HIP_MEMORY_SCOPE_AGENT);
            f32x4 gv[2][2];
#pragma unroll
            for (int bj = 0; bj < 2; ++bj)
#pragma unroll
                for (int n = 0; n < 2; ++n) gv[bj][n] = *(const f32x4*)(gain + col0 + bj * HALF + 4 * n);
#pragma unroll
            for (int ai = 0; ai < 2; ++ai)
#pragma unroll
                for (int m = 0; m < 4; ++m) { const size_t off = (size_t)(u.pm * BM + ai * HALF + wr * 64 + m * 16 + fr) * ldc + col0;
                    const float rs = __builtin_amdgcn_rsqf(rsv[ai][m] * (1.0f / 2048.0f) + 1e-6f);
#pragma unroll
                    for (int bj = 0; bj < 2; ++bj) { *(f32x4*)((float*)out + off + bj * HALF) = acc[ai][bj][m][0] * rs * gv[bj][0]; *(f32x4*)((float*)out + off + bj * HALF + 4) = acc[ai][bj][m][1] * rs * gv[bj][1]; } }
        } else {
            const bf16_t* bs = (const bf16_t*)base;
            u32x4 pre[2][4][2];
#pragma unroll
            for (int ai = 0; ai < 2; ++ai)
#pragma unroll
                for (int m = 0; m < 4; ++m) { const size_t off = (size_t)(u.pm * BM + ai * HALF + wr * 64 + m * 16 + fr) * ldc + col0;
#pragma unroll
                    for (int bj = 0; bj < 2; ++bj) pre[ai][m][bj] = *(const u32x4*)(bs + off + bj * HALF); }
            asm volatile("" ::: "memory");
#pragma unroll
            for (int ai = 0; ai < 2; ++ai)
#pragma unroll
                for (int m = 0; m < 4; ++m) { const int row = u.pm * BM + ai * HALF + wr * 64 + m * 16 + fr; const size_t off = (size_t)row * ldc + col0; float ss = 0.f;
#pragma unroll
                    for (int bj = 0; bj < 2; ++bj) { const u32x4 pb = pre[ai][m][bj];
                        const f32x4 v0 = lo4(pb.x, pb.y) + acc[ai][bj][m][0] * s, v1 = lo4(pb.z, pb.w) + acc[ai][bj][m][1] * s;
                        if constexpr (MODE == 1) {
                            ss += (v0[0] * v0[0] + v0[1] * v0[1]) + (v0[2] * v0[2] + v0[3] * v0[3]) + (v1[0] * v1[0] + v1[1] * v1[1]) + (v1[2] * v1[2] + v1[3] * v1[3]);
                            u32x4 w; w.x = cvt_pk_bf16(v0[0], v0[1]); w.y = cvt_pk_bf16(v0[2], v0[3]); w.z = cvt_pk_bf16(v1[0], v1[1]); w.w = cvt_pk_bf16(v1[2], v1[3]);
                            *(u32x4*)((bf16_t*)out + off + bj * HALF) = w;
                        } else { *(f32x4*)((float*)out + off + bj * HALF) = v0; *(f32x4*)((float*)out + off + bj * HALF + 4) = v1; } }
                    if constexpr (MODE == 1) { ss += __shfl_xor(ss, 16); ss += __shfl_xor(ss, 32); if (fq == 0) atomicAdd(ssq + row, ss); } }
        }
    }
};
struct EpiProj {
    static constexpr bool PERM = true, AFTER_DRAIN = false;
    bf16_t* O; int ldc; int q_lo, q_hi; float qscale; const float* ssq;
    __device__ __forceinline__ void operator()(const f32x4 (&acc)[2][2][4][2], const Unit& u, int wr, int wc, int fr, int fq) const {
        const int row0 = u.pm * BM + wr * 64 + fr, colt = u.pn * BM, col0 = colt + wc * 32 + 8 * fq;
        const float sc = (colt >= q_lo && colt < q_hi) ? qscale : 1.0f;
        float rsv[2][4];
#pragma unroll
        for (int ai = 0; ai < 2; ++ai)
#pragma unroll
            for (int m = 0; m < 4; ++m) rsv[ai][m] = ssq[row0 + ai * HALF + m * 16];
        asm volatile("" ::: "memory");
#pragma unroll
        for (int ai = 0; ai < 2; ++ai)
#pragma unroll
            for (int m = 0; m < 4; ++m) { bf16_t* rowp = O + (size_t)(row0 + ai * HALF + m * 16) * ldc + col0;
                const float rs = sc * __builtin_amdgcn_rsqf(rsv[ai][m] * (1.0f / 2048.0f) + 1e-6f);
#pragma unroll
                for (int bj = 0; bj < 2; ++bj) { const f32x4 v0 = acc[ai][bj][m][0] * rs, v1 = acc[ai][bj][m][1] * rs;
                    u32x4 w; w.x = cvt_pk_bf16(v0[0], v0[1]); w.y = cvt_pk_bf16(v0[2], v0[3]); w.z = cvt_pk_bf16(v1[0], v1[1]); w.w = cvt_pk_bf16(v1[2], v1[3]);
                    *(u32x4*)(rowp + bj * HALF) = w; } }
    }
};

template <class Epi, class Sched, bool ALIGN_EPI = false, bool SP2 = false>
__device__ __forceinline__ void gemm_phase(PG8_LAS unsigned char* lds, const Gemm g, const Sched& S, const Epi& E) {
    int tid_ = threadIdx.x; asm volatile("" : "+v"(tid_)); const int tid = tid_, wid = __builtin_amdgcn_readfirstlane(tid >> 6), lane = tid & 63, wr = wid >> 2, wc = wid & 3, fr = lane & 15, fq = lane >> 4;
    const int K = g.K, nt = K / BK;
    unsigned voffA[2], voffB[2];
#pragma unroll
    for (int i = 0; i < 2; ++i) { int R, C; stage_rc(tid * 16 + i * 8192, R, C); const int Rb = Epi::PERM ? ((R & ~31) + perm32(R & 31)) : R;
        voffA[i] = (unsigned)(R * K + C) * 2u; voffB[i] = (unsigned)(Rb * K + C) * 2u; }
    const size_t kstep = (size_t)(BK * 2);
    const size_t hstep = (size_t)HALF * K * 2;
    const size_t tstep = 2 * hstep;
    const unsigned ldsw = (unsigned)wid * 1024u;
    const int aoff = lds_byte(wr * 64 + fr, fq * 8), boff = lds_byte(wc * 32 + fr, fq * 8);
#define PG8_SA(b, h) (((b) * 2 + (h)) * HTB)
#define PG8_SB(b, h) ((4 + (b) * 2 + (h)) * HTB)
#define PG8_STAGE(bufoff, gbase, voff) do { _Pragma("unroll") for (int _i = 0; _i < 2; ++_i) \
        __builtin_amdgcn_global_load_lds((const unsigned*)((const char*)(gbase) + (voff)[_i]), (PG8_LAS unsigned*)(lds + (bufoff) + ldsw + _i * 8192), 16, 0, 0); } while (0)
#define PG8_LDA(dst, b, h) do { _Pragma("unroll") for (int m = 0; m < 4; ++m) _Pragma("unroll") for (int k = 0; k < 2; ++k) dst[m][k] = *(const PG8_LAS bf16x8*)(lds + PG8_SA(b, h) + aoff + m * 2048 + k * 1024); } while (0)
#define PG8_LDB(dst, b, h) do { _Pragma("unroll") for (int n = 0; n < 2; ++n) _Pragma("unroll") for (int k = 0; k < 2; ++k) dst[n][k] = *(const PG8_LAS bf16x8*)(lds + PG8_SB(b, h) + boff + n * 2048 + k * 1024); } while (0)
#define PG8_MMA(ai, bj, At, Bt) do { __builtin_amdgcn_s_setprio(1); _Pragma("unroll") for (int m = 0; m < 4; ++m) _Pragma("unroll") for (int n = 0; n < 2; ++n) _Pragma("unroll") for (int k = 0; k < 2; ++k) \
        acc[ai][bj][m][n] = __builtin_amdgcn_mfma_f32_16x16x32_bf16(Bt[n][k], At[m][k], acc[ai][bj][m][n], 0, 0, 0); __builtin_amdgcn_s_setprio(0); } while (0)
#define PG8_WAIT_V(n) asm volatile("s_waitcnt vmcnt(" #n ")" ::: "memory")
#define PG8_WAIT_L(n) asm volatile("s_waitcnt lgkmcnt(" #n ")" ::: "memory")
#define PG8_BAR __builtin_amdgcn_s_barrier()
#define PG8_SCHED __builtin_amdgcn_sched_barrier(0)
    Unit cur, nxt; int ui = 0;
    if (!S.next(0, cur)) return;
    f32x4 acc[2][2][4][2];
#pragma unroll
    for (int a = 0; a < 2; ++a)
#pragma unroll
        for (int b = 0; b < 2; ++b)
#pragma unroll
            for (int m = 0; m < 4; ++m)
#pragma unroll
                for (int n = 0; n < 2; ++n) acc[a][b][m][n] = (f32x4){0.f, 0.f, 0.f, 0.f};
    bf16x8 At[4][2], B0[2][2], B1[2][2];
    const char* cA = (const char*)g.A + (size_t)cur.pm * tstep; const char* cB = (const char*)g.Bt + (size_t)cur.pn * tstep;
    S.a_ready(cur);
    if constexpr (SP2) {
        PG8_STAGE(PG8_SB(0, 0), cB, voffB); PG8_STAGE(PG8_SB(0, 1), cB + hstep, voffB); PG8_STAGE(PG8_SA(0, 0), cA, voffA); PG8_STAGE(PG8_SA(0, 1), cA + hstep, voffA);
        if (wr == 1) PG8_BAR;
        PG8_WAIT_V(2); PG8_BAR;
        PG8_STAGE(PG8_SB(1, 0), cB + kstep, voffB); PG8_STAGE(PG8_SA(1, 0), cA + kstep, voffA); PG8_STAGE(PG8_SB(1, 1), cB + hstep + kstep, voffB);
        PG8_WAIT_V(6); PG8_BAR;
    } else {
        PG8_STAGE(PG8_SB(0, 0), cB, voffB); PG8_STAGE(PG8_SA(0, 0), cA, voffA); PG8_STAGE(PG8_SB(0, 1), cB + hstep, voffB); PG8_STAGE(PG8_SA(0, 1), cA + hstep, voffA);
        if (wr == 1) PG8_BAR;
        PG8_WAIT_V(4); PG8_BAR;
        PG8_STAGE(PG8_SB(1, 0), cB + kstep, voffB); PG8_STAGE(PG8_SA(1, 0), cA + kstep, voffA); PG8_STAGE(PG8_SB(1, 1), cB + hstep + kstep, voffB);
        PG8_WAIT_V(6); PG8_BAR;
    }
    for (;;) {
        const bool has_next = S.next(ui + 1, nxt);
        const char* nA = has_next ? (const char*)g.A + (size_t)nxt.pm * tstep : cA; const char* nB = has_next ? (const char*)g.Bt + (size_t)nxt.pn * tstep : cB;
        for (int t = 0; t < nt; t += 2) {
            const bool last = (t == nt - 2);
            const char* a1 = cA + (size_t)(t + 1) * kstep;
            const char* a2 = last ? nA : cA + (size_t)(t + 2) * kstep; const char* b2 = last ? nB : cB + (size_t)(t + 2) * kstep;
            const char* a3 = a2 + kstep; const char* b3 = b2 + kstep;
            if (last && has_next) S.a_ready(nxt);
            if constexpr (SP2) {
            PG8_LDB(B0, 0, 0); PG8_LDB(B1, 0, 1); PG8_SCHED; PG8_LDA(At, 0, 0); PG8_STAGE(PG8_SA(1, 1), a1 + hstep, voffA);
            PG8_WAIT_V(8); PG8_WAIT_L(0); PG8_BAR; PG8_MMA(0, 0, At, B0); PG8_MMA(0, 1, At, B1); PG8_BAR; PG8_SCHED;
            PG8_LDA(At, 0, 1); PG8_STAGE(PG8_SB(0, 0), b2, voffB); PG8_STAGE(PG8_SB(0, 1), b2 + hstep, voffB); PG8_STAGE(PG8_SA(0, 0), a2, voffA);
            PG8_WAIT_V(8); PG8_WAIT_L(0); PG8_BAR; PG8_MMA(1, 0, At, B0); PG8_MMA(1, 1, At, B1); PG8_BAR; PG8_SCHED;
            PG8_LDB(B0, 1, 0); PG8_LDB(B1, 1, 1); PG8_SCHED; PG8_LDA(At, 1, 0); PG8_STAGE(PG8_SA(0, 1), a2 + hstep, voffA);
            PG8_WAIT_V(8); PG8_WAIT_L(0); PG8_BAR; PG8_MMA(0, 0, At, B0); PG8_MMA(0, 1, At, B1); PG8_BAR; PG8_SCHED;
            PG8_LDA(At, 1, 1); PG8_STAGE(PG8_SB(1, 0), b3, voffB); PG8_STAGE(PG8_SB(1, 1), b3 + hstep, voffB); PG8_STAGE(PG8_SA(1, 0), a3, voffA);
            PG8_WAIT_V(8); PG8_WAIT_L(0); PG8_BAR; PG8_MMA(1, 0, At, B0); PG8_MMA(1, 1, At, B1); PG8_BAR; PG8_SCHED;
            } else {
            PG8_LDB(B0, 0, 0); PG8_SCHED; PG8_LDA(At, 0, 0); PG8_STAGE(PG8_SA(1, 1), a1 + hstep, voffA);
            PG8_WAIT_L(8); PG8_BAR; PG8_WAIT_L(0); PG8_MMA(0, 0, At, B0); PG8_BAR; PG8_SCHED;
            PG8_LDB(B1, 0, 1); PG8_STAGE(PG8_SB(0, 0), b2, voffB);
            PG8_BAR; PG8_WAIT_L(0); PG8_MMA(0, 1, At, B1); PG8_BAR;
            PG8_LDA(At, 0, 1); PG8_STAGE(PG8_SA(0, 0), a2, voffA);
            PG8_BAR; PG8_WAIT_L(0); PG8_MMA(1, 0, At, B0); PG8_BAR; PG8_SCHED;
            PG8_STAGE(PG8_SB(0, 1), b2 + hstep, voffB);
            PG8_WAIT_V(6); PG8_BAR; PG8_MMA(1, 1, At, B1); PG8_BAR;
            PG8_LDB(B0, 1, 0); PG8_SCHED; PG8_LDA(At, 1, 0); PG8_STAGE(PG8_SA(0, 1), a2 + hstep, voffA);
            PG8_WAIT_L(8); PG8_BAR; PG8_WAIT_L(0); PG8_MMA(0, 0, At, B0); PG8_BAR; PG8_SCHED;
            PG8_LDB(B1, 1, 1); PG8_STAGE(PG8_SB(1, 0), b3, voffB);
            PG8_BAR; PG8_WAIT_L(0); PG8_MMA(0, 1, At, B1); PG8_BAR;
            PG8_LDA(At, 1, 1); PG8_STAGE(PG8_SA(1, 0), a3, voffA);
            PG8_BAR; PG8_WAIT_L(0); PG8_MMA(1, 0, At, B0); PG8_BAR; PG8_SCHED;
            PG8_STAGE(PG8_SB(1, 1), b3 + hstep, voffB);
            PG8_WAIT_V(6); PG8_BAR; PG8_MMA(1, 1, At, B1); PG8_BAR;
            }
        }
        if constexpr (ALIGN_EPI) { if (wr == 0) PG8_BAR; }
        if constexpr (!Epi::AFTER_DRAIN) { E(acc, cur, wr, wc, fr, fq); S.done(cur); }
        if (!has_next) break;
#pragma unroll
        for (int a = 0; a < 2; ++a)
#pragma unroll
            for (int b = 0; b < 2; ++b)
#pragma unroll
                for (int m = 0; m < 4; ++m)
#pragma unroll
                    for (int n = 0; n < 2; ++n) acc[a][b][m][n] = (f32x4){0.f, 0.f, 0.f, 0.f};
        cur = nxt; cA = nA; cB = nB; ++ui;
        if constexpr (ALIGN_EPI) { if (wr == 1) PG8_BAR; }
    }
    PG8_WAIT_V(0);
    if constexpr (!ALIGN_EPI) { if (wr == 0) PG8_BAR; }
    PG8_BAR;
    if constexpr (Epi::AFTER_DRAIN) { E.fused(acc, cur, wr, wc, fr, fq, lds, wid, lane); S.done(cur); }
#undef PG8_SA
#undef PG8_SB
#undef PG8_STAGE
#undef PG8_LDA
#undef PG8_LDB
#undef PG8_MMA
#undef PG8_WAIT_V
#undef PG8_WAIT_L
#undef PG8_BAR
#undef PG8_SCHED
}
}

#ifndef PG8_SP2
#define PG8_SP2 true
#endif
#ifndef PG8_ALIGN
#define PG8_ALIGN true
#endif
#include <hip/hip_bf16.h>
#include <cmath>
namespace attn_body {
using bf16=__hip_bfloat16;
using bf16x8=__attribute__((ext_vector_type(8)))short;
using s16x4=__attribute__((ext_vector_type(4)))short;
using f32x16=__attribute__((ext_vector_type(16)))float;
using u32x4=__attribute__((ext_vector_type(4)))unsigned;
constexpr int BATCH=4,SEQ=8192,D=64,PP=6144,OP=2048;
constexpr int NW=8,QBLK=32,QB=QBLK*NW,KVBLK=64,NQB=SEQ/QB;
constexpr int ATTN_UNIT_ROWS=QB;
__device__ __forceinline__ int crow(int r,int hi){return (r&3)+8*(r>>2)+4*hi;}
#define SBAR() __builtin_amdgcn_sched_barrier(0)
__device__ __forceinline__ void cmask(f32x16&p0,f32x16&p1,int jb,int qrel,int hi){
  const float NEG=-INFINITY; int kb=64*jb+4*hi;
  #pragma unroll
  for(int r=0;r<16;++r){int kv=kb+(r&3)+8*(r>>2); if(kv>qrel)p0[r]=NEG; if(kv+32>qrel)p1[r]=NEG;}
}

constexpr int NSLOT=3, SLOTB=8192;
constexpr int LDS_K=0, LDS_V=NSLOT*SLOTB, LDS_WS=2*NSLOT*SLOTB, LDS_OST=LDS_WS+NW*64*4, LDS_BYTES=LDS_OST+NW*4096;
constexpr float C2=0.125f*1.4426950408889634f;
__device__ __forceinline__ void glds16(const void*gsrc,unsigned lds_dst){unsigned keep;
  asm volatile("s_mov_b32 %0, m0\n\ts_mov_b32 m0, %2\n\ts_nop 0\n\tglobal_load_lds_dwordx4 %1, off\n\ts_mov_b32 m0, %0":"=&s"(keep):"v"(gsrc),"s"(lds_dst):"memory");}
__device__ __forceinline__ float max3f(float a,float b,float c){float r;asm("v_max3_f32 %0, %1, %2, %3":"=v"(r):"v"(a),"v"(b),"v"(c));return r;}
__device__ __forceinline__ float max2f(float a,float b){float r;asm("v_max_f32_e32 %0, %1, %2":"=v"(r):"v"(a),"v"(b));return r;}
__device__ __forceinline__ float fadd_s(float a,float b){float r;asm("v_add_f32_e32 %0, %1, %2":"=v"(r):"v"(a),"v"(b));return r;}
__device__ __forceinline__ float fsub_s(float a,float b){float r;asm("v_sub_f32_e32 %0, %1, %2":"=v"(r):"v"(a),"v"(b));return r;}
typedef float f32x2_t __attribute__((ext_vector_type(2))); typedef __bf16 bf16x2_t __attribute__((ext_vector_type(2)));
__device__ __forceinline__ unsigned cvtpk_s(float lo,float hi){f32x2_t v={lo,hi};bf16x2_t b=__builtin_convertvector(v,bf16x2_t);return __builtin_bit_cast(unsigned,b);}
#define WAIT_BAR(N) asm volatile("s_waitcnt vmcnt(" #N ") lgkmcnt(0)\n\ts_barrier":::"memory")

__device__ __forceinline__ void qkt(f32x16&p0,f32x16&p1,const char*Kslot,const bf16x8*qr,const f32x16&negm,int r32,int hi){
  const char*kb=Kslot+hi*1024+r32*16;
  #pragma unroll
  for(int d0=0;d0<4;++d0){
    const bf16x8 b0=*reinterpret_cast<const bf16x8*>(kb+d0*2048);
    const bf16x8 b1=*reinterpret_cast<const bf16x8*>(kb+d0*2048+512);
    if(d0==0){p0=__builtin_amdgcn_mfma_f32_32x32x16_bf16(b0,qr[0],negm,0,0,0);p1=__builtin_amdgcn_mfma_f32_32x32x16_bf16(b1,qr[0],negm,0,0,0);}
    else{p0=__builtin_amdgcn_mfma_f32_32x32x16_bf16(b0,qr[d0],p0,0,0,0);p1=__builtin_amdgcn_mfma_f32_32x32x16_bf16(b1,qr[d0],p1,0,0,0);}}
}
typedef __attribute__((address_space(3))) const char* lds_cptr;
typedef short v4i16_t __attribute__((ext_vector_type(4)));
__device__ __forceinline__ void kload8(bf16x8*kf,lds_cptr kp){
  kf[0]=*(const __attribute__((address_space(3))) bf16x8*)(kp);      kf[1]=*(const __attribute__((address_space(3))) bf16x8*)(kp+512);
  kf[2]=*(const __attribute__((address_space(3))) bf16x8*)(kp+2048); kf[3]=*(const __attribute__((address_space(3))) bf16x8*)(kp+2560);
  kf[4]=*(const __attribute__((address_space(3))) bf16x8*)(kp+4096); kf[5]=*(const __attribute__((address_space(3))) bf16x8*)(kp+4608);
  kf[6]=*(const __attribute__((address_space(3))) bf16x8*)(kp+6144); kf[7]=*(const __attribute__((address_space(3))) bf16x8*)(kp+6656);
}
__device__ __forceinline__ void kload2(bf16x8*kf,lds_cptr kp,int j){ kf[2*j]=*(const __attribute__((address_space(3))) bf16x8*)(kp+j*2048); kf[2*j+1]=*(const __attribute__((address_space(3))) bf16x8*)(kp+j*2048+512); }
__device__ __forceinline__ s16x4 vtr(lds_cptr p){ return __builtin_bit_cast(s16x4,__builtin_amdgcn_ds_read_tr16_b64_v4i16((__attribute__((address_space(3))) v4i16_t*)p)); }
__device__ __forceinline__ float rowmax(const f32x16&p0,const f32x16&p1){
  float a=max3f(p0[0],p0[1],p1[0]),b=max3f(p0[2],p0[3],p1[1]);a=max3f(a,p1[2],p1[3]);
  #pragma unroll
  for(int r=4;r<16;r+=4){a=max3f(a,p0[r],p0[r+1]);b=max3f(b,p0[r+2],p0[r+3]);a=max3f(a,p1[r],p1[r+1]);b=max3f(b,p1[r+2],p1[r+3]);}
  const float m=max2f(a,b);
  auto rr=__builtin_amdgcn_permlane32_swap(__float_as_uint(m),__float_as_uint(m),false,false);
  return max2f(__uint_as_float(rr[0]),__uint_as_float(rr[1]));
}
__device__ __forceinline__ void pv(f32x16*o,int vb,bf16x8 pa0,bf16x8 pa1,bf16x8 pa2,bf16x8 pa3){
  #pragma unroll
  for(int d0=0;d0<2;++d0){s16x4 lo[4],hi[4];
    #pragma unroll
    for(int ks=0;ks<4;++ks){
      asm volatile("ds_read_b64_tr_b16 %0,%1 offset:%c2":"=&v"(lo[ks]):"v"(vb),"i"(d0*4096+ks*1024):"memory");
      asm volatile("ds_read_b64_tr_b16 %0,%1 offset:%c2":"=&v"(hi[ks]):"v"(vb),"i"(d0*4096+ks*1024+512):"memory");}
    asm volatile("s_waitcnt lgkmcnt(0)":::"memory");SBAR();
    #define PK(k) (bf16x8){lo[k][0],lo[k][1],lo[k][2],lo[k][3],hi[k][0],hi[k][1],hi[k][2],hi[k][3]}
    o[d0]=__builtin_amdgcn_mfma_f32_32x32x16_bf16(pa0,PK(0),o[d0],0,0,0);
    o[d0]=__builtin_amdgcn_mfma_f32_32x32x16_bf16(pa1,PK(1),o[d0],0,0,0);
    o[d0]=__builtin_amdgcn_mfma_f32_32x32x16_bf16(pa2,PK(2),o[d0],0,0,0);
    o[d0]=__builtin_amdgcn_mfma_f32_32x32x16_bf16(pa3,PK(3),o[d0],0,0,0);
    #undef PK
  }
}

#ifndef ATTN_STORE16
#define ATTN_STORE16(p,v) (*(u32x4*)(p)=(v))
#endif
template<int THRL> __device__ __forceinline__ void attn_unit(int b,int qb,const bf16*Q,const bf16*__restrict__ K,const bf16*__restrict__ V,bf16*O,char*shm){
  const int tid=threadIdx.x,lane=tid&63,r32=lane&31,hi=lane>>5; const int wid=__builtin_amdgcn_readfirstlane(tid>>6);
  const long rowbase=(long)b*SEQ; const int q0=qb*QB;
  const bf16*Qw=Q+(rowbase+q0+wid*QBLK)*PP;
  const bf16*Kh=K+rowbase*PP,*Vh=V+rowbase*PP;
  const unsigned lds0=(unsigned)(uintptr_t)shm;
  float*wsf=(float*)(shm+LDS_WS)+wid*64;
  const bf16*ksrc=Kh+(long)lane*PP+wid*8;
  const bf16*vsrc=Vh+(long)(16*(wid&3)+(lane>>2))*PP+(wid>>2)*32+(lane&3)*8;
  const unsigned kdst=lds0+LDS_K+wid*1024, vdst=lds0+LDS_V+wid*1024;
  #define DMA_K(t,slot) glds16(ksrc+(long)(t)*KVBLK*PP,(unsigned)__builtin_amdgcn_readfirstlane(kdst+(slot)))
  #define DMA_V(t,slot) glds16(vsrc+(long)(t)*KVBLK*PP,(unsigned)__builtin_amdgcn_readfirstlane(vdst+(slot)))
  const int vb0=(int)(lds0+LDS_V)+((lane>>4)&1)*32+(lane&3)*8+(4*hi+((lane&15)>>2))*64;
  const char*Kbase=shm+LDS_K; bf16x8 kf[8];
  const lds_cptr shm3=(lds_cptr)shm; const lds_cptr kp0=shm3+LDS_K+hi*1024+r32*16; const lds_cptr vp0=shm3+LDS_V+((lane>>4)&1)*32+(lane&3)*8+(4*hi+((lane&15)>>2))*64;
  const int NT=(q0+QB)/KVBLK;
  DMA_K(0,0);DMA_V(0,0);DMA_K(1,SLOTB);
  bf16x8 qr[4];
  #pragma unroll
  for(int d0=0;d0<4;++d0)qr[d0]=*reinterpret_cast<const bf16x8*>(&Qw[(long)r32*PP+d0*16+hi*8]);
  float mhat=0.f,l_reg=0.f;f32x16 o[2];o[0]=f32x16{};o[1]=f32x16{};f32x16 negm=f32x16{};asm volatile("":"+v"(negm));
  const int qrel=wid*QBLK+r32;
  #define CMASK(P0,P1,t) do{int jb_=(t)-(NT-4); if(jb_>=0)cmask(P0,P1,jb_,qrel,hi);}while(0)
  bool resc=false;
  #define START(P0,P1) do{ const float rm=rowmax(P0,P1); resc=false; \
    { const float dl=rm; mhat=fadd_s(mhat,dl); \
      _Pragma("unroll") for(int r=0;r<16;++r){P0[r]=fsub_s(P0[r],dl);P1[r]=fsub_s(P1[r],dl);} \
      _Pragma("unroll") for(int r=0;r<16;++r)negm[r]=-mhat; asm volatile("":"+v"(negm)); } \
    _Pragma("unroll") for(int r=0;r<16;++r)P0[r]=__builtin_amdgcn_exp2f(P0[r]); }while(0)
  #define RESC() do{ if(resc){ asm volatile("s_waitcnt lgkmcnt(0)":::"memory"); \
      _Pragma("unroll") for(int d_=0;d_<2;++d_) _Pragma("unroll") for(int r=0;r<16;++r)o[d_][r]*=wsf[crow(r,hi)]; } }while(0)
  f32x16 pA0,pA1,pB0,pB1;
  int sl_prev=0,sl_cur=0,sl_next=SLOTB;
  #define ROT() do{sl_prev=sl_cur;sl_cur=sl_next;sl_next=(sl_next==(NSLOT-1)*SLOTB)?0:sl_next+SLOTB;}while(0)
  DMA_K(2,2*SLOTB);
  WAIT_BAR(3);
  qkt(pA0,pA1,Kbase,qr,negm,r32,hi);asm volatile("s_nop 15\n\ts_nop 7":"+v"(pA0),"+v"(pA1));CMASK(pA0,pA1,0);
  START(pA0,pA1);
  _Pragma("unroll") for(int r=0;r<16;++r)pA1[r]=__builtin_amdgcn_exp2f(pA1[r]);
  WAIT_BAR(0);
  DMA_K(3,0);DMA_V(1,SLOTB);
  ROT();
  kload8(kf,kp0+sl_cur);
  WAIT_BAR(2);
  s16x4 vlo[8],vhi[8]; u32x4 pw0,pw1,pw2,pw3;
  #define PKW(P,B) cvtpk_s(P[B],P[B+1])
  #define PAF(k) __builtin_bit_cast(bf16x8,pw##k)
  #define VFR(i) (bf16x8){vlo[i][0],vlo[i][1],vlo[i][2],vlo[i][3],vhi[i][0],vhi[i][1],vhi[i][2],vhi[i][3]}
  #define PIN(x) asm volatile("":"+v"(x))
  #define MX3(a,b,c) __builtin_fmaxf(__builtin_fmaxf((a),(b)),(c))
  #define GAPA(MF,A0,A1,A2,A3,W0,W1,PW) do{ MF; sacc+=A0; sacc+=A1; sacc+=A2; sacc+=A3; PIN(sacc); W0; W1; PIN(PW); SBAR(); }while(0)
  #define EX(v) __builtin_amdgcn_exp2f(v)
  #define GAPB(MF,X,B) do{ MF; X[B]=EX(X[B]); X[B+1]=EX(X[B+1]); X[B+2]=EX(X[B+2]); X[B+3]=EX(X[B+3]); PIN(X); SBAR(); }while(0)
  #define VRD(i) do{ vlo[i]=vtr(vp_+(((i)>>2)*4096+((i)&3)*1024)); vhi[i]=vtr(vp_+(((i)>>2)*4096+((i)&3)*1024+512)); }while(0)
  #define KRD(G,j) do{ if(G){ kload2(kf,kp0+sl_next,j); SBAR(); } }while(0)
  #define STEP(C0,C1,P0,P1,t,GK,GV,GL) do{ SBAR(); \
    const lds_cptr vp_=vp0+sl_prev; \
    VRD(0); SBAR(); float sacc=(P0[0]+P0[1]); \
    GAPA(C0=__builtin_amdgcn_mfma_f32_32x32x16_bf16(kf[0],qr[0],negm,0,0,0), P0[2],P0[3],P0[4],P0[5],     pw0[0]=PKW(P0,0), pw0[1]=PKW(P0,2), pw0); \
    VRD(4); SBAR(); GAPA(C1=__builtin_amdgcn_mfma_f32_32x32x16_bf16(kf[1],qr[0],negm,0,0,0), P0[6],P0[7],P0[8],P0[9],     pw0[2]=PKW(P0,4), pw0[3]=PKW(P0,6), pw0); \
    VRD(1); SBAR(); GAPA(C0=__builtin_amdgcn_mfma_f32_32x32x16_bf16(kf[2],qr[1],C0,0,0,0),   P0[10],P0[11],P0[12],P0[13], pw1[0]=PKW(P0,8), pw1[1]=PKW(P0,10), pw1); \
    VRD(5); SBAR(); GAPA(C1=__builtin_amdgcn_mfma_f32_32x32x16_bf16(kf[3],qr[1],C1,0,0,0),   P0[14],P0[15],P1[0],P1[1],   pw1[2]=PKW(P0,12),pw1[3]=PKW(P0,14), pw1); \
    VRD(2); SBAR(); GAPA(C0=__builtin_amdgcn_mfma_f32_32x32x16_bf16(kf[4],qr[2],C0,0,0,0),   P1[2],P1[3],P1[4],P1[5],     pw2[0]=PKW(P1,0), pw2[1]=PKW(P1,2), pw2); \
    VRD(6); SBAR(); GAPA(C1=__builtin_amdgcn_mfma_f32_32x32x16_bf16(kf[5],qr[2],C1,0,0,0),   P1[6],P1[7],P1[8],P1[9],     pw2[2]=PKW(P1,4), pw2[3]=PKW(P1,6), pw2); \
    VRD(3); SBAR(); GAPA(C0=__builtin_amdgcn_mfma_f32_32x32x16_bf16(kf[6],qr[3],C0,0,0,0),   P1[10],P1[11],P1[12],P1[13], pw3[0]=PKW(P1,8), pw3[1]=PKW(P1,10), pw3); \
    VRD(7); SBAR(); GAPA(C1=__builtin_amdgcn_mfma_f32_32x32x16_bf16(kf[7],qr[3],C1,0,0,0),   P1[14],P1[15],0.f,0.f,       pw3[2]=PKW(P1,12),pw3[3]=PKW(P1,14), pw3); \
    l_reg+=sacc; \
    if(GK){DMA_K((t)+3,sl_cur);} if(GV){DMA_V((t)+1,sl_next);} \
    CMASK(C0,C1,t); \
    { float a=MX3(C0[0],C0[1],C1[0]),b=MX3(C0[2],C0[3],C1[1]); a=MX3(a,C1[2],C1[3]); \
      _Pragma("unroll") for(int r=4;r<16;r+=4){a=MX3(a,C0[r],C0[r+1]);b=MX3(b,C0[r+2],C0[r+3]);a=MX3(a,C1[r],C1[r+1]);b=MX3(b,C1[r+2],C1[r+3]);} \
      float rm=__builtin_fmaxf(a,b); { auto rr=__builtin_amdgcn_permlane32_swap(__float_as_uint(rm),__float_as_uint(rm),false,false); rm=__builtin_fmaxf(__uint_as_float(rr[0]),__uint_as_float(rr[1])); } \
      resc=false; \
      if(__builtin_expect(__any(rm>(float)THRL),0)){ const float dl=__builtin_fmaxf(rm,0.f); mhat+=dl; \
        _Pragma("unroll") for(int r=0;r<16;++r){C0[r]-=dl;C1[r]-=dl;} \
        _Pragma("unroll") for(int r=0;r<16;++r)negm[r]=-mhat; asm volatile("":"+v"(negm)); \
        const float f=__builtin_amdgcn_exp2f(-dl); l_reg*=f; if(hi==0)wsf[r32]=f; resc=true; } } \
    SBAR(); \
    GAPB(o[0]=__builtin_amdgcn_mfma_f32_32x32x16_bf16(PAF(0),VFR(0),o[0],0,0,0), C0,0); \
    GAPB(o[1]=__builtin_amdgcn_mfma_f32_32x32x16_bf16(PAF(0),VFR(4),o[1],0,0,0), C0,4); \
    KRD(GL,0); GAPB(o[0]=__builtin_amdgcn_mfma_f32_32x32x16_bf16(PAF(1),VFR(1),o[0],0,0,0), C0,8); \
    KRD(GL,1); GAPB(o[1]=__builtin_amdgcn_mfma_f32_32x32x16_bf16(PAF(1),VFR(5),o[1],0,0,0), C0,12); \
    KRD(GL,2); GAPB(o[0]=__builtin_amdgcn_mfma_f32_32x32x16_bf16(PAF(2),VFR(2),o[0],0,0,0), C1,0); \
    KRD(GL,3); GAPB(o[1]=__builtin_amdgcn_mfma_f32_32x32x16_bf16(PAF(2),VFR(6),o[1],0,0,0), C1,4); \
    GAPB(o[0]=__builtin_amdgcn_mfma_f32_32x32x16_bf16(PAF(3),VFR(3),o[0],0,0,0), C1,8); \
    GAPB(o[1]=__builtin_amdgcn_mfma_f32_32x32x16_bf16(PAF(3),VFR(7),o[1],0,0,0), C1,12); \
    }while(0)
  int t=1;
  #undef CMASK
  #define CMASK(P0,P1,t) do{}while(0)
  for(;t+5<NT;t+=2){
    STEP(pB0,pB1,pA0,pA1,t,true,true,true);     WAIT_BAR(2); RESC(); ROT();
    STEP(pA0,pA1,pB0,pB1,t+1,true,true,true);   WAIT_BAR(2); RESC(); ROT();
  }
  #undef CMASK
  #define CMASK(P0,P1,t) do{int jb_=(t)-(NT-4); if(jb_>=0)cmask(P0,P1,jb_,qrel,hi);}while(0)
  #define ENDW(tt) do{ if((tt)+3<NT){WAIT_BAR(2);} else if((tt)+2<NT){WAIT_BAR(1);} else {WAIT_BAR(0);} }while(0)
  for(;t+1<NT;t+=2){
    STEP(pB0,pB1,pA0,pA1,t,(t+3<NT),(t+1<NT),(t+1<NT));       ENDW(t);   RESC(); ROT();
    STEP(pA0,pA1,pB0,pB1,t+1,(t+4<NT),(t+2<NT),(t+2<NT));     ENDW(t+1); RESC(); ROT();
  }
  STEP(pB0,pB1,pA0,pA1,NT-1,false,false,false); RESC();
  { float sacc=pB0[0]+pB0[1]; _Pragma("unroll") for(int r=2;r<16;++r)sacc+=pB0[r]; _Pragma("unroll") for(int r=0;r<16;++r)sacc+=pB1[r]; l_reg+=sacc;
    pw0=(u32x4){PKW(pB0,0),PKW(pB0,2),PKW(pB0,4),PKW(pB0,6)};pw1=(u32x4){PKW(pB0,8),PKW(pB0,10),PKW(pB0,12),PKW(pB0,14)};pw2=(u32x4){PKW(pB1,0),PKW(pB1,2),PKW(pB1,4),PKW(pB1,6)};pw3=(u32x4){PKW(pB1,8),PKW(pB1,10),PKW(pB1,12),PKW(pB1,14)};
    SBAR(); pv(o,vb0+sl_cur,PAF(0),PAF(1),PAF(2),PAF(3)); }
  #undef PKW
  #undef PAF
  #undef VFR
  #undef PIN
  #undef MX3
  #undef GAPA
  #undef GAPB
  #undef EX
  #undef VRD
  #undef KRD
  #undef STEP
  #undef ENDW
  {auto rr=__builtin_amdgcn_permlane32_swap(__float_as_uint(l_reg),__float_as_uint(l_reg),false,false);l_reg=__uint_as_float(rr[0])+__uint_as_float(rr[1]);}
  if(hi==0)wsf[32+r32]=l_reg;asm volatile("s_waitcnt lgkmcnt(0)":::"memory");
  float rli[16];
  #pragma unroll
  for(int r=0;r<16;++r)rli[r]=__builtin_amdgcn_rcpf(wsf[32+crow(r,hi)]);
  bf16*Ow=O+(rowbase+q0+wid*QBLK)*OP;
  { bf16*stg=(bf16*)(shm+LDS_OST)+wid*2048;
    #pragma unroll
    for(int r=0;r<16;++r){const int orow=crow(r,hi);
      #pragma unroll
      for(int d0=0;d0<2;++d0)stg[orow*64+d0*32+r32]=__float2bfloat16(o[d0][r]*rli[r]);}
    asm volatile("s_waitcnt lgkmcnt(0)":::"memory");
    #pragma unroll
    for(int i=0;i<4;++i){const int row=i*8+(lane>>3),ch=lane&7; const u32x4 v=*(const u32x4*)(stg+row*64+ch*8); ATTN_STORE16(Ow+(long)row*OP+ch*8,v);} }
  asm volatile("s_waitcnt lgkmcnt(0)\n\ts_barrier":::"memory");
  #undef DMA_K
  #undef DMA_V
  #undef CMASK
  #undef START
  #undef RESC
  #undef ROT
}
constexpr int ATTN_LDS_BYTES=LDS_BYTES;
struct AttnTensors { const bf16* P; bf16* O; };
struct AttnUnit { int bh; int qb; };
struct StaticOrder {
  int vcu;
  __device__ __forceinline__ explicit StaticOrder(int grid,int block):vcu((block%8)*(grid/8)+block/8){}
  __device__ __forceinline__ bool next(int i,AttnUnit&u)const{ if(i>=16)return false; const int s=vcu&7,j=i&3; u.bh=(i>>2)*32+(vcu>>3); u.qb=(j==0)?s:(j==1)?15-s:(j==2)?16+s:31-s; return true; }
};
template<class Sched,int THRL=8> __device__ __forceinline__ void attn_phase(char*lds,const AttnTensors&T,const Sched&S){
  AttnUnit u;
  for(int i=0;S.next(i,u);++i){ const int b=u.bh>>5,v=u.bh&31,hc=v>>1,h=v>>2,vh=v&1;
    attn_unit<THRL>(b,u.qb,T.P+3072+hc*64,T.P+4096+hc*64,T.P+5120+h*128+vh*64,T.O+v*64,lds); }
}
constexpr int SLOTK=8192, SLOTV=16384;
constexpr int L2_K=0, L2_V=3*SLOTK, L2_WS=L2_V+3*SLOTV, L2_OST=L2_WS+NW*64*4, LDS2_BYTES=L2_OST+NW*8192;
template<int THRL> __device__ __forceinline__ void attn_unit2(int b,int qb,const bf16*Q,const bf16*__restrict__ K,const bf16*__restrict__ V,bf16*O,char*shm){
  const int tid=threadIdx.x,lane=tid&63,r32=lane&31,hi=lane>>5; const int wid=__builtin_amdgcn_readfirstlane(tid>>6);
  const long rowbase=(long)b*SEQ; const int q0=qb*QB;
  const bf16*Qw=Q+(rowbase+q0+wid*QBLK)*PP;
  const bf16*Kh=K+rowbase*PP,*Vh=V+rowbase*PP;
  const unsigned lds0=(unsigned)(uintptr_t)shm;
  float*wsf=(float*)(shm+L2_WS)+wid*64;
  const bf16*ksrc=Kh+(long)lane*PP+wid*8;
  const bf16*vsrc=Vh+(long)(16*(wid&3)+(lane>>2))*PP+(wid>>2)*32+(lane&3)*8;
  const unsigned kdst=lds0+L2_K+wid*1024, vdst=lds0+L2_V+wid*1024;
  #define DMA2_K(t,s) glds16(ksrc+(long)(t)*KVBLK*PP,(unsigned)__builtin_amdgcn_readfirstlane(kdst+(s)*SLOTK))
  #define DMA2_V(t,s) do{ glds16(vsrc+(long)(t)*KVBLK*PP,(unsigned)__builtin_amdgcn_readfirstlane(vdst+(s)*SLOTV)); glds16(vsrc+(long)(t)*KVBLK*PP+64,(unsigned)__builtin_amdgcn_readfirstlane(vdst+(s)*SLOTV+8192)); }while(0)
  const int vb0=(int)(lds0+L2_V)+((lane>>4)&1)*32+(lane&3)*8+(4*hi+((lane&15)>>2))*64;
  bf16x8 qr[4];
  #pragma unroll
  for(int d0=0;d0<4;++d0)qr[d0]=*reinterpret_cast<const bf16x8*>(&Qw[(long)r32*PP+d0*16+hi*8]);
  const int NT=(q0+QB)/KVBLK;
  DMA2_K(0,0);DMA2_V(0,0);DMA2_K(1,1);DMA2_V(1,1);
  float mhat=0.f,l_reg=0.f;f32x16 o[4];o[0]=f32x16{};o[1]=f32x16{};o[2]=f32x16{};o[3]=f32x16{};f32x16 negm=f32x16{};asm volatile("":"+v"(negm));
  const int qrel=wid*QBLK+r32;
  int slot=0;
  for(int t=0;t<NT;++t){
    if(t+1<NT){WAIT_BAR(3);}else{WAIT_BAR(0);}
    if(t+2<NT){const int s2=(slot==0)?2:slot-1; DMA2_K(t+2,s2);DMA2_V(t+2,s2);}
    f32x16 p0,p1;
    qkt(p0,p1,shm+L2_K+slot*SLOTK,qr,negm,r32,hi);
    asm volatile("s_nop 15\n\ts_nop 7":"+v"(p0),"+v"(p1));
    if(t>=NT-4)cmask(p0,p1,t-(NT-4),qrel,hi);
    const float rm=rowmax(p0,p1);
    const bool first=(t==0);
    if(first||__any(rm>(float)THRL)){
      const float dl=first?rm:__builtin_fmaxf(rm,0.f); mhat+=dl;
      #pragma unroll
      for(int r=0;r<16;++r){p0[r]-=dl;p1[r]-=dl;}
      #pragma unroll
      for(int r=0;r<16;++r)negm[r]=-mhat;
      asm volatile("":"+v"(negm));
      if(!first){ const float f=__builtin_amdgcn_exp2f(-dl); l_reg*=f; if(hi==0)wsf[r32]=f; asm volatile("s_waitcnt lgkmcnt(0)":::"memory");
        #pragma unroll
        for(int d_=0;d_<4;++d_)
          #pragma unroll
          for(int r=0;r<16;++r)o[d_][r]*=wsf[crow(r,hi)];
        asm volatile("s_waitcnt lgkmcnt(0)":::"memory"); }
    }
    #pragma unroll
    for(int r=0;r<16;++r){p0[r]=__builtin_amdgcn_exp2f(p0[r]);p1[r]=__builtin_amdgcn_exp2f(p1[r]);}
    { float sa=0.f,sb=0.f;
      #pragma unroll
      for(int r=0;r<16;++r){sa+=p0[r];sb+=p1[r];}
      l_reg+=sa+sb; }
    u32x4 pw0,pw1,pw2,pw3;
    pw0=(u32x4){cvtpk_s(p0[0],p0[1]),cvtpk_s(p0[2],p0[3]),cvtpk_s(p0[4],p0[5]),cvtpk_s(p0[6],p0[7])};
    pw1=(u32x4){cvtpk_s(p0[8],p0[9]),cvtpk_s(p0[10],p0[11]),cvtpk_s(p0[12],p0[13]),cvtpk_s(p0[14],p0[15])};
    pw2=(u32x4){cvtpk_s(p1[0],p1[1]),cvtpk_s(p1[2],p1[3]),cvtpk_s(p1[4],p1[5]),cvtpk_s(p1[6],p1[7])};
    pw3=(u32x4){cvtpk_s(p1[8],p1[9]),cvtpk_s(p1[10],p1[11]),cvtpk_s(p1[12],p1[13]),cvtpk_s(p1[14],p1[15])};
    SBAR();
    pv(o,vb0+slot*SLOTV,__builtin_bit_cast(bf16x8,pw0),__builtin_bit_cast(bf16x8,pw1),__builtin_bit_cast(bf16x8,pw2),__builtin_bit_cast(bf16x8,pw3));
    pv(o+2,vb0+slot*SLOTV+8192,__builtin_bit_cast(bf16x8,pw0),__builtin_bit_cast(bf16x8,pw1),__builtin_bit_cast(bf16x8,pw2),__builtin_bit_cast(bf16x8,pw3));
    slot=(slot==2)?0:slot+1;
  }
  {auto rr=__builtin_amdgcn_permlane32_swap(__float_as_uint(l_reg),__float_as_uint(l_reg),false,false);l_reg=__uint_as_float(rr[0])+__uint_as_float(rr[1]);}
  if(hi==0)wsf[32+r32]=l_reg;asm volatile("s_waitcnt lgkmcnt(0)":::"memory");
  float rli[16];
  #pragma unroll
  for(int r=0;r<16;++r)rli[r]=__builtin_amdgcn_rcpf(wsf[32+crow(r,hi)]);
  bf16*Ow=O+(rowbase+q0+wid*QBLK)*OP;
  { bf16*stg=(bf16*)(shm+L2_OST)+wid*4096;
    #pragma unroll
    for(int r=0;r<16;++r){const int orow=crow(r,hi);
      #pragma unroll
      for(int d0=0;d0<4;++d0)stg[orow*128+d0*32+r32]=__float2bfloat16(o[d0][r]*rli[r]);}
    asm volatile("s_waitcnt lgkmcnt(0)":::"memory");
    #pragma unroll
    for(int i=0;i<8;++i){const int row=i*4+(lane>>4),ch=lane&15; const u32x4 v=*(const u32x4*)(stg+row*128+ch*8); ATTN_STORE16(Ow+(long)row*OP+ch*8,v);} }
  asm volatile("s_waitcnt lgkmcnt(0)\n\ts_barrier":::"memory");
  #undef DMA2_K
  #undef DMA2_V
}
struct StaticOrder2 {
  int vcu;
  __device__ __forceinline__ explicit StaticOrder2(int grid,int block):vcu((block%8)*(grid/8)+block/8){}
  __device__ __forceinline__ bool next(int i,AttnUnit&u)const{ if(i>=8)return false; const int s=vcu&7,j=i&3; u.bh=(i>>2)*32+(vcu>>3); u.qb=(j==0)?s:(j==1)?15-s:(j==2)?16+s:31-s; return true; }
};
template<class Sched,int THRL=8> __device__ __forceinline__ void attn_phase2(char*lds,const AttnTensors&T,const Sched&S){
  AttnUnit u;
  for(int i=0;S.next(i,u);++i){ const int b=u.bh>>4,hc=u.bh&15,h=hc>>1;
    attn_unit2<THRL>(b,u.qb,T.P+3072+hc*64,T.P+4096+hc*64,T.P+5120+h*128,T.O+hc*128,lds); }
}

constexpr int NSK=4;
constexpr int L3_K=0, L3_V=NSK*SLOTK, L3_WS=L3_V+3*SLOTV, L3_Q=L3_WS+NW*64*4, LDS3_BYTES=L3_Q+NW*4096;
__device__ __forceinline__ float rowmax_c(const f32x16&p0,const f32x16&p1){
  #define MX3C(a,b,c) __builtin_fmaxf(__builtin_fmaxf((a),(b)),(c))
  float a=MX3C(p0[0],p0[1],p1[0]),b=MX3C(p0[2],p0[3],p1[1]);a=MX3C(a,p1[2],p1[3]);
  #pragma unroll
  for(int r=4;r<16;r+=4){a=MX3C(a,p0[r],p0[r+1]);b=MX3C(b,p0[r+2],p0[r+3]);a=MX3C(a,p1[r],p1[r+1]);b=MX3C(b,p1[r+2],p1[r+3]);}
  #undef MX3C
  const float m=__builtin_fmaxf(a,b);
  auto rr=__builtin_amdgcn_permlane32_swap(__float_as_uint(m),__float_as_uint(m),false,false);
  return __builtin_fmaxf(__uint_as_float(rr[0]),__uint_as_float(rr[1]));
}

__device__ __forceinline__ void qkt4(f32x16&p0,f32x16&p1,lds_cptr kp,lds_cptr qp,const f32x16&negm){
  #define KFR(off) (*(const __attribute__((address_space(3))) bf16x8*)(kp+(off)))
  #define QFR(d0) (*(const __attribute__((address_space(3))) bf16x8*)(qp+(d0)*1024))
  bf16x8 ka=KFR(0),kb=KFR(512),q0=QFR(0),kc=KFR(2048),kd=KFR(2560),q1=QFR(1); SBAR();
  p0=__builtin_amdgcn_mfma_f32_32x32x16_bf16(ka,q0,negm,0,0,0); ka=KFR(4096); SBAR();
  p1=__builtin_amdgcn_mfma_f32_32x32x16_bf16(kb,q0,negm,0,0,0); kb=KFR(4608); q0=QFR(2); SBAR();
  p0=__builtin_amdgcn_mfma_f32_32x32x16_bf16(kc,q1,p0,0,0,0);   kc=KFR(6144); SBAR();
  p1=__builtin_amdgcn_mfma_f32_32x32x16_bf16(kd,q1,p1,0,0,0);   kd=KFR(6656); q1=QFR(3); SBAR();
  p0=__builtin_amdgcn_mfma_f32_32x32x16_bf16(ka,q0,p0,0,0,0); SBAR();
  p1=__builtin_amdgcn_mfma_f32_32x32x16_bf16(kb,q0,p1,0,0,0); SBAR();
  p0=__builtin_amdgcn_mfma_f32_32x32x16_bf16(kc,q1,p0,0,0,0); SBAR();
  p1=__builtin_amdgcn_mfma_f32_32x32x16_bf16(kd,q1,p1,0,0,0); SBAR();
  #undef KFR
  #undef QFR
}
template<int THRL> __device__ __forceinline__ void attn_unit3(int b,int qb,const bf16*Q,const bf16*__restrict__ K,const bf16*__restrict__ V,bf16*O,char*shm){
  const int tid=threadIdx.x,lane=tid&63,r32=lane&31,hi=lane>>5; const int wid=__builtin_amdgcn_readfirstlane(tid>>6);
  const long rowbase=(long)b*SEQ; const int q0=qb*QB;
  const bf16*Qw=Q+(rowbase+q0+wid*QBLK)*PP;
  const bf16*Kh=K+rowbase*PP,*Vh=V+rowbase*PP;
  const unsigned lds0=(unsigned)(uintptr_t)shm;
  float*wsf=(float*)(shm+L3_WS)+wid*64;
  const bf16*ksrc=Kh+(long)lane*PP+wid*8;
  const bf16*vsrc=Vh+(long)(16*(wid&3)+(lane>>2))*PP+(wid>>2)*32+(lane&3)*8;
  const unsigned kdst=lds0+L3_K+wid*1024, vdst=lds0+L3_V+wid*1024;
  #define DMA3_K(t) glds16(ksrc+(long)(t)*KVBLK*PP,(unsigned)__builtin_amdgcn_readfirstlane(kdst+((t)&3)*SLOTK))
  #define DMA3_V(t,s) do{ glds16(vsrc+(long)(t)*KVBLK*PP,(unsigned)__builtin_amdgcn_readfirstlane(vdst+(s)*SLOTV)); glds16(vsrc+(long)(t)*KVBLK*PP+64,(unsigned)__builtin_amdgcn_readfirstlane(vdst+(s)*SLOTV+8192)); }while(0)
  const lds_cptr shm3=(lds_cptr)shm; const lds_cptr kp0=shm3+L3_K+hi*1024+r32*16; const lds_cptr vp0=shm3+L3_V+((lane>>4)&1)*32+(lane&3)*8+(4*hi+((lane&15)>>2))*64;
  const lds_cptr qp=shm3+L3_Q+wid*4096+lane*16;
  { bf16x8 qr[4];
    #pragma unroll
    for(int d0=0;d0<4;++d0)qr[d0]=*reinterpret_cast<const bf16x8*>(&Qw[(long)r32*PP+d0*16+hi*8]);
    #pragma unroll
    for(int d0=0;d0<4;++d0)*(__attribute__((address_space(3))) bf16x8*)((__attribute__((address_space(3))) char*)qp+d0*1024)=qr[d0]; }
  const int NT=(q0+QB)/KVBLK;
  DMA3_K(0);DMA3_V(0,0);DMA3_K(1);DMA3_V(1,1);DMA3_K(2);
  float mhat=0.f;f32x16 lacc=f32x16{};const bf16x8 ones={16256,16256,16256,16256,16256,16256,16256,16256};     f32x16 o[4];o[0]=f32x16{};o[1]=f32x16{};o[2]=f32x16{};o[3]=f32x16{};f32x16 negm=f32x16{};asm volatile("":"+v"(negm));
  const int qrel=wid*QBLK+r32;
  WAIT_BAR(3);
  DMA3_K(3);DMA3_V(2,2);
  f32x16 p0,p1; u32x4 pw0,pw1,pw2,pw3;
  qkt4(p0,p1,kp0,qp,negm);
  if(NT==4)cmask(p0,p1,0,qrel,hi);
  { const float rm=rowmax_c(p0,p1); mhat=rm;
    #pragma unroll
    for(int r=0;r<16;++r){p0[r]=__builtin_amdgcn_exp2f(p0[r]-rm);p1[r]=__builtin_amdgcn_exp2f(p1[r]-rm);}
    #pragma unroll
    for(int r=0;r<16;++r)negm[r]=-mhat;
    asm volatile("":"+v"(negm));
    pw0=(u32x4){cvtpk_s(p0[0],p0[1]),cvtpk_s(p0[2],p0[3]),cvtpk_s(p0[4],p0[5]),cvtpk_s(p0[6],p0[7])};
    pw1=(u32x4){cvtpk_s(p0[8],p0[9]),cvtpk_s(p0[10],p0[11]),cvtpk_s(p0[12],p0[13]),cvtpk_s(p0[14],p0[15])};
    pw2=(u32x4){cvtpk_s(p1[0],p1[1]),cvtpk_s(p1[2],p1[3]),cvtpk_s(p1[4],p1[5]),cvtpk_s(p1[6],p1[7])};
    pw3=(u32x4){cvtpk_s(p1[8],p1[9]),cvtpk_s(p1[10],p1[11]),cvtpk_s(p1[12],p1[13]),cvtpk_s(p1[14],p1[15])}; }
  int vs=0;
  #define VFL(dq,ks) ({ const s16x4 lo_=vtr(vp_+((dq)*4096+(ks)*1024)),hi_=vtr(vp_+((dq)*4096+(ks)*1024+512)); (bf16x8){lo_[0],lo_[1],lo_[2],lo_[3],hi_[0],hi_[1],hi_[2],hi_[3]}; })
  u32x4 n0=(u32x4){0u,0u,0u,0u},n1=n0,n2=n0,n3=n0;
  for(int t2=0;t2<NT;t2+=2){
   { const int t=t2;
    const bool more=(t+1<NT);
    if(t>0){
      if(t+2<NT){WAIT_BAR(3);}else if(more){WAIT_BAR(2);}else{WAIT_BAR(0);}
      if(t+3<NT)DMA3_K(t+3);
      if(t+2<NT){const int s2=(vs==0)?2:vs-1; DMA3_V(t+2,s2);}
    }
    bool resc=false;
    if(more){
      qkt4(p0,p1,kp0+((t+1)&3)*SLOTK,qp,negm);
      if(t+1>=NT-4)cmask(p0,p1,t+1-(NT-4),qrel,hi);
      const float rm=rowmax_c(p0,p1);
      if(__builtin_expect(__any(rm>(float)THRL),0)){ const float dl=__builtin_fmaxf(rm,0.f); mhat+=dl;
        #pragma unroll
        for(int r=0;r<16;++r){p0[r]-=dl;p1[r]-=dl;}
        #pragma unroll
        for(int r=0;r<16;++r)negm[r]=-mhat;
        asm volatile("":"+v"(negm));
        const float f=__builtin_amdgcn_exp2f(-dl); if(hi==0)wsf[r32]=f; resc=true; }
    }
    const lds_cptr vp_=vp0+vs*SLOTV;
    bf16x8 vf0=VFL(0,0),vf1=VFL(1,0),vf2=VFL(2,0),vf3=VFL(3,0);

    SBAR();
    o[0]=__builtin_amdgcn_mfma_f32_32x32x16_bf16(__builtin_bit_cast(bf16x8,pw0),vf0,o[0],0,0,0); vf0=VFL(0,1); asm volatile("":"+v"(p0)); { const float e0=__builtin_amdgcn_exp2f(p0[0]),e1=__builtin_amdgcn_exp2f(p0[1]); n0[0]=cvtpk_s(e0,e1); } asm volatile("":"+v"(n0)); SBAR();
    o[1]=__builtin_amdgcn_mfma_f32_32x32x16_bf16(__builtin_bit_cast(bf16x8,pw0),vf1,o[1],0,0,0); vf1=VFL(1,1); asm volatile("":"+v"(p0)); { const float e0=__builtin_amdgcn_exp2f(p0[2]),e1=__builtin_amdgcn_exp2f(p0[3]); n0[1]=cvtpk_s(e0,e1); } asm volatile("":"+v"(n0)); SBAR();
    o[2]=__builtin_amdgcn_mfma_f32_32x32x16_bf16(__builtin_bit_cast(bf16x8,pw0),vf2,o[2],0,0,0); vf2=VFL(2,1); asm volatile("":"+v"(p0)); { const float e0=__builtin_amdgcn_exp2f(p0[4]),e1=__builtin_amdgcn_exp2f(p0[5]); n0[2]=cvtpk_s(e0,e1); } asm volatile("":"+v"(n0)); SBAR();
    o[3]=__builtin_amdgcn_mfma_f32_32x32x16_bf16(__builtin_bit_cast(bf16x8,pw0),vf3,o[3],0,0,0); vf3=VFL(3,1); asm volatile("":"+v"(p0)); { const float e0=__builtin_amdgcn_exp2f(p0[6]),e1=__builtin_amdgcn_exp2f(p0[7]); n0[3]=cvtpk_s(e0,e1); } asm volatile("":"+v"(n0)); SBAR();
    lacc=__builtin_amdgcn_mfma_f32_32x32x16_bf16(__builtin_bit_cast(bf16x8,pw0),ones,lacc,0,0,0); SBAR();
    o[0]=__builtin_amdgcn_mfma_f32_32x32x16_bf16(__builtin_bit_cast(bf16x8,pw1),vf0,o[0],0,0,0); vf0=VFL(0,2); asm volatile("":"+v"(p0)); { const float e0=__builtin_amdgcn_exp2f(p0[8]),e1=__builtin_amdgcn_exp2f(p0[9]); n1[0]=cvtpk_s(e0,e1); } asm volatile("":"+v"(n1)); SBAR();
    o[1]=__builtin_amdgcn_mfma_f32_32x32x16_bf16(__builtin_bit_cast(bf16x8,pw1),vf1,o[1],0,0,0); vf1=VFL(1,2); asm volatile("":"+v"(p0)); { const float e0=__builtin_amdgcn_exp2f(p0[10]),e1=__builtin_amdgcn_exp2f(p0[11]); n1[1]=cvtpk_s(e0,e1); } asm volatile("":"+v"(n1)); SBAR();
    o[2]=__builtin_amdgcn_mfma_f32_32x32x16_bf16(__builtin_bit_cast(bf16x8,pw1),vf2,o[2],0,0,0); vf2=VFL(2,2); asm volatile("":"+v"(p0)); { const float e0=__builtin_amdgcn_exp2f(p0[12]),e1=__builtin_amdgcn_exp2f(p0[13]); n1[2]=cvtpk_s(e0,e1); } asm volatile("":"+v"(n1)); SBAR();
    o[3]=__builtin_amdgcn_mfma_f32_32x32x16_bf16(__builtin_bit_cast(bf16x8,pw1),vf3,o[3],0,0,0); vf3=VFL(3,2); asm volatile("":"+v"(p0)); { const float e0=__builtin_amdgcn_exp2f(p0[14]),e1=__builtin_amdgcn_exp2f(p0[15]); n1[3]=cvtpk_s(e0,e1); } asm volatile("":"+v"(n1)); SBAR();
    lacc=__builtin_amdgcn_mfma_f32_32x32x16_bf16(__builtin_bit_cast(bf16x8,pw1),ones,lacc,0,0,0); SBAR();
    o[0]=__builtin_amdgcn_mfma_f32_32x32x16_bf16(__builtin_bit_cast(bf16x8,pw2),vf0,o[0],0,0,0); vf0=VFL(0,3); asm volatile("":"+v"(p1)); { const float e0=__builtin_amdgcn_exp2f(p1[0]),e1=__builtin_amdgcn_exp2f(p1[1]); n2[0]=cvtpk_s(e0,e1); } asm volatile("":"+v"(n2)); SBAR();
    o[1]=__builtin_amdgcn_mfma_f32_32x32x16_bf16(__builtin_bit_cast(bf16x8,pw2),vf1,o[1],0,0,0); vf1=VFL(1,3); asm volatile("":"+v"(p1)); { const float e0=__builtin_amdgcn_exp2f(p1[2]),e1=__builtin_amdgcn_exp2f(p1[3]); n2[1]=cvtpk_s(e0,e1); } asm volatile("":"+v"(n2)); SBAR();
    o[2]=__builtin_amdgcn_mfma_f32_32x32x16_bf16(__builtin_bit_cast(bf16x8,pw2),vf2,o[2],0,0,0); vf2=VFL(2,3); asm volatile("":"+v"(p1)); { const float e0=__builtin_amdgcn_exp2f(p1[4]),e1=__builtin_amdgcn_exp2f(p1[5]); n2[2]=cvtpk_s(e0,e1); } asm volatile("":"+v"(n2)); SBAR();
    o[3]=__builtin_amdgcn_mfma_f32_32x32x16_bf16(__builtin_bit_cast(bf16x8,pw2),vf3,o[3],0,0,0); vf3=VFL(3,3); asm volatile("":"+v"(p1)); { const float e0=__builtin_amdgcn_exp2f(p1[6]),e1=__builtin_amdgcn_exp2f(p1[7]); n2[3]=cvtpk_s(e0,e1); } asm volatile("":"+v"(n2)); SBAR();
    lacc=__builtin_amdgcn_mfma_f32_32x32x16_bf16(__builtin_bit_cast(bf16x8,pw2),ones,lacc,0,0,0); SBAR();
    o[0]=__builtin_amdgcn_mfma_f32_32x32x16_bf16(__builtin_bit_cast(bf16x8,pw3),vf0,o[0],0,0,0); asm volatile("":"+v"(p1)); { const float e0=__builtin_amdgcn_exp2f(p1[8]),e1=__builtin_amdgcn_exp2f(p1[9]); n3[0]=cvtpk_s(e0,e1); } asm volatile("":"+v"(n3)); SBAR();
    o[1]=__builtin_amdgcn_mfma_f32_32x32x16_bf16(__builtin_bit_cast(bf16x8,pw3),vf1,o[1],0,0,0); asm volatile("":"+v"(p1)); { const float e0=__builtin_amdgcn_exp2f(p1[10]),e1=__builtin_amdgcn_exp2f(p1[11]); n3[1]=cvtpk_s(e0,e1); } asm volatile("":"+v"(n3)); SBAR();
    o[2]=__builtin_amdgcn_mfma_f32_32x32x16_bf16(__builtin_bit_cast(bf16x8,pw3),vf2,o[2],0,0,0); asm volatile("":"+v"(p1)); { const float e0=__builtin_amdgcn_exp2f(p1[12]),e1=__builtin_amdgcn_exp2f(p1[13]); n3[2]=cvtpk_s(e0,e1); } asm volatile("":"+v"(n3)); SBAR();
    o[3]=__builtin_amdgcn_mfma_f32_32x32x16_bf16(__builtin_bit_cast(bf16x8,pw3),vf3,o[3],0,0,0); asm volatile("":"+v"(p1)); { const float e0=__builtin_amdgcn_exp2f(p1[14]),e1=__builtin_amdgcn_exp2f(p1[15]); n3[3]=cvtpk_s(e0,e1); } asm volatile("":"+v"(n3)); SBAR();
    lacc=__builtin_amdgcn_mfma_f32_32x32x16_bf16(__builtin_bit_cast(bf16x8,pw3),ones,lacc,0,0,0); SBAR();
    if(resc){ asm volatile("s_waitcnt lgkmcnt(0)":::"memory");
      #pragma unroll
      for(int d_=0;d_<4;++d_)
        #pragma unroll
        for(int r=0;r<16;++r)o[d_][r]*=wsf[crow(r,hi)];
      #pragma unroll
      for(int r=0;r<16;++r)lacc[r]*=wsf[crow(r,hi)];
      asm volatile("s_waitcnt lgkmcnt(0)":::"memory"); }
    vs=(vs==2)?0:vs+1;
     }
   { const int t=t2+1;
    const bool more=(t+1<NT);
    if(t>0){
      if(t+2<NT){WAIT_BAR(3);}else if(more){WAIT_BAR(2);}else{WAIT_BAR(0);}
      if(t+3<NT)DMA3_K(t+3);
      if(t+2<NT){const int s2=(vs==0)?2:vs-1; DMA3_V(t+2,s2);}
    }
    bool resc=false;
    if(more){
      qkt4(p0,p1,kp0+((t+1)&3)*SLOTK,qp,negm);
      if(t+1>=NT-4)cmask(p0,p1,t+1-(NT-4),qrel,hi);
      const float rm=rowmax_c(p0,p1);
      if(__builtin_expect(__any(rm>(float)THRL),0)){ const float dl=__builtin_fmaxf(rm,0.f); mhat+=dl;
        #pragma unroll
        for(int r=0;r<16;++r){p0[r]-=dl;p1[r]-=dl;}
        #pragma unroll
        for(int r=0;r<16;++r)negm[r]=-mhat;
        asm volatile("":"+v"(negm));
        const float f=__builtin_amdgcn_exp2f(-dl); if(hi==0)wsf[r32]=f; resc=true; }
    }
    const lds_cptr vp_=vp0+vs*SLOTV;
    bf16x8 vf0=VFL(0,0),vf1=VFL(1,0),vf2=VFL(2,0),vf3=VFL(3,0);

    SBAR();
    o[0]=__builtin_amdgcn_mfma_f32_32x32x16_bf16(__builtin_bit_cast(bf16x8,n0),vf0,o[0],0,0,0); vf0=VFL(0,1); asm volatile("":"+v"(p0)); { const float e0=__builtin_amdgcn_exp2f(p0[0]),e1=__builtin_amdgcn_exp2f(p0[1]); pw0[0]=cvtpk_s(e0,e1); } asm volatile("":"+v"(pw0)); SBAR();
    o[1]=__builtin_amdgcn_mfma_f32_32x32x16_bf16(__builtin_bit_cast(bf16x8,n0),vf1,o[1],0,0,0); vf1=VFL(1,1); asm volatile("":"+v"(p0)); { const float e0=__builtin_amdgcn_exp2f(p0[2]),e1=__builtin_amdgcn_exp2f(p0[3]); pw0[1]=cvtpk_s(e0,e1); } asm volatile("":"+v"(pw0)); SBAR();
    o[2]=__builtin_amdgcn_mfma_f32_32x32x16_bf16(__builtin_bit_cast(bf16x8,n0),vf2,o[2],0,0,0); vf2=VFL(2,1); asm volatile("":"+v"(p0)); { const float e0=__builtin_amdgcn_exp2f(p0[4]),e1=__builtin_amdgcn_exp2f(p0[5]); pw0[2]=cvtpk_s(e0,e1); } asm volatile("":"+v"(pw0)); SBAR();
    o[3]=__builtin_amdgcn_mfma_f32_32x32x16_bf16(__builtin_bit_cast(bf16x8,n0),vf3,o[3],0,0,0); vf3=VFL(3,1); asm volatile("":"+v"(p0)); { const float e0=__builtin_amdgcn_exp2f(p0[6]),e1=__builtin_amdgcn_exp2f(p0[7]); pw0[3]=cvtpk_s(e0,e1); } asm volatile("":"+v"(pw0)); SBAR();
    lacc=__builtin_amdgcn_mfma_f32_32x32x16_bf16(__builtin_bit_cast(bf16x8,n0),ones,lacc,0,0,0); SBAR();
    o[0]=__builtin_amdgcn_mfma_f32_32x32x16_bf16(__builtin_bit_cast(bf16x8,n1),vf0,o[0],0,0,0); vf0=VFL(0,2); asm volatile("":"+v"(p0)); { const float e0=__builtin_amdgcn_exp2f(p0[8]),e1=__builtin_amdgcn_exp2f(p0[9]); pw1[0]=cvtpk_s(e0,e1); } asm volatile("":"+v"(pw1)); SBAR();
    o[1]=__builtin_amdgcn_mfma_f32_32x32x16_bf16(__builtin_bit_cast(bf16x8,n1),vf1,o[1],0,0,0); vf1=VFL(1,2); asm volatile("":"+v"(p0)); { const float e0=__builtin_amdgcn_exp2f(p0[10]),e1=__builtin_amdgcn_exp2f(p0[11]); pw1[1]=cvtpk_s(e0,e1); } asm volatile("":"+v"(pw1)); SBAR();
    o[2]=__builtin_amdgcn_mfma_f32_32x32x16_bf16(__builtin_bit_cast(bf16x8,n1),vf2,o[2],0,0,0); vf2=VFL(2,2); asm volatile("":"+v"(p0)); { const float e0=__builtin_amdgcn_exp2f(p0[12]),e1=__builtin_amdgcn_exp2f(p0[13]); pw1[2]=cvtpk_s(e0,e1); } asm volatile("":"+v"(pw1)); SBAR();
    o[3]=__builtin_amdgcn_mfma_f32_32x32x16_bf16(__builtin_bit_cast(bf16x8,n1),vf3,o[3],0,0,0); vf3=VFL(3,2); asm volatile("":"+v"(p0)); { const float e0=__builtin_amdgcn_exp2f(p0[14]),e1=__builtin_amdgcn_exp2f(p0[15]); pw1[3]=cvtpk_s(e0,e1); } asm volatile("":"+v"(pw1)); SBAR();
    lacc=__builtin_amdgcn_mfma_f32_32x32x16_bf16(__builtin_bit_cast(bf16x8,n1),ones,lacc,0,0,0); SBAR();
    o[0]=__builtin_amdgcn_mfma_f32_32x32x16_bf16(__builtin_bit_cast(bf16x8,n2),vf0,o[0],0,0,0); vf0=VFL(0,3); asm volatile("":"+v"(p1)); { const float e0=__builtin_amdgcn_exp2f(p1[0]),e1=__builtin_amdgcn_exp2f(p1[1]); pw2[0]=cvtpk_s(e0,e1); } asm volatile("":"+v"(pw2)); SBAR();
    o[1]=__builtin_amdgcn_mfma_f32_32x32x16_bf16(__builtin_bit_cast(bf16x8,n2),vf1,o[1],0,0,0); vf1=VFL(1,3); asm volatile("":"+v"(p1)); { const float e0=__builtin_amdgcn_exp2f(p1[2]),e1=__builtin_amdgcn_exp2f(p1[3]); pw2[1]=cvtpk_s(e0,e1); } asm volatile("":"+v"(pw2)); SBAR();
    o[2]=__builtin_amdgcn_mfma_f32_32x32x16_bf16(__builtin_bit_cast(bf16x8,n2),vf2,o[2],0,0,0); vf2=VFL(2,3); asm volatile("":"+v"(p1)); { const float e0=__builtin_amdgcn_exp2f(p1[4]),e1=__builtin_amdgcn_exp2f(p1[5]); pw2[2]=cvtpk_s(e0,e1); } asm volatile("":"+v"(pw2)); SBAR();
    o[3]=__builtin_amdgcn_mfma_f32_32x32x16_bf16(__builtin_bit_cast(bf16x8,n2),vf3,o[3],0,0,0); vf3=VFL(3,3); asm volatile("":"+v"(p1)); { const float e0=__builtin_amdgcn_exp2f(p1[6]),e1=__builtin_amdgcn_exp2f(p1[7]); pw2[3]=cvtpk_s(e0,e1); } asm volatile("":"+v"(pw2)); SBAR();
    lacc=__builtin_amdgcn_mfma_f32_32x32x16_bf16(__builtin_bit_cast(bf16x8,n2),ones,lacc,0,0,0); SBAR();
    o[0]=__builtin_amdgcn_mfma_f32_32x32x16_bf16(__builtin_bit_cast(bf16x8,n3),vf0,o[0],0,0,0); asm volatile("":"+v"(p1)); { const float e0=__builtin_amdgcn_exp2f(p1[8]),e1=__builtin_amdgcn_exp2f(p1[9]); pw3[0]=cvtpk_s(e0,e1); } asm volatile("":"+v"(pw3)); SBAR();
    o[1]=__builtin_amdgcn_mfma_f32_32x32x16_bf16(__builtin_bit_cast(bf16x8,n3),vf1,o[1],0,0,0); asm volatile("":"+v"(p1)); { const float e0=__builtin_amdgcn_exp2f(p1[10]),e1=__builtin_amdgcn_exp2f(p1[11]); pw3[1]=cvtpk_s(e0,e1); } asm volatile("":"+v"(pw3)); SBAR();
    o[2]=__builtin_amdgcn_mfma_f32_32x32x16_bf16(__builtin_bit_cast(bf16x8,n3),vf2,o[2],0,0,0); asm volatile("":"+v"(p1)); { const float e0=__builtin_amdgcn_exp2f(p1[12]),e1=__builtin_amdgcn_exp2f(p1[13]); pw3[2]=cvtpk_s(e0,e1); } asm volatile("":"+v"(pw3)); SBAR();
    o[3]=__builtin_amdgcn_mfma_f32_32x32x16_bf16(__builtin_bit_cast(bf16x8,n3),vf3,o[3],0,0,0); asm volatile("":"+v"(p1)); { const float e0=__builtin_amdgcn_exp2f(p1[14]),e1=__builtin_amdgcn_exp2f(p1[15]); pw3[3]=cvtpk_s(e0,e1); } asm volatile("":"+v"(pw3)); SBAR();
    lacc=__builtin_amdgcn_mfma_f32_32x32x16_bf16(__builtin_bit_cast(bf16x8,n3),ones,lacc,0,0,0); SBAR();
    if(resc){ asm volatile("s_waitcnt lgkmcnt(0)":::"memory");
      #pragma unroll
      for(int d_=0;d_<4;++d_)
        #pragma unroll
        for(int r=0;r<16;++r)o[d_][r]*=wsf[crow(r,hi)];
      #pragma unroll
      for(int r=0;r<16;++r)lacc[r]*=wsf[crow(r,hi)];
      asm volatile("s_waitcnt lgkmcnt(0)":::"memory"); }
    vs=(vs==2)?0:vs+1;
     }
  }
  #undef VFL
  WAIT_BAR(0);
  float rli[16];
  #pragma unroll
  for(int r=0;r<16;++r)rli[r]=__builtin_amdgcn_rcpf(lacc[r]);
  bf16*Ow=O+(rowbase+q0+wid*QBLK)*OP;
  { int ln=lane; asm volatile("":"+v"(ln));
    const int r32e=ln&31,hie=ln>>5;
    bf16*stg=(bf16*)shm+wid*4096;
    bf16*sw=stg+4*hie*128+r32e;
    #pragma unroll
    for(int r=0;r<16;++r){
      #pragma unroll
      for(int d0=0;d0<4;++d0)sw[((r&3)+8*(r>>2))*128+d0*32]=__float2bfloat16(o[d0][r]*rli[r]);}
    asm volatile("s_waitcnt lgkmcnt(0)":::"memory");
    const bf16*sr=stg+(ln>>4)*128+(ln&15)*8; bf16*gw_=Ow+(long)(ln>>4)*OP+(ln&15)*8;
    #pragma unroll
    for(int i=0;i<8;++i){ const u32x4 v=*(const u32x4*)(sr+i*4*128); ATTN_STORE16(gw_+(long)i*4*OP,v);} }
  asm volatile("s_waitcnt lgkmcnt(0)\n\ts_barrier":::"memory");
  #undef DMA3_K
  #undef DMA3_V
}
template<class Sched,int THRL=8> __device__ __forceinline__ void attn_phase3(char*lds,const AttnTensors&T,const Sched&S){
  AttnUnit u;
  for(int i=0;S.next(i,u);++i){ const int b=u.bh>>4,hc=u.bh&15,h=hc>>1;
    attn_unit3<THRL>(b,u.qb,T.P+3072+hc*64,T.P+4096+hc*64,T.P+5120+h*128,T.O+hc*128,lds); }
}
#undef SBAR
#undef WAIT_BAR
}
namespace cg = cooperative_groups;
constexpr int NWAVES = 8;
constexpr int BATCH = 4, SEQ = 8192, DMODEL = 2048, FFN = 5632, INC = 6144;
constexpr int M = BATCH * SEQ;
constexpr float RMS_EPS = 1e-6f;
constexpr size_t MiB = 1u << 20;
constexpr size_t WS_WGU1 = 2 * MiB, WS_WD1 = 46 * MiB, WS_WIN = 68 * MiB, WS_WOUT = 92 * MiB, WS_WGU2 = 100 * MiB, WS_WD2 = 144 * MiB;
constexpr size_t WS_XN = 168 * MiB, WS_O = 296 * MiB, WS_H = 424 * MiB, WS_Y = 808 * MiB, WS_END = 936 * MiB;
constexpr int LDS_BYTES = 147456 + 1024;
constexpr int MISC_OFF = 147456;
constexpr size_t WS_CTL = 0, CTL_ZERO_BYTES = 640 * 1024;
constexpr size_t WS_CNT = 64 * 1024, WS_SSQ3 = 512 * 1024;
constexpr size_t WS_SSQ0 = 128 * 1024, WS_SSQ1 = 256 * 1024, WS_SSQ2 = 384 * 1024;
constexpr int CW_BAR = 1024;
#ifndef REP_ATTN
#define REP_ATTN 1
#endif
#ifndef REP_LIGHT
#define REP_LIGHT 1
#endif
#ifndef REP_P0
#define REP_P0 1
#endif

#define GAS __attribute__((address_space(1)))
#define LAS __attribute__((address_space(3)))
typedef unsigned short bf16;
typedef unsigned v4u __attribute__((ext_vector_type(4)));
typedef float f32x4 __attribute__((ext_vector_type(4)));
#define LDS_WAIT() asm volatile("s_waitcnt lgkmcnt(0)" ::: "memory")
__device__ __forceinline__ unsigned f2bf(float f) { unsigned u = __builtin_bit_cast(unsigned, f); return (u + 0x7fffu + ((u >> 16) & 1u)) >> 16; }
__device__ __forceinline__ unsigned pk2(float lo, float hi) { return f2bf(lo) | (f2bf(hi) << 16); }
__device__ __forceinline__ float bflo(unsigned w) { return __uint_as_float(w << 16); }
__device__ __forceinline__ float bfhi(unsigned w) { return __uint_as_float(w & 0xffff0000u); }
__device__ __forceinline__ float wave_sum(float v) {
#pragma unroll
    for (int o = 1; o < 64; o <<= 1) v += __shfl_xor(v, o);
    return v;
}
__device__ __forceinline__ void p0_transpose_item(const float* W, int K, int N, bf16* WT, int mode, LAS float* scr, int item, int lane, const float* g = nullptr) {
    const int nblk = N / 32, kb = item / nblk, nb = item % nblk, k0 = 64 * kb, n0 = 32 * nb;
    const int drow0 = (mode == 0) ? n0 : (256 * (n0 >> 7) + (n0 & 127) + (mode == 2 ? 128 : 0));
#pragma unroll 8
    for (int i = 0; i < 32; ++i) { const int kk = 2 * i + (lane >> 5); const float gk = g ? g[k0 + kk] : 1.0f; scr[kk * 33 + (lane & 31)] = W[(size_t)(k0 + kk) * N + n0 + (lane & 31)] * gk; }
    LDS_WAIT(); asm volatile("" ::: "memory");
    const int c = lane & 7;
#pragma unroll
    for (int j = 0; j < 4; ++j) { const int n = (lane >> 3) + 8 * j; const LAS float* s = scr + (8 * c) * 33 + n;
        v4u o; o.x = pk2(s[0 * 33], s[1 * 33]); o.y = pk2(s[2 * 33], s[3 * 33]); o.z = pk2(s[4 * 33], s[5 * 33]); o.w = pk2(s[6 * 33], s[7 * 33]);
        *(GAS v4u*)(WT + (size_t)(drow0 + n) * K + k0 + 8 * c) = o; }
    LDS_WAIT(); asm volatile("" ::: "memory");
}
__device__ __forceinline__ void rms_row_to_bf16(const float* xrow, const float* g, bf16* orow, float* ssq_row, int lane) {
    const GAS f32x4* xr = (const GAS f32x4*)xrow + lane; (void)g;
    f32x4 v[8]; float s = 0.f;
#pragma unroll
    for (int j = 0; j < 8; ++j) { v[j] = xr[64 * j]; s += (v[j].x * v[j].x + v[j].y * v[j].y) + (v[j].z * v[j].z + v[j].w * v[j].w); }
    s = wave_sum(s); if (lane == 0) *ssq_row = s;
    GAS unsigned long long* o8 = (GAS unsigned long long*)orow + lane;
#pragma unroll
    for (int j = 0; j < 8; ++j) { const f32x4 y = v[j];
        o8[64 * j] = (unsigned long long)pk2(y.x, y.y) | ((unsigned long long)pk2(y.z, y.w) << 32); }
}
__device__ __forceinline__ void rms_row_f32(const float* xrow, const float* g, float* orow, int lane) {
    const GAS f32x4* xr = (const GAS f32x4*)xrow + lane; const GAS f32x4* gr = (const GAS f32x4*)g + lane;
    f32x4 v[8]; float s = 0.f;
#pragma unroll
    for (int j = 0; j < 8; ++j) { v[j] = xr[64 * j]; s += (v[j].x * v[j].x + v[j].y * v[j].y) + (v[j].z * v[j].z + v[j].w * v[j].w); }
    const float rstd = 1.0f / sqrtf(wave_sum(s) * (1.f / DMODEL) + RMS_EPS);
    GAS f32x4* o = (GAS f32x4*)orow + lane;
#pragma unroll
    for (int j = 0; j < 8; ++j) { const f32x4 gv = gr[64 * j]; o[64 * j] = v[j] * rstd * gv; }
}
__device__ __forceinline__ void mix_row(const bf16* P, const bf16* O, bf16* Y, const float* convw, const float* subln, float lam, int m, int lane) {
    const int t = m & (SEQ - 1);
    const bf16* pr = P + (size_t)m * INC; bf16* yr = Y + (size_t)m * DMODEL;
#pragma unroll
    for (int i = 0; i < 2; ++i) {
        const int j = lane * 8 + 512 * i;
        const v4u bq = *(const GAS v4u*)(pr + j), c0 = *(const GAS v4u*)(pr + 1024 + j), x0 = *(const GAS v4u*)(pr + 2048 + j);
        v4u c1 = (v4u){0u, 0u, 0u, 0u}, x1 = c1, c2 = c1, x2 = c1;
        if (t >= 1) { c1 = *(const GAS v4u*)(pr - INC + 1024 + j); x1 = *(const GAS v4u*)(pr - INC + 2048 + j); }
        if (t >= 2) { c2 = *(const GAS v4u*)(pr - 2 * INC + 1024 + j); x2 = *(const GAS v4u*)(pr - 2 * INC + 2048 + j); }
        const f32x4 wa0 = *(const GAS f32x4*)(convw + j), wa1 = *(const GAS f32x4*)(convw + j + 4);
        const f32x4 wb0 = *(const GAS f32x4*)(convw + 1024 + j), wb1 = *(const GAS f32x4*)(convw + 1024 + j + 4);
        const f32x4 wc0 = *(const GAS f32x4*)(convw + 2048 + j), wc1 = *(const GAS f32x4*)(convw + 2048 + j + 4);
        v4u o;
#define MIXPAIR(q, WA, WB, WC, e0, e1) pk2( \
            bflo(bq[q]) * (WA[e0] * (bflo(c2[q]) * bflo(x2[q])) + WB[e0] * (bflo(c1[q]) * bflo(x1[q])) + WC[e0] * (bflo(c0[q]) * bflo(x0[q]))), \
            bfhi(bq[q]) * (WA[e1] * (bfhi(c2[q]) * bfhi(x2[q])) + WB[e1] * (bfhi(c1[q]) * bfhi(x1[q])) + WC[e1] * (bfhi(c0[q]) * bfhi(x0[q]))))
        o.x = MIXPAIR(0, wa0, wb0, wc0, 0, 1); o.y = MIXPAIR(1, wa0, wb0, wc0, 2, 3); o.z = MIXPAIR(2, wa1, wb1, wc1, 0, 1); o.w = MIXPAIR(3, wa1, wb1, wc1, 2, 3);
#undef MIXPAIR
        *(GAS v4u*)(yr + j) = o;
    }
    {
        const int h = lane >> 3, d0 = (lane & 7) * 16;
        const bf16* o1p = O + (size_t)m * DMODEL + h * 256 + d0; const bf16* o2p = o1p + 128;
        const v4u a0 = *(const GAS v4u*)o1p, a1 = *(const GAS v4u*)(o1p + 8), b0 = *(const GAS v4u*)o2p, b1 = *(const GAS v4u*)(o2p + 8);
        float o[16]; float ss = 0.f;
#pragma unroll
        for (int q = 0; q < 4; ++q) { o[2 * q] = bflo(a0[q]) - lam * bflo(b0[q]); o[2 * q + 1] = bfhi(a0[q]) - lam * bfhi(b0[q]);
            o[8 + 2 * q] = bflo(a1[q]) - lam * bflo(b1[q]); o[8 + 2 * q + 1] = bfhi(a1[q]) - lam * bfhi(b1[q]); }
#pragma unroll
        for (int e = 0; e < 16; ++e) ss += o[e] * o[e];
        ss += __shfl_xor(ss, 1); ss += __shfl_xor(ss, 2); ss += __shfl_xor(ss, 4);
        const float rs = 0.8f / sqrtf(ss * (1.f / 128.f) + RMS_EPS);
        const f32x4 g0 = *(const GAS f32x4*)(subln + d0), g1 = *(const GAS f32x4*)(subln + d0 + 4), g2 = *(const GAS f32x4*)(subln + d0 + 8), g3 = *(const GAS f32x4*)(subln + d0 + 12);
        v4u w0, w1;
        w0.x = pk2(o[0] * rs * g0[0], o[1] * rs * g0[1]); w0.y = pk2(o[2] * rs * g0[2], o[3] * rs * g0[3]); w0.z = pk2(o[4] * rs * g1[0], o[5] * rs * g1[1]); w0.w = pk2(o[6] * rs * g1[2], o[7] * rs * g1[3]);
        w1.x = pk2(o[8] * rs * g2[0], o[9] * rs * g2[1]); w1.y = pk2(o[10] * rs * g2[2], o[11] * rs * g2[3]); w1.z = pk2(o[12] * rs * g3[0], o[13] * rs * g3[1]); w1.w = pk2(o[14] * rs * g3[2], o[15] * rs * g3[3]);
        bf16* yo = yr + 1024 + h * 128 + d0;
        *(GAS v4u*)yo = w0; *(GAS v4u*)(yo + 8) = w1;
    }
}

#define XB_TMO      128
#define XB_XCNT(j)  (256  + 64 * (j))
#define XB_XSUB(j)  (1280 + 64 * (j))
#define XB_XGEN(j)  (2304 + 64 * (j))
#define XB_TOP      3328
#define XB_TOPGEN   3392
#define XCD_BAR_WORDS 3456
#define XB_SPIN_CAP (1u << 18)

__device__ __forceinline__ unsigned xb_ld(unsigned* p)              { return __hip_atomic_load(p, __ATOMIC_RELAXED, __HIP_MEMORY_SCOPE_AGENT); }
__device__ __forceinline__ unsigned xb_add(unsigned* p, unsigned v) { return __hip_atomic_fetch_add(p, v, __ATOMIC_RELAXED, __HIP_MEMORY_SCOPE_AGENT); }
__device__ __forceinline__ unsigned xb_xcc_id() { return (unsigned)__builtin_amdgcn_s_getreg((3 << 11) | 20) & 0xFu; }
#define XB_SPIN(cond, bar) do { unsigned _sp = 0; while (cond) { __builtin_amdgcn_s_sleep(1); \
    if ((++_sp & 255u) == 0u) { if (xb_ld(&(bar)[XB_TMO])) break; if (_sp > XB_SPIN_CAP) { atomicAdd(&(bar)[XB_TMO], 1u); break; } } } } while (0)

struct XcdBarrier {
    unsigned* bar; unsigned x;
    volatile LAS unsigned* st;
};

__device__ __forceinline__ XcdBarrier xcd_barrier_post(unsigned* bar, volatile LAS unsigned* st) {
    XcdBarrier b; b.bar = bar; b.x = xb_xcc_id(); b.st = st;
    if (threadIdx.x == 0) (void)xb_add(&bar[XB_XCNT(b.x)], 1u);
    return b;
}
__device__ __forceinline__ void xcd_barrier_complete(unsigned* bar, unsigned x, unsigned& nloc, unsigned& nx) {
    const unsigned G = gridDim.x * gridDim.y * gridDim.z;
    unsigned sum, cnt, mine, sp = 0u;
    for (;;) {
        sum = 0u; cnt = 0u; mine = 0u;
#pragma unroll
        for (unsigned j = 0; j < 16; ++j) { const unsigned c = xb_ld(&bar[XB_XCNT(j)]); sum += c; cnt += (c > 0u) ? 1u : 0u; mine = (j == x) ? c : mine; }
        if (sum == G) break;
        __builtin_amdgcn_s_sleep(1);
        if ((++sp & 255u) == 0u) { if (xb_ld(&bar[XB_TMO])) break; if (sp > XB_SPIN_CAP) { atomicAdd(&bar[XB_TMO], 1u); break; } }
    }
    nloc = mine > 0u ? mine : 1u; nx = cnt > 0u ? cnt : 1u;
}

__device__ __forceinline__ void xcd_barrier(const XcdBarrier& b) {
    asm volatile("s_waitcnt vmcnt(0)" ::: "memory");
    __syncthreads();
    if (threadIdx.x == 0) {
        unsigned* bar = b.bar;
        __builtin_amdgcn_s_waitcnt(0);
        unsigned nloc = b.st[0], nx = b.st[1];
        if (nloc == 0u) { xcd_barrier_complete(bar, b.x, nloc, nx); b.st[0] = nloc; b.st[1] = nx; }
        const unsigned old = xb_add(&bar[XB_XSUB(b.x)], 1u);
        const unsigned gen = old / nloc;
        if (old + 1u == (gen + 1u) * nloc) {
            __builtin_amdgcn_fence(__ATOMIC_RELEASE, "agent");
            asm volatile("s_waitcnt vmcnt(0)" ::: "memory");
            const unsigned og = xb_add(&bar[XB_TOP], 1u);
            const unsigned tg = og / nx;
            if (og + 1u == (tg + 1u) * nx) xb_add(&bar[XB_TOPGEN], 1u);
            else XB_SPIN(xb_ld(&bar[XB_TOPGEN]) == tg, bar);
            __builtin_amdgcn_fence(__ATOMIC_ACQUIRE, "agent");
            xb_add(&bar[XB_XGEN(b.x)], 1u);
            asm volatile("s_waitcnt vmcnt(0)" ::: "memory");
        } else {
            XB_SPIN(xb_ld(&bar[XB_XGEN(b.x)]) == gen, bar);
            __builtin_amdgcn_fence(__ATOMIC_ACQUIRE, "agent");
            asm volatile("s_waitcnt vmcnt(0)" ::: "memory");
        }
    }
    __syncthreads();
}

struct Args { const float* in[19]; float* out; unsigned char* ws; };
__global__ void __launch_bounds__(NWAVES * 64, 2) mega_fwd(Args args) {
    extern __shared__ __attribute__((aligned(16))) unsigned char lds[];
    cg::grid_group grid = cg::this_grid();
    LAS unsigned char* ldsp = (LAS unsigned char*)lds;
    const int tid = threadIdx.x, wave = __builtin_amdgcn_readfirstlane(tid >> 6);
    const int G = gridDim.x, bx = blockIdx.x;
    const int vcu = (G % 8 == 0) ? (bx % 8) * (G / 8) + bx / 8 : bx;
    const int gw = vcu * NWAVES + wave, NGW = G * NWAVES;
    for (int u = tid; u < (LDS_BYTES - MISC_OFF) / 4; u += NWAVES * 64) ((LAS unsigned*)(ldsp + MISC_OFF))[u] = 0u;
    __syncthreads();
    const XcdBarrier bar = xcd_barrier_post((unsigned*)(args.ws + WS_CTL) + CW_BAR, (volatile LAS unsigned*)(ldsp + MISC_OFF) + 8);
    typedef const Args __attribute__((address_space(4)))* kargp_t;
#define KARG(field) ({ kargp_t _ka = (kargp_t)__builtin_amdgcn_kernarg_segment_ptr(); asm volatile("" : "+s"(_ka)); _ka->field; })
#define IN(i) KARG(in[i])
#define WSP(off) (KARG(ws) + (off))
#define WGU1 ((bf16*)WSP(WS_WGU1))
#define WD1 ((bf16*)WSP(WS_WD1))
#define WIN ((bf16*)WSP(WS_WIN))
#define WOUT ((bf16*)WSP(WS_WOUT))
#define WGU2 ((bf16*)WSP(WS_WGU2))
#define WD2 ((bf16*)WSP(WS_WD2))
#define XN ((bf16*)WSP(WS_XN))
#define OB ((bf16*)WSP(WS_O))
#define HB ((bf16*)WSP(WS_H))
#define PROJ HB
#define YB ((bf16*)WSP(WS_Y))

#define FRESH_LANE() ({ int _l = threadIdx.x & 63; asm volatile("" : "+v"(_l)); _l; })
    for (int rep = 0; rep < REP_P0; ++rep) {
        const int lane = FRESH_LANE();
        LAS float* scr = (LAS float*)(ldsp + wave * 16384);
        constexpr int I_G = (DMODEL / 64) * (FFN / 32), I_D = (FFN / 64) * (DMODEL / 32), I_IN = (DMODEL / 64) * (INC / 32), I_O = (DMODEL / 64) * (DMODEL / 32);
        constexpr int NITEMS = 4 * I_G + 2 * I_D + I_IN + I_O;
        for (int it = gw; it < NITEMS; it += NGW) {
            int r = it;
            if (r < I_G) { p0_transpose_item(IN(2), DMODEL, FFN, WGU1, 1, scr, r, lane, IN(1)); continue; } r -= I_G;
            if (r < I_G) { p0_transpose_item(IN(3), DMODEL, FFN, WGU1, 2, scr, r, lane, IN(1)); continue; } r -= I_G;
            if (r < I_D) { p0_transpose_item(IN(4), FFN, DMODEL, WD1, 0, scr, r, lane); continue; } r -= I_D;
            if (r < I_IN) { p0_transpose_item(IN(6), DMODEL, INC, WIN, 0, scr, r, lane, IN(5)); continue; } r -= I_IN;
            if (r < I_O) { p0_transpose_item(IN(13), DMODEL, DMODEL, WOUT, 0, scr, r, lane); continue; } r -= I_O;
            if (r < I_G) { p0_transpose_item(IN(15), DMODEL, FFN, WGU2, 1, scr, r, lane, IN(14)); continue; } r -= I_G;
            if (r < I_G) { p0_transpose_item(IN(16), DMODEL, FFN, WGU2, 2, scr, r, lane, IN(14)); continue; } r -= I_G;
            p0_transpose_item(IN(17), FFN, DMODEL, WD2, 0, scr, r, lane);
        }
        { const float* xi = IN(0); const float* gn = IN(1); bf16* xn = XN; float* sq = (float*)WSP(WS_SSQ0); for (int m = gw; m < M; m += NGW) rms_row_to_bf16(xi + (size_t)m * DMODEL, gn, xn + (size_t)m * DMODEL, sq + m, lane); }
    }
    grid.sync();
    {
        pg8::Gemm g{XN, WGU1, M, 2 * FFN, DMODEL}; pg8::StaticOrder S; S.init(M, 2 * FFN, G, bx);
        pg8::EpiSwiGLU E{HB, FFN, (const float*)WSP(WS_SSQ0)};
        pg8::gemm_phase<pg8::EpiSwiGLU, pg8::StaticOrder, PG8_ALIGN, PG8_SP2>(ldsp, g, S, E);
    }
    xcd_barrier(bar);
    {
        pg8::Gemm g{HB, WD1, M, DMODEL, FFN}; pg8::StaticOrderW<4> S; S.init(M, DMODEL, G, bx);
        pg8::EpiRes<0> E{IN(0), XN, DMODEL, 0.5f, (float*)WSP(WS_SSQ1)};
        pg8::gemm_phase<pg8::EpiRes<0>, pg8::StaticOrderW<4>, PG8_ALIGN, PG8_SP2>(ldsp, g, S, E);
    }
    xcd_barrier(bar);
    {
        pg8::Gemm g{XN, WIN, M, INC, DMODEL}; pg8::StaticOrder S; S.init(M, INC, G, bx);
        pg8::EpiProj E{PROJ, INC, 3072, 4096, attn_body::C2, (const float*)WSP(WS_SSQ1)};
        pg8::gemm_phase<pg8::EpiProj, pg8::StaticOrder, PG8_ALIGN, PG8_SP2>(ldsp, g, S, E);
    }
    xcd_barrier(bar);
    {
        const attn_body::AttnTensors AT{(const attn_body::bf16*)PROJ, (attn_body::bf16*)OB};
        static_assert(attn_body::LDS3_BYTES <= MISC_OFF, "attention LDS");
        const attn_body::StaticOrder2 S(G, bx);
        attn_body::attn_phase3<attn_body::StaticOrder2>((char*)lds, AT, S);
    }
    xcd_barrier(bar);
    for (int rep = 0; rep < REP_LIGHT; ++rep) {
        const int lane = FRESH_LANE();
        const float s1 = wave_sum(IN(8)[lane] * IN(9)[lane]), s2 = wave_sum(IN(10)[lane] * IN(11)[lane]);
        const float lam = expf(s1) - expf(s2) + 0.2f;
        const bf16* pj = PROJ; const bf16* ob = OB; bf16* yb = YB; const float* cw = IN(7); const float* sl = IN(12);
        for (int m = gw; m < M; m += NGW) mix_row(pj, ob, yb, cw, sl, lam, m, lane);
    }
    xcd_barrier(bar);
    {
        pg8::Gemm g{YB, WOUT, M, DMODEL, DMODEL}; pg8::StaticOrderW<4> S; S.init(M, DMODEL, G, bx);
        pg8::EpiRes<1> E{XN, OB, DMODEL, 1.0f, (float*)WSP(WS_SSQ2)};
        pg8::gemm_phase<pg8::EpiRes<1>, pg8::StaticOrderW<4>, PG8_ALIGN, PG8_SP2>(ldsp, g, S, E);
    }
    xcd_barrier(bar);
    {
        pg8::Gemm g{OB, WGU2, M, 2 * FFN, DMODEL}; pg8::StaticOrder S; S.init(M, 2 * FFN, G, bx);
        pg8::EpiSwiGLU E{HB, FFN, (const float*)WSP(WS_SSQ2)};
        pg8::gemm_phase<pg8::EpiSwiGLU, pg8::StaticOrder, PG8_ALIGN, PG8_SP2>(ldsp, g, S, E);
    }
    xcd_barrier(bar);
    {
        pg8::Gemm g{HB, WD2, M, DMODEL, FFN}; pg8::StaticOrderW<4> S; S.init(M, DMODEL, G, bx);
        float* outp = KARG(out); pg8::EpiRes<3> E{OB, outp, DMODEL, 0.5f, (float*)WSP(WS_SSQ3), (unsigned*)WSP(WS_CNT), IN(18)};
        pg8::gemm_phase<pg8::EpiRes<3>, pg8::StaticOrderW<4>, PG8_ALIGN, PG8_SP2>(ldsp, g, S, E);
    }
}

#undef KARG
#undef FRESH_LANE
#undef IN
#undef WSP
#undef WGU1
#undef WD1
#undef WIN
#undef WOUT
#undef WGU2
#undef WD2
#undef XN
#undef OB
#undef HB
#undef PROJ
#undef YB
extern "C" void kernel_launch(void* const* d_in, const int* in_sizes, int n_in, void* d_out, int out_size, void* d_ws, size_t ws_size, hipStream_t stream) {
    static int grid = 0;
    if (grid == 0) {
        if (n_in != 19 || in_sizes[0] != M * DMODEL || out_size != M * DMODEL || ws_size < WS_END) { fprintf(stderr, "kernel_launch: unexpected shapes (n_in %d, in0 %d, out %d, ws %zu); nothing launched\n", n_in, n_in > 0 ? in_sizes[0] : -1, out_size, ws_size); grid = -1; return; }
        int dev = 0, cus = 0, per_cu = 0;
        if (hipGetDevice(&dev) != hipSuccess || hipDeviceGetAttribute(&cus, hipDeviceAttributeMultiprocessorCount, dev) != hipSuccess) { grid = -1; return; }
        if (hipFuncSetAttribute((const void*)mega_fwd, hipFuncAttributeMaxDynamicSharedMemorySize, LDS_BYTES) != hipSuccess) { fprintf(stderr, "kernel_launch: hipFuncSetAttribute failed\n"); grid = -1; return; }
        if (hipOccupancyMaxActiveBlocksPerMultiprocessor(&per_cu, (const void*)mega_fwd, NWAVES * 64, LDS_BYTES) != hipSuccess) per_cu = 0;
        (void)hipGetLastError();
        if (cus * per_cu < 256) { fprintf(stderr, "kernel_launch: resident capacity %d x %d < 256 workgroups; nothing launched\n", cus, per_cu); grid = -1; return; }
        grid = 256;
    }
    if (grid < 0) return;
    if (hipMemsetAsync((char*)d_ws + WS_CTL, 0, CTL_ZERO_BYTES, stream) != hipSuccess) { fprintf(stderr, "kernel_launch: hipMemsetAsync failed\n"); return; }
    Args a{};
    for (int i = 0; i < 19; ++i) a.in[i] = (const float*)d_in[i];
    a.out = (float*)d_out; a.ws = (unsigned char*)d_ws;
    void* kargs[] = {&a};
    const hipError_t le = hipLaunchCooperativeKernel((const void*)mega_fwd, dim3(grid), dim3(NWAVES * 64), kargs, LDS_BYTES, stream);
    if (le != hipSuccess) fprintf(stderr, "kernel_launch: cooperative launch failed: %s\n", hipGetErrorName(le));
}
```

```cpp
#include <hip/hip_runtime.h>
#include <hip/hip_cooperative_groups.h>
#include <cstdio>
#include <cstdint>

namespace pg8 {
#define PG8_LAS __attribute__((address_space(3)))
typedef unsigned short bf16_t;
typedef short bf16x8 __attribute__((ext_vector_type(8)));
typedef float f32x4 __attribute__((ext_vector_type(4)));
typedef unsigned u32x4 __attribute__((ext_vector_type(4)));
constexpr int BM = 256, BK = 64, HALF = 128, HTB = HALF * BK * 2  , STAGE_BYTES = 8 * HTB, NXCD = 8, WGM = 8;

__host__ __device__ __forceinline__ int lds_byte(int r, int c) { const int st = (r >> 4) * 2 + (c >> 5), rr = r & 15, cc = c & 31, ob = rr * 64 + cc * 2; return st * 1024 + (ob ^ (((ob >> 9) & 1) << 5)); }
__host__ __device__ __forceinline__ void stage_rc(int b, int& R, int& C) { const int st = b / 1024, sb = b % 1024, swz = sb ^ (((sb >> 9) & 1) << 5); R = (st >> 1) * 16 + swz / 64; C = (st & 1) * 32 + (swz % 64) / 2; }
__host__ __device__ __forceinline__ int perm32(int rho) { const int n = rho >> 4, i = rho & 15; return 8 * (i >> 2) + 4 * n + (i & 3); }

struct Unit { int pm, pn, par; };
struct Gemm { const bf16_t* A; const bf16_t* Bt; int M, N, K; };

struct StaticOrder {
    int nM, nN, nwg, G, c;
    __host__ __device__ void init(int M, int N, int G_, int c_) { nM = M / BM; nN = N / BM; nwg = nM * nN; G = G_; c = c_; }
    __host__ __device__ bool next(int i, Unit& u) const {
        const long L = (long)i * G + c; if (L >= nwg) return false;
        int wgid = (int)L; { const int q = nwg / NXCD, r = nwg % NXCD, xcd = wgid % NXCD, off = wgid / NXCD; wgid = (xcd < r ? xcd * (q + 1) : r * (q + 1) + (xcd - r) * q) + off; }
        const int nig = WGM * nN, gid = wgid / nig, fm = gid * WGM, gsz = (nM - fm) < WGM ? (nM - fm) : WGM;
        u.pm = fm + ((wgid % nig) % gsz); u.pn = (wgid % nig) / gsz; return true;
    }
    __device__ __forceinline__ void a_ready(const Unit&) const {}
    __device__ __forceinline__ void done(const Unit&) const {}
};

__device__ __forceinline__ unsigned cvt_pk_bf16(float lo, float hi) { unsigned r; asm volatile("v_cvt_pk_bf16_f32 %0, %1, %2" : "=v"(r) : "v"(lo), "v"(hi)); return r; }
typedef float f32x2 __attribute__((ext_vector_type(2)));
__device__ __forceinline__ f32x2 gelu_pk(f32x2 v) {
    const f32x2 av = __builtin_elementwise_abs(v), d = av * 0.2316418882f + 1.0f;
    f32x2 t; t.x = __builtin_amdgcn_rcpf(d.x); t.y = __builtin_amdgcn_rcpf(d.y);
    f32x2 q = t * 0.5307027145f + (-0.7265760135f); q = q * t + 0.7107068705f; q = q * t + (-0.142248368f); q = q * t + 0.127414796f; q = q * t;
    const f32x2 s = (v * v) * (-0.72134752044f);
    f32x2 e; e.x = __builtin_amdgcn_exp2f(s.x); e.y = __builtin_amdgcn_exp2f(s.y);
    const f32x2 m = v * (q * e), r = v - m;
    f32x2 o; o.x = v.x < 0.f ? m.x : r.x; o.y = v.y < 0.f ? m.y : r.y; return o;
}

template <int ACT  > struct EpiBf16 {
    static constexpr bool PERM = true, AFTER_DRAIN = false; static_assert(ACT == 0 || ACT == 1, "EpiBf16: ACT is 0 (none) or 1 (gelu_pk)");
    bf16_t* O; int ldc; const float* bias; int split_cols; size_t split_stride; float scale0;
    __device__ __forceinline__ void operator()(const f32x4 (&acc)[2][2][4][2], const Unit& u, int wr, int wc, int fr, int fq) const {
        const int row0 = u.pm * BM + wr * 64 + fr; int colt = u.pn * BM; bf16_t* base = O;
        float sc = 1.f; if (split_cols) { const int t = colt / split_cols; base += (size_t)t * split_stride; colt -= t * split_cols; if (t == 0) sc = scale0; }
        const int col0 = colt + wc * 32 + 8 * fq, bcol0 = u.pn * BM + wc * 32 + 8 * fq;
        f32x4 bv[2][2];
#pragma unroll
        for (int bj = 0; bj < 2; ++bj)
#pragma unroll
            for (int n = 0; n < 2; ++n) bv[bj][n] = bias ? *(const f32x4*)(bias + bcol0 + bj * HALF + 4 * n) : (f32x4){0.f, 0.f, 0.f, 0.f};
#pragma unroll
        for (int ai = 0; ai < 2; ++ai)
#pragma unroll
            for (int m = 0; m < 4; ++m) { bf16_t* rowp = base + (size_t)(row0 + ai * HALF + m * 16) * ldc + col0;
#pragma unroll
                for (int bj = 0; bj < 2; ++bj) { f32x4 v0 = acc[ai][bj][m][0] + bv[bj][0], v1 = acc[ai][bj][m][1] + bv[bj][1];
                    if (ACT == 1) { f32x2 a = gelu_pk((f32x2){v0[0], v0[1]}), b = gelu_pk((f32x2){v0[2], v0[3]}), c = gelu_pk((f32x2){v1[0], v1[1]}), d = gelu_pk((f32x2){v1[2], v1[3]});
                        v0 = (f32x4){a.x, a.y, b.x, b.y}; v1 = (f32x4){c.x, c.y, d.x, d.y}; }
                    v0 = v0 * sc; v1 = v1 * sc; u32x4 w; w.x = cvt_pk_bf16(v0[0], v0[1]); w.y = cvt_pk_bf16(v0[2], v0[3]); w.z = cvt_pk_bf16(v1[0], v1[1]); w.w = cvt_pk_bf16(v1[2], v1[3]);
                    *(u32x4*)(rowp + bj * HALF) = w; } }
    }
};
template <int W> struct StaticOrderW : StaticOrder {
    __host__ __device__ bool next(int i, Unit& u) const {
        const long L = (long)i * G + c; if (L >= nwg) return false;
        int wgid = (int)L; { const int q = nwg / NXCD, r = nwg % NXCD, xcd = wgid % NXCD, off = wgid / NXCD; wgid = (xcd < r ? xcd * (q + 1) : r * (q + 1) + (xcd - r) * q) + off; }
        const int nig = W * nN, gid = wgid / nig, fm = gid * W, gsz = (nM - fm) < W ? (nM - fm) : W;
        u.pm = fm + ((wgid % nig) % gsz); u.pn = (wgid % nig) / gsz; return true;
    }
};
struct EpiSwiGLU {
    static constexpr bool PERM = true, AFTER_DRAIN = false;
    bf16_t* O; int ldc; const float* ssq;
    typedef float f32x2 __attribute__((ext_vector_type(2)));
    __device__ __forceinline__ static unsigned sg2(f32x2 g, f32x2 up, float c, float rs2) {
        const f32x2 m = g * c; f32x2 e; e.x = __builtin_amdgcn_exp2f(m.x); e.y = __builtin_amdgcn_exp2f(m.y);
        const f32x2 d = e + 1.0f; f32x2 r; r.x = __builtin_amdgcn_rcpf(d.x); r.y = __builtin_amdgcn_rcpf(d.y);
        const f32x2 h = (g * up) * rs2 * r; return cvt_pk_bf16(h.x, h.y); }
    __device__ __forceinline__ void operator()(const f32x4 (&acc)[2][2][4][2], const Unit& u, int wr, int wc, int fr, int fq) const {
        const int row0 = u.pm * BM + wr * 64 + fr, col0 = u.pn * HALF + wc * 32 + 8 * fq;
        float rsv[2][4];
#pragma unroll
        for (int ai = 0; ai < 2; ++ai)
#pragma unroll
            for (int m = 0; m < 4; ++m) rsv[ai][m] = ssq[row0 + ai * HALF + m * 16];
        asm volatile("" ::: "memory");
#pragma unroll
        for (int ai = 0; ai < 2; ++ai)
#pragma unroll
            for (int m = 0; m < 4; ++m) {
                bf16_t* rowp = O + (size_t)(row0 + ai * HALF + m * 16) * ldc + col0;
                const float rs = __builtin_amdgcn_rsqf(rsv[ai][m] * (1.0f / 2048.0f) + 1e-6f), c = -1.4426950408889634f * rs, rs2 = rs * rs;
                const f32x4 g0 = acc[ai][0][m][0], g1 = acc[ai][0][m][1], u0 = acc[ai][1][m][0], u1 = acc[ai][1][m][1];
                u32x4 w; w.x = sg2((f32x2){g0[0], g0[1]}, (f32x2){u0[0], u0[1]}, c, rs2); w.y = sg2((f32x2){g0[2], g0[3]}, (f32x2){u0[2], u0[3]}, c, rs2);
                w.z = sg2((f32x2){g1[0], g1[1]}, (f32x2){u1[0], u1[1]}, c, rs2); w.w = sg2((f32x2){g1[2], g1[3]}, (f32x2){u1[2], u1[3]}, c, rs2);
                *(u32x4*)rowp = w; }
    }
};
template <int MODE> struct EpiRes {
    static constexpr bool PERM = true, AFTER_DRAIN = false;
    const void* base; void* out; int ldc; float s; float* ssq; unsigned* cnt; const float* gain;
    __device__ __forceinline__ static f32x4 lo4(unsigned a, unsigned b) { return (f32x4){__uint_as_float(a << 16), __uint_as_float(a & 0xffff0000u), __uint_as_float(b << 16), __uint_as_float(b & 0xffff0000u)}; }
    __device__ __forceinline__ void operator()(const f32x4 (&acc)[2][2][4][2], const Unit& u, int wr, int wc, int fr, int fq) const {
        const int col0 = u.pn * BM + wc * 32 + 8 * fq;
        if constexpr (MODE == 0) {
            const float* bs = (const float*)base; bf16_t* o = (bf16_t*)out;
#pragma unroll
            for (int ai = 0; ai < 2; ++ai) {
                f32x4 pre[4][2][2];
#pragma unroll
                for (int m = 0; m < 4; ++m) { const size_t off = (size_t)(u.pm * BM + ai * HALF + wr * 64 + m * 16 + fr) * ldc + col0;
#pragma unroll
                    for (int bj = 0; bj < 2; ++bj) { pre[m][bj][0] = *(const f32x4*)(bs + off + bj * HALF); pre[m][bj][1] = *(const f32x4*)(bs + off + bj * HALF + 4); } }
                asm volatile("" ::: "memory");
#pragma unroll
                for (int m = 0; m < 4; ++m) { const int row = u.pm * BM + ai * HALF + wr * 64 + m * 16 + fr; const size_t off = (size_t)row * ldc + col0; float ss = 0.f;
#pragma unroll
                    for (int bj = 0; bj < 2; ++bj) { const f32x4 v0 = pre[m][bj][0] + acc[ai][bj][m][0] * s, v1 = pre[m][bj][1] + acc[ai][bj][m][1] * s;
                        ss += (v0[0] * v0[0] + v0[1] * v0[1]) + (v0[2] * v0[2] + v0[3] * v0[3]) + (v1[0] * v1[0] + v1[1] * v1[1]) + (v1[2] * v1[2] + v1[3] * v1[3]);
                        u32x4 w; w.x = cvt_pk_bf16(v0[0], v0[1]); w.y = cvt_pk_bf16(v0[2], v0[3]); w.z = cvt_pk_bf16(v1[0], v1[1]); w.w = cvt_pk_bf16(v1[2], v1[3]);
                        *(u32x4*)(o + off + bj * HALF) = w; }
                    ss += __shfl_xor(ss, 16); ss += __shfl_xor(ss, 32); if (fq == 0) atomicAdd(ssq + row, ss); }
            }
        } else if constexpr (MODE == 3) {
            auto& A = const_cast<f32x4 (&)[2][2][4][2]>(acc);
            const bf16_t* bs = (const bf16_t*)base;
            { u32x4 pre[2][4][2];
#pragma unroll
              for (int ai = 0; ai < 2; ++ai)
#pragma unroll
                for (int m = 0; m < 4; ++m) { const size_t off = (size_t)(u.pm * BM + ai * HALF + wr * 64 + m * 16 + fr) * ldc + col0;
#pragma unroll
                    for (int bj = 0; bj < 2; ++bj) pre[ai][m][bj] = *(const u32x4*)(bs + off + bj * HALF); }
              asm volatile("" ::: "memory");
#pragma unroll
              for (int ai = 0; ai < 2; ++ai)
#pragma unroll
                for (int m = 0; m < 4; ++m) { const int row = u.pm * BM + ai * HALF + wr * 64 + m * 16 + fr; float ss = 0.f;
#pragma unroll
                    for (int bj = 0; bj < 2; ++bj) { const u32x4 pb = pre[ai][m][bj];
                        const f32x4 v0 = lo4(pb.x, pb.y) + acc[ai][bj][m][0] * s, v1 = lo4(pb.z, pb.w) + acc[ai][bj][m][1] * s;
                        ss += (v0[0] * v0[0] + v0[1] * v0[1]) + (v0[2] * v0[2] + v0[3] * v0[3]) + (v1[0] * v1[0] + v1[1] * v1[1]) + (v1[2] * v1[2] + v1[3] * v1[3]);
                        A[ai][bj][m][0] = v0; A[ai][bj][m][1] = v1; }
                    ss += __shfl_xor(ss, 16); ss += __shfl_xor(ss, 32); if (fq == 0) atomicAdd(ssq + row, ss); } }
            asm volatile("s_waitcnt vmcnt(0)" ::: "memory");
            unsigned* c = cnt + 64 * u.pm;
            if ((threadIdx.x & 63) == 0) __hip_atomic_fetch_add(c, 1u, __ATOMIC_RELAXED, __HIP_MEMORY_SCOPE_AGENT);
            { unsigned spins = 0;
              while ((unsigned)__builtin_amdgcn_readfirstlane(__hip_atomic_load(c, __ATOMIC_RELAXED, __HIP_MEMORY_SCOPE_AGENT)) < 64u) { __builtin_amdgcn_s_sleep(4); if (++spins > (1u << 22)) break; } }
            float rsv[2][4];
#pragma unroll
            for (int ai = 0; ai < 2; ++ai)
#pragma unroll
                for (int m = 0; m < 4; ++m) rsv[ai][m] = __hip_atomic_load(ssq + u.pm * BM + ai * HALF + wr * 64 + m * 16 + fr, __ATOMIC_RELAXED, __HIP_MEMORY_SCOPE_AGENT);
            f32x4 gv[2][2];
#pragma unroll
            for (int bj = 0; bj < 2; ++bj)
#pragma unroll
                for (int n = 0; n < 2; ++n) gv[bj][n] = *(const f32x4*)(gain + col0 + bj * HALF + 4 * n);
#pragma unroll
            for (int ai = 0; ai < 2; ++ai)
#pragma unroll
                for (int m = 0; m < 4; ++m) { const size_t off = (size_t)(u.pm * BM + ai * HALF + wr * 64 + m * 16 + fr) * ldc + col0;
                    const float rs = __builtin_amdgcn_rsqf(rsv[ai][m] * (1.0f / 2048.0f) + 1e-6f);
#pragma unroll
                    for (int bj = 0; bj < 2; ++bj) { *(f32x4*)((float*)out + off + bj * HALF) = acc[ai][bj][m][0] * rs * gv[bj][0]; *(f32x4*)((float*)out + off + bj * HALF + 4) = acc[ai][bj][m][1] * rs * gv[bj][1]; } }
        } else {
            const bf16_t* bs = (const bf16_t*)base;
            u32x4 pre[2][4][2];
#pragma unroll
            for (int ai = 0; ai < 2; ++ai)
#pragma unroll
                for (int m = 0; m < 4; ++m) { const size_t off = (size_t)(u.pm * BM + ai * HALF + wr * 64 + m * 16 + fr) * ldc + col0;
#pragma unroll
                    for (int bj = 0; bj < 2; ++bj) pre[ai][m][bj] = *(const u32x4*)(bs + off + bj * HALF); }
            asm volatile("" ::: "memory");
#pragma unroll
            for (int ai = 0; ai < 2; ++ai)
#pragma unroll
                for (int m = 0; m < 4; ++m) { const int row = u.pm * BM + ai * HALF + wr * 64 + m * 16 + fr; const size_t off = (size_t)row * ldc + col0; float ss = 0.f;
#pragma unroll
                    for (int bj = 0; bj < 2; ++bj) { const u32x4 pb = pre[ai][m][bj];
                        const f32x4 v0 = lo4(pb.x, pb.y) + acc[ai][bj][m][0] * s, v1 = lo4(pb.z, pb.w) + acc[ai][bj][m][1] * s;
                        if constexpr (MODE == 1) {
                            ss += (v0[0] * v0[0] + v0[1] * v0[1]) + (v0[2] * v0[2] + v0[3] * v0[3]) + (v1[0] * v1[0] + v1[1] * v1[1]) + (v1[2] * v1[2] + v1[3] * v1[3]);
                            u32x4 w; w.x = cvt_pk_bf16(v0[0], v0[1]); w.y = cvt_pk_bf16(v0[2], v0[3]); w.z = cvt_pk_bf16(v1[0], v1[1]); w.w = cvt_pk_bf16(v1[2], v1[3]);
                            *(u32x4*)((bf16_t*)out + off + bj * HALF) = w;
                        } else { *(f32x4*)((float*)out + off + bj * HALF) = v0; *(f32x4*)((float*)out + off + bj * HALF + 4) = v1; } }
                    if constexpr (MODE == 1) { ss += __shfl_xor(ss, 16); ss += __shfl_xor(ss, 32); if (fq == 0) atomicAdd(ssq + row, ss); } }
        }
    }
};
struct EpiProj {
    static constexpr bool PERM = true, AFTER_DRAIN = false;
    bf16_t* O; int ldc; int q_lo, q_hi; float qscale; const float* ssq;
    __device__ __forceinline__ void operator()(const f32x4 (&acc)[2][2][4][2], const Unit& u, int wr, int wc, int fr, int fq) const {
        const int row0 = u.pm * BM + wr * 64 + fr, colt = u.pn * BM, col0 = colt + wc * 32 + 8 * fq;
        const float sc = (colt >= q_lo && colt < q_hi) ? qscale : 1.0f;
        float rsv[2][4];
#pragma unroll
        for (int ai = 0; ai < 2; ++ai)
#pragma unroll
            for (int m = 0; m < 4; ++m) rsv[ai][m] = ssq[row0 + ai * HALF + m * 16];
        asm volatile("" ::: "memory");
#pragma unroll
        for (int ai = 0; ai < 2; ++ai)
#pragma unroll
            for (int m = 0; m < 4; ++m) { bf16_t* rowp = O + (size_t)(row0 + ai * HALF + m * 16) * ldc + col0;
                const float rs = sc * __builtin_amdgcn_rsqf(rsv[ai][m] * (1.0f / 2048.0f) + 1e-6f);
#pragma unroll
                for (int bj = 0; bj < 2; ++bj) { const f32x4 v0 = acc[ai][bj][m][0] * rs, v1 = acc[ai][bj][m][1] * rs;
                    u32x4 w; w.x = cvt_pk_bf16(v0[0], v0[1]); w.y = cvt_pk_bf16(v0[2], v0[3]); w.z = cvt_pk_bf16(v1[0], v1[1]); w.w = cvt_pk_bf16(v1[2], v1[3]);
                    *(u32x4*)(rowp + bj * HALF) = w; } }
    }
};

template <class Epi, class Sched, bool ALIGN_EPI = false, bool SP2 = false>
__device__ __forceinline__ void gemm_phase(PG8_LAS unsigned char* lds, const Gemm g, const Sched& S, const Epi& E) {
    int tid_ = threadIdx.x; asm volatile("" : "+v"(tid_)); const int tid = tid_, wid = __builtin_amdgcn_readfirstlane(tid >> 6), lane = tid & 63, wr = wid >> 2, wc = wid & 3, fr = lane & 15, fq = lane >> 4;
    const int K = g.K, nt = K / BK;
    unsigned voffA[2], voffB[2];
#pragma unroll
    for (int i = 0; i < 2; ++i) { int R, C; stage_rc(tid * 16 + i * 8192, R, C); const int Rb = Epi::PERM ? ((R & ~31) + perm32(R & 31)) : R;
        voffA[i] = (unsigned)(R * K + C) * 2u; voffB[i] = (unsigned)(Rb * K + C) * 2u; }
    const size_t kstep = (size_t)(BK * 2);
    const size_t hstep = (size_t)HALF * K * 2;
    const size_t tstep = 2 * hstep;
    const unsigned ldsw = (unsigned)wid * 1024u;
    const int aoff = lds_byte(wr * 64 + fr, fq * 8), boff = lds_byte(wc * 32 + fr, fq * 8);
#define PG8_SA(b, h) (((b) * 2 + (h)) * HTB)
#define PG8_SB(b, h) ((4 + (b) * 2 + (h)) * HTB)
#define PG8_STAGE(bufoff, gbase, voff) do { _Pragma("unroll") for (int _i = 0; _i < 2; ++_i) \
        __builtin_amdgcn_global_load_lds((const unsigned*)((const char*)(gbase) + (voff)[_i]), (PG8_LAS unsigned*)(lds + (bufoff) + ldsw + _i * 8192), 16, 0, 0); } while (0)
#define PG8_LDA(dst, b, h) do { _Pragma("unroll") for (int m = 0; m < 4; ++m) _Pragma("unroll") for (int k = 0; k < 2; ++k) dst[m][k] = *(const PG8_LAS bf16x8*)(lds + PG8_SA(b, h) + aoff + m * 2048 + k * 1024); } while (0)
#define PG8_LDB(dst, b, h) do { _Pragma("unroll") for (int n = 0; n < 2; ++n) _Pragma("unroll") for (int k = 0; k < 2; ++k) dst[n][k] = *(const PG8_LAS bf16x8*)(lds + PG8_SB(b, h) + boff + n * 2048 + k * 1024); } while (0)
#define PG8_MMA(ai, bj, At, Bt) do { __builtin_amdgcn_s_setprio(1); _Pragma("unroll") for (int m = 0; m < 4; ++m) _Pragma("unroll") for (int n = 0; n < 2; ++n) _Pragma("unroll") for (int k = 0; k < 2; ++k) \
        acc[ai][bj][m][n] = __builtin_amdgcn_mfma_f32_16x16x32_bf16(Bt[n][k], At[m][k], acc[ai][bj][m][n], 0, 0, 0); __builtin_amdgcn_s_setprio(0); } while (0)
#define PG8_WAIT_V(n) asm volatile("s_waitcnt vmcnt(" #n ")" ::: "memory")
#define PG8_WAIT_L(n) asm volatile("s_waitcnt lgkmcnt(" #n ")" ::: "memory")
#define PG8_BAR __builtin_amdgcn_s_barrier()
#define PG8_SCHED __builtin_amdgcn_sched_barrier(0)
    Unit cur, nxt; int ui = 0;
    if (!S.next(0, cur)) return;
    f32x4 acc[2][2][4][2];
#pragma unroll
    for (int a = 0; a < 2; ++a)
#pragma unroll
        for (int b = 0; b < 2; ++b)
#pragma unroll
            for (int m = 0; m < 4; ++m)
#pragma unroll
                for (int n = 0; n < 2; ++n) acc[a][b][m][n] = (f32x4){0.f, 0.f, 0.f, 0.f};
    bf16x8 At[4][2], B0[2][2], B1[2][2];
    const char* cA = (const char*)g.A + (size_t)cur.pm * tstep; const char* cB = (const char*)g.Bt + (size_t)cur.pn * tstep;
    S.a_ready(cur);
    if constexpr (SP2) {
        PG8_STAGE(PG8_SB(0, 0), cB, voffB); PG8_STAGE(PG8_SB(0, 1), cB + hstep, voffB); PG8_STAGE(PG8_SA(0, 0), cA, voffA); PG8_STAGE(PG8_SA(0, 1), cA + hstep, voffA);
        if (wr == 1) PG8_BAR;
        PG8_WAIT_V(2); PG8_BAR;
        PG8_STAGE(PG8_SB(1, 0), cB + kstep, voffB); PG8_STAGE(PG8_SA(1, 0), cA + kstep, voffA); PG8_STAGE(PG8_SB(1, 1), cB + hstep + kstep, voffB);
        PG8_WAIT_V(6); PG8_BAR;
    } else {
        PG8_STAGE(PG8_SB(0, 0), cB, voffB); PG8_STAGE(PG8_SA(0, 0), cA, voffA); PG8_STAGE(PG8_SB(0, 1), cB + hstep, voffB); PG8_STAGE(PG8_SA(0, 1), cA + hstep, voffA);
        if (wr == 1) PG8_BAR;
        PG8_WAIT_V(4); PG8_BAR;
        PG8_STAGE(PG8_SB(1, 0), cB + kstep, voffB); PG8_STAGE(PG8_SA(1, 0), cA + kstep, voffA); PG8_STAGE(PG8_SB(1, 1), cB + hstep + kstep, voffB);
        PG8_WAIT_V(6); PG8_BAR;
    }
    for (;;) {
        const bool has_next = S.next(ui + 1, nxt);
        const char* nA = has_next ? (const char*)g.A + (size_t)nxt.pm * tstep : cA; const char* nB = has_next ? (const char*)g.Bt + (size_t)nxt.pn * tstep : cB;
        for (int t = 0; t < nt; t += 2) {
            const bool last = (t == nt - 2);
            const char* a1 = cA + (size_t)(t + 1) * kstep;
            const char* a2 = last ? nA : cA + (size_t)(t + 2) * kstep; const char* b2 = last ? nB : cB + (size_t)(t + 2) * kstep;
            const char* a3 = a2 + kstep; const char* b3 = b2 + kstep;
            if (last && has_next) S.a_ready(nxt);
            if constexpr (SP2) {
            PG8_LDB(B0, 0, 0); PG8_LDB(B1, 0, 1); PG8_SCHED; PG8_LDA(At, 0, 0); PG8_STAGE(PG8_SA(1, 1), a1 + hstep, voffA);
            PG8_WAIT_V(8); PG8_WAIT_L(0); PG8_BAR; PG8_MMA(0, 0, At, B0); PG8_MMA(0, 1, At, B1); PG8_BAR; PG8_SCHED;
            PG8_LDA(At, 0, 1); PG8_STAGE(PG8_SB(0, 0), b2, voffB); PG8_STAGE(PG8_SB(0, 1), b2 + hstep, voffB); PG8_STAGE(PG8_SA(0, 0), a2, voffA);
            PG8_WAIT_V(8); PG8_WAIT_L(0); PG8_BAR; PG8_MMA(1, 0, At, B0); PG8_MMA(1, 1, At, B1); PG8_BAR; PG8_SCHED;
            PG8_LDB(B0, 1, 0); PG8_LDB(B1, 1, 1); PG8_SCHED; PG8_LDA(At, 1, 0); PG8_STAGE(PG8_SA(0, 1), a2 + hstep, voffA);
            PG8_WAIT_V(8); PG8_WAIT_L(0); PG8_BAR; PG8_MMA(0, 0, At, B0); PG8_MMA(0, 1, At, B1); PG8_BAR; PG8_SCHED;
            PG8_LDA(At, 1, 1); PG8_STAGE(PG8_SB(1, 0), b3, voffB); PG8_STAGE(PG8_SB(1, 1), b3 + hstep, voffB); PG8_STAGE(PG8_SA(1, 0), a3, voffA);
            PG8_WAIT_V(8); PG8_WAIT_L(0); PG8_BAR; PG8_MMA(1, 0, At, B0); PG8_MMA(1, 1, At, B1); PG8_BAR; PG8_SCHED;
            } else {
            PG8_LDB(B0, 0, 0); PG8_SCHED; PG8_LDA(At, 0, 0); PG8_STAGE(PG8_SA(1, 1), a1 + hstep, voffA);
            PG8_WAIT_L(8); PG8_BAR; PG8_WAIT_L(0); PG8_MMA(0, 0, At, B0); PG8_BAR; PG8_SCHED;
            PG8_LDB(B1, 0, 1); PG8_STAGE(PG8_SB(0, 0), b2, voffB);
            PG8_BAR; PG8_WAIT_L(0); PG8_MMA(0, 1, At, B1); PG8_BAR;
            PG8_LDA(At, 0, 1); PG8_STAGE(PG8_SA(0, 0), a2, voffA);
            PG8_BAR; PG8_WAIT_L(0); PG8_MMA(1, 0, At, B0); PG8_BAR; PG8_SCHED;
            PG8_STAGE(PG8_SB(0, 1), b2 + hstep, voffB);
            PG8_WAIT_V(6); PG8_BAR; PG8_MMA(1, 1, At, B1); PG8_BAR;
            PG8_LDB(B0, 1, 0); PG8_SCHED; PG8_LDA(At, 1, 0); PG8_STAGE(PG8_SA(0, 1), a2 + hstep, voffA);
            PG8_WAIT_L(8); PG8_BAR; PG8_WAIT_L(0); PG8_MMA(0, 0, At, B0); PG8_BAR; PG8_SCHED;
            PG8_LDB(B1, 1, 1); PG8_STAGE(PG8_SB(1, 0), b3, voffB);
            PG8_BAR; PG8_WAIT_L(0); PG8_MMA(0, 1, At, B1); PG8_BAR;
            PG8_LDA(At, 1, 1); PG8_STAGE(PG8_SA(1, 0), a3, voffA);
            PG8_BAR; PG8_WAIT_L(0); PG8_MMA(1, 0, At, B0); PG8_BAR; PG8_SCHED;
            PG8_STAGE(PG8_SB(1, 1), b3 + hstep, voffB);
            PG8_WAIT_V(6); PG8_BAR; PG8_MMA(1, 1, At, B1); PG8_BAR;
            }
        }
        if constexpr (ALIGN_EPI) { if (wr == 0) PG8_BAR; }
        if constexpr (!Epi::AFTER_DRAIN) { E(acc, cur, wr, wc, fr, fq); S.done(cur); }
        if (!has_next) break;
#pragma unroll
        for (int a = 0; a < 2; ++a)
#pragma unroll
            for (int b = 0; b < 2; ++b)
#pragma unroll
                for (int m = 0; m < 4; ++m)
#pragma unroll
                    for (int n = 0; n < 2; ++n) acc[a][b][m][n] = (f32x4){0.f, 0.f, 0.f, 0.f};
        cur = nxt; cA = nA; cB = nB; ++ui;
        if constexpr (ALIGN_EPI) { if (wr == 1) PG8_BAR; }
    }
    PG8_WAIT_V(0);
    if constexpr (!ALIGN_EPI) { if (wr == 0) PG8_BAR; }
    PG8_BAR;
    if constexpr (Epi::AFTER_DRAIN) { E.fused(acc, cur, wr, wc, fr, fq, lds, wid, lane); S.done(cur); }
#undef PG8_SA
#undef PG8_SB
#undef PG8_STAGE
#undef PG8_LDA
#undef PG8_LDB
#undef PG8_MMA
#undef PG8_WAIT_V
#undef PG8_WAIT_L
#undef PG8_BAR
#undef PG8_SCHED
}
}

#ifndef PG8_SP2
#define PG8_SP2 true
#endif
#ifndef PG8_ALIGN
#define PG8_ALIGN true
#endif
#include <hip/hip_bf16.h>
#include <cmath>
namespace attn_body {
using bf16=__hip_bfloat16;
using bf16x8=__attribute__((ext_vector_type(8)))short;
using s16x4=__attribute__((ext_vector_type(4)))short;
using f32x16=__attribute__((ext_vector_type(16)))float;
using u32x4=__attribute__((ext_vector_type(4)))unsigned;
constexpr int BATCH=4,SEQ=8192,D=64,PP=6144,OP=2048;
constexpr int NW=8,QBLK=32,QB=QBLK*NW,KVBLK=64,NQB=SEQ/QB;
constexpr int ATTN_UNIT_ROWS=QB;
__device__ __forceinline__ int crow(int r,int hi){return (r&3)+8*(r>>2)+4*hi;}
#define SBAR() __builtin_amdgcn_sched_barrier(0)
__device__ __forceinline__ void cmask(f32x16&p0,f32x16&p1,int jb,int qrel,int hi){
  const float NEG=-INFINITY; int kb=64*jb+4*hi;
  #pragma unroll
  for(int r=0;r<16;++r){int kv=kb+(r&3)+8*(r>>2); if(kv>qrel)p0[r]=NEG; if(kv+32>qrel)p1[r]=NEG;}
}

constexpr int NSLOT=3, SLOTB=8192;
constexpr int LDS_K=0, LDS_V=NSLOT*SLOTB, LDS_WS=2*NSLOT*SLOTB, LDS_OST=LDS_WS+NW*64*4, LDS_BYTES=LDS_OST+NW*4096;
constexpr float C2=0.125f*1.4426950408889634f;
__device__ __forceinline__ void glds16(const void*gsrc,unsigned lds_dst){unsigned keep;
  asm volatile("s_mov_b32 %0, m0\n\ts_mov_b32 m0, %2\n\ts_nop 0\n\tglobal_load_lds_dwordx4 %1, off\n\ts_mov_b32 m0, %0":"=&s"(keep):"v"(gsrc),"s"(lds_dst):"memory");}
__device__ __forceinline__ float max3f(float a,float b,float c){float r;asm("v_max3_f32 %0, %1, %2, %3":"=v"(r):"v"(a),"v"(b),"v"(c));return r;}
__device__ __forceinline__ float max2f(float a,float b){float r;asm("v_max_f32_e32 %0, %1, %2":"=v"(r):"v"(a),"v"(b));return r;}
__device__ __forceinline__ float fadd_s(float a,float b){float r;asm("v_add_f32_e32 %0, %1, %2":"=v"(r):"v"(a),"v"(b));return r;}
__device__ __forceinline__ float fsub_s(float a,float b){float r;asm("v_sub_f32_e32 %0, %1, %2":"=v"(r):"v"(a),"v"(b));return r;}
typedef float f32x2_t __attribute__((ext_vector_type(2))); typedef __bf16 bf16x2_t __attribute__((ext_vector_type(2)));
__device__ __forceinline__ unsigned cvtpk_s(float lo,float hi){f32x2_t v={lo,hi};bf16x2_t b=__builtin_convertvector(v,bf16x2_t);return __builtin_bit_cast(unsigned,b);}
#define WAIT_BAR(N) asm volatile("s_waitcnt vmcnt(" #N ") lgkmcnt(0)\n\ts_barrier":::"memory")

__device__ __forceinline__ void qkt(f32x16&p0,f32x16&p1,const char*Kslot,const bf16x8*qr,const f32x16&negm,int r32,int hi){
  const char*kb=Kslot+hi*1024+r32*16;
  #pragma unroll
  for(int d0=0;d0<4;++d0){
    const bf16x8 b0=*reinterpret_cast<const bf16x8*>(kb+d0*2048);
    const bf16x8 b1=*reinterpret_cast<const bf16x8*>(kb+d0*2048+512);
    if(d0==0){p0=__builtin_amdgcn_mfma_f32_32x32x16_bf16(b0,qr[0],negm,0,0,0);p1=__builtin_amdgcn_mfma_f32_32x32x16_bf16(b1,qr[0],negm,0,0,0);}
    else{p0=__builtin_amdgcn_mfma_f32_32x32x16_bf16(b0,qr[d0],p0,0,0,0);p1=__builtin_amdgcn_mfma_f32_32x32x16_bf16(b1,qr[d0],p1,0,0,0);}}
}
typedef __attribute__((address_space(3))) const char* lds_cptr;
typedef short v4i16_t __attribute__((ext_vector_type(4)));
__device__ __forceinline__ void kload8(bf16x8*kf,lds_cptr kp){
  kf[0]=*(const __attribute__((address_space(3))) bf16x8*)(kp);      kf[1]=*(const __attribute__((address_space(3))) bf16x8*)(kp+512);
  kf[2]=*(const __attribute__((address_space(3))) bf16x8*)(kp+2048); kf[3]=*(const __attribute__((address_space(3))) bf16x8*)(kp+2560);
  kf[4]=*(const __attribute__((address_space(3))) bf16x8*)(kp+4096); kf[5]=*(const __attribute__((address_space(3))) bf16x8*)(kp+4608);
  kf[6]=*(const __attribute__((address_space(3))) bf16x8*)(kp+6144); kf[7]=*(const __attribute__((address_space(3))) bf16x8*)(kp+6656);
}
__device__ __forceinline__ void kload2(bf16x8*kf,lds_cptr kp,int j){ kf[2*j]=*(const __attribute__((address_space(3))) bf16x8*)(kp+j*2048); kf[2*j+1]=*(const __attribute__((address_space(3))) bf16x8*)(kp+j*2048+512); }
__device__ __forceinline__ s16x4 vtr(lds_cptr p){ return __builtin_bit_cast(s16x4,__builtin_amdgcn_ds_read_tr16_b64_v4i16((__attribute__((address_space(3))) v4i16_t*)p)); }
__device__ __forceinline__ float rowmax(const f32x16&p0,const f32x16&p1){
  float a=max3f(p0[0],p0[1],p1[0]),b=max3f(p0[2],p0[3],p1[1]);a=max3f(a,p1[2],p1[3]);
  #pragma unroll
  for(int r=4;r<16;r+=4){a=max3f(a,p0[r],p0[r+1]);b=max3f(b,p0[r+2],p0[r+3]);a=max3f(a,p1[r],p1[r+1]);b=max3f(b,p1[r+2],p1[r+3]);}
  const float m=max2f(a,b);
  auto rr=__builtin_amdgcn_permlane32_swap(__float_as_uint(m),__float_as_uint(m),false,false);
  return max2f(__uint_as_float(rr[0]),__uint_as_float(rr[1]));
}
__device__ __forceinline__ void pv(f32x16*o,int vb,bf16x8 pa0,bf16x8 pa1,bf16x8 pa2,bf16x8 pa3){
  #pragma unroll
  for(int d0=0;d0<2;++d0){s16x4 lo[4],hi[4];
    #pragma unroll
    for(int ks=0;ks<4;++ks){
      asm volatile("ds_read_b64_tr_b16 %0,%1 offset:%c2":"=&v"(lo[ks]):"v"(vb),"i"(d0*4096+ks*1024):"memory");
      asm volatile("ds_read_b64_tr_b16 %0,%1 offset:%c2":"=&v"(hi[ks]):"v"(vb),"i"(d0*4096+ks*1024+512):"memory");}
    asm volatile("s_waitcnt lgkmcnt(0)":::"memory");SBAR();
    #define PK(k) (bf16x8){lo[k][0],lo[k][1],lo[k][2],lo[k][3],hi[k][0],hi[k][1],hi[k][2],hi[k][3]}
    o[d0]=__builtin_amdgcn_mfma_f32_32x32x16_bf16(pa0,PK(0),o[d0],0,0,0);
    o[d0]=__builtin_amdgcn_mfma_f32_32x32x16_bf16(pa1,PK(1),o[d0],0,0,0);
    o[d0]=__builtin_amdgcn_mfma_f32_32x32x16_bf16(pa2,PK(2),o[d0],0,0,0);
    o[d0]=__builtin_amdgcn_mfma_f32_32x32x16_bf16(pa3,PK(3),o[d0],0,0,0);
    #undef PK
  }
}

#ifndef ATTN_STORE16
#define ATTN_STORE16(p,v) (*(u32x4*)(p)=(v))
#endif
template<int THRL> __device__ __forceinline__ void attn_unit(int b,int qb,const bf16*Q,const bf16*__restrict__ K,const bf16*__restrict__ V,bf16*O,char*shm){
  const int tid=threadIdx.x,lane=tid&63,r32=lane&31,hi=lane>>5; const int wid=__builtin_amdgcn_readfirstlane(tid>>6);
  const long rowbase=(long)b*SEQ; const int q0=qb*QB;
  const bf16*Qw=Q+(rowbase+q0+wid*QBLK)*PP;
  const bf16*Kh=K+rowbase*PP,*Vh=V+rowbase*PP;
  const unsigned lds0=(unsigned)(uintptr_t)shm;
  float*wsf=(float*)(shm+LDS_WS)+wid*64;
  const bf16*ksrc=Kh+(long)lane*PP+wid*8;
  const bf16*vsrc=Vh+(long)(16*(wid&3)+(lane>>2))*PP+(wid>>2)*32+(lane&3)*8;
  const unsigned kdst=lds0+LDS_K+wid*1024, vdst=lds0+LDS_V+wid*1024;
  #define DMA_K(t,slot) glds16(ksrc+(long)(t)*KVBLK*PP,(unsigned)__builtin_amdgcn_readfirstlane(kdst+(slot)))
  #define DMA_V(t,slot) glds16(vsrc+(long)(t)*KVBLK*PP,(unsigned)__builtin_amdgcn_readfirstlane(vdst+(slot)))
  const int vb0=(int)(lds0+LDS_V)+((lane>>4)&1)*32+(lane&3)*8+(4*hi+((lane&15)>>2))*64;
  const char*Kbase=shm+LDS_K; bf16x8 kf[8];
  const lds_cptr shm3=(lds_cptr)shm; const lds_cptr kp0=shm3+LDS_K+hi*1024+r32*16; const lds_cptr vp0=shm3+LDS_V+((lane>>4)&1)*32+(lane&3)*8+(4*hi+((lane&15)>>2))*64;
  const int NT=(q0+QB)/KVBLK;
  DMA_K(0,0);DMA_V(0,0);DMA_K(1,SLOTB);
  bf16x8 qr[4];
  #pragma unroll
  for(int d0=0;d0<4;++d0)qr[d0]=*reinterpret_cast<const bf16x8*>(&Qw[(long)r32*PP+d0*16+hi*8]);
  float mhat=0.f,l_reg=0.f;f32x16 o[2];o[0]=f32x16{};o[1]=f32x16{};f32x16 negm=f32x16{};asm volatile("":"+v"(negm));
  const int qrel=wid*QBLK+r32;
  #define CMASK(P0,P1,t) do{int jb_=(t)-(NT-4); if(jb_>=0)cmask(P0,P1,jb_,qrel,hi);}while(0)
  bool resc=false;
  #define START(P0,P1) do{ const float rm=rowmax(P0,P1); resc=false; \
    { const float dl=rm; mhat=fadd_s(mhat,dl); \
      _Pragma("unroll") for(int r=0;r<16;++r){P0[r]=fsub_s(P0[r],dl);P1[r]=fsub_s(P1[r],dl);} \
      _Pragma("unroll") for(int r=0;r<16;++r)negm[r]=-mhat; asm volatile("":"+v"(negm)); } \
    _Pragma("unroll") for(int r=0;r<16;++r)P0[r]=__builtin_amdgcn_exp2f(P0[r]); }while(0)
  #define RESC() do{ if(resc){ asm volatile("s_waitcnt lgkmcnt(0)":::"memory"); \
      _Pragma("unroll") for(int d_=0;d_<2;++d_) _Pragma("unroll") for(int r=0;r<16;++r)o[d_][r]*=wsf[crow(r,hi)]; } }while(0)
  f32x16 pA0,pA1,pB0,pB1;
  int sl_prev=0,sl_cur=0,sl_next=SLOTB;
  #define ROT() do{sl_prev=sl_cur;sl_cur=sl_next;sl_next=(sl_next==(NSLOT-1)*SLOTB)?0:sl_next+SLOTB;}while(0)
  DMA_K(2,2*SLOTB);
  WAIT_BAR(3);
  qkt(pA0,pA1,Kbase,qr,negm,r32,hi);asm volatile("s_nop 15\n\ts_nop 7":"+v"(pA0),"+v"(pA1));CMASK(pA0,pA1,0);
  START(pA0,pA1);
  _Pragma("unroll") for(int r=0;r<16;++r)pA1[r]=__builtin_amdgcn_exp2f(pA1[r]);
  WAIT_BAR(0);
  DMA_K(3,0);DMA_V(1,SLOTB);
  ROT();
  kload8(kf,kp0+sl_cur);
  WAIT_BAR(2);
  s16x4 vlo[8],vhi[8]; u32x4 pw0,pw1,pw2,pw3;
  #define PKW(P,B) cvtpk_s(P[B],P[B+1])
  #define PAF(k) __builtin_bit_cast(bf16x8,pw##k)
  #define VFR(i) (bf16x8){vlo[i][0],vlo[i][1],vlo[i][2],vlo[i][3],vhi[i][0],vhi[i][1],vhi[i][2],vhi[i][3]}
  #define PIN(x) asm volatile("":"+v"(x))
  #define MX3(a,b,c) __builtin_fmaxf(__builtin_fmaxf((a),(b)),(c))
  #define GAPA(MF,A0,A1,A2,A3,W0,W1,PW) do{ MF; sacc+=A0; sacc+=A1; sacc+=A2; sacc+=A3; PIN(sacc); W0; W1; PIN(PW); SBAR(); }while(0)
  #define EX(v) __builtin_amdgcn_exp2f(v)
  #define GAPB(MF,X,B) do{ MF; X[B]=EX(X[B]); X[B+1]=EX(X[B+1]); X[B+2]=EX(X[B+2]); X[B+3]=EX(X[B+3]); PIN(X); SBAR(); }while(0)
  #define VRD(i) do{ vlo[i]=vtr(vp_+(((i)>>2)*4096+((i)&3)*1024)); vhi[i]=vtr(vp_+(((i)>>2)*4096+((i)&3)*1024+512)); }while(0)
  #define KRD(G,j) do{ if(G){ kload2(kf,kp0+sl_next,j); SBAR(); } }while(0)
  #define STEP(C0,C1,P0,P1,t,GK,GV,GL) do{ SBAR(); \
    const lds_cptr vp_=vp0+sl_prev; \
    VRD(0); SBAR(); float sacc=(P0[0]+P0[1]); \
    GAPA(C0=__builtin_amdgcn_mfma_f32_32x32x16_bf16(kf[0],qr[0],negm,0,0,0), P0[2],P0[3],P0[4],P0[5],     pw0[0]=PKW(P0,0), pw0[1]=PKW(P0,2), pw0); \
    VRD(4); SBAR(); GAPA(C1=__builtin_amdgcn_mfma_f32_32x32x16_bf16(kf[1],qr[0],negm,0,0,0), P0[6],P0[7],P0[8],P0[9],     pw0[2]=PKW(P0,4), pw0[3]=PKW(P0,6), pw0); \
    VRD(1); SBAR(); GAPA(C0=__builtin_amdgcn_mfma_f32_32x32x16_bf16(kf[2],qr[1],C0,0,0,0),   P0[10],P0[11],P0[12],P0[13], pw1[0]=PKW(P0,8), pw1[1]=PKW(P0,10), pw1); \
    VRD(5); SBAR(); GAPA(C1=__builtin_amdgcn_mfma_f32_32x32x16_bf16(kf[3],qr[1],C1,0,0,0),   P0[14],P0[15],P1[0],P1[1],   pw1[2]=PKW(P0,12),pw1[3]=PKW(P0,14), pw1); \
    VRD(2); SBAR(); GAPA(C0=__builtin_amdgcn_mfma_f32_32x32x16_bf16(kf[4],qr[2],C0,0,0,0),   P1[2],P1[3],P1[4],P1[5],     pw2[0]=PKW(P1,0), pw2[1]=PKW(P1,2), pw2); \
    VRD(6); SBAR(); GAPA(C1=__builtin_amdgcn_mfma_f32_32x32x16_bf16(kf[5],qr[2],C1,0,0,0),   P1[6],P1[7],P1[8],P1[9],     pw2[2]=PKW(P1,4), pw2[3]=PKW(P1,6), pw2); \
    VRD(3); SBAR(); GAPA(C0=__builtin_amdgcn_mfma_f32_32x32x16_bf16(kf[6],qr[3],C0,0,0,0),   P1[10],P1[11],P1[12],P1[13], pw3[0]=PKW(P1,8), pw3[1]=PKW(P1,10), pw3); \
    VRD(7); SBAR(); GAPA(C1=__builtin_amdgcn_mfma_f32_32x32x16_bf16(kf[7],qr[3],C1,0,0,0),   P1[14],P1[15],0.f,0.f,       pw3[2]=PKW(P1,12),pw3[3]=PKW(P1,14), pw3); \
    l_reg+=sacc; \
    if(GK){DMA_K((t)+3,sl_cur);} if(GV){DMA_V((t)+1,sl_next);} \
    CMASK(C0,C1,t); \
    { float a=MX3(C0[0],C0[1],C1[0]),b=MX3(C0[2],C0[3],C1[1]); a=MX3(a,C1[2],C1[3]); \
      _Pragma("unroll") for(int r=4;r<16;r+=4){a=MX3(a,C0[r],C0[r+1]);b=MX3(b,C0[r+2],C0[r+3]);a=MX3(a,C1[r],C1[r+1]);b=MX3(b,C1[r+2],C1[r+3]);} \
      float rm=__builtin_fmaxf(a,b); { auto rr=__builtin_amdgcn_permlane32_swap(__float_as_uint(rm),__float_as_uint(rm),false,false); rm=__builtin_fmaxf(__uint_as_float(rr[0]),__uint_as_float(rr[1])); } \
      resc=false; \
      if(__builtin_expect(__any(rm>(float)THRL),0)){ const float dl=__builtin_fmaxf(rm,0.f); mhat+=dl; \
        _Pragma("unroll") for(int r=0;r<16;++r){C0[r]-=dl;C1[r]-=dl;} \
        _Pragma("unroll") for(int r=0;r<16;++r)negm[r]=-mhat; asm volatile("":"+v"(negm)); \
        const float f=__builtin_amdgcn_exp2f(-dl); l_reg*=f; if(hi==0)wsf[r32]=f; resc=true; } } \
    SBAR(); \
    GAPB(o[0]=__builtin_amdgcn_mfma_f32_32x32x16_bf16(PAF(0),VFR(0),o[0],0,0,0), C0,0); \
    GAPB(o[1]=__builtin_amdgcn_mfma_f32_32x32x16_bf16(PAF(0),VFR(4),o[1],0,0,0), C0,4); \
    KRD(GL,0); GAPB(o[0]=__builtin_amdgcn_mfma_f32_32x32x16_bf16(PAF(1),VFR(1),o[0],0,0,0), C0,8); \
    KRD(GL,1); GAPB(o[1]=__builtin_amdgcn_mfma_f32_32x32x16_bf16(PAF(1),VFR(5),o[1],0,0,0), C0,12); \
    KRD(GL,2); GAPB(o[0]=__builtin_amdgcn_mfma_f32_32x32x16_bf16(PAF(2),VFR(2),o[0],0,0,0), C1,0); \
    KRD(GL,3); GAPB(o[1]=__builtin_amdgcn_mfma_f32_32x32x16_bf16(PAF(2),VFR(6),o[1],0,0,0), C1,4); \
    GAPB(o[0]=__builtin_amdgcn_mfma_f32_32x32x16_bf16(PAF(3),VFR(3),o[0],0,0,0), C1,8); \
    GAPB(o[1]=__builtin_amdgcn_mfma_f32_32x32x16_bf16(PAF(3),VFR(7),o[1],0,0,0), C1,12); \
    }while(0)
  int t=1;
  #undef CMASK
  #define CMASK(P0,P1,t) do{}while(0)
  for(;t+5<NT;t+=2){
    STEP(pB0,pB1,pA0,pA1,t,true,true,true);     WAIT_BAR(2); RESC(); ROT();
    STEP(pA0,pA1,pB0,pB1,t+1,true,true,true);   WAIT_BAR(2); RESC(); ROT();
  }
  #undef CMASK
  #define CMASK(P0,P1,t) do{int jb_=(t)-(NT-4); if(jb_>=0)cmask(P0,P1,jb_,qrel,hi);}while(0)
  #define ENDW(tt) do{ if((tt)+3<NT){WAIT_BAR(2);} else if((tt)+2<NT){WAIT_BAR(1);} else {WAIT_BAR(0);} }while(0)
  for(;t+1<NT;t+=2){
    STEP(pB0,pB1,pA0,pA1,t,(t+3<NT),(t+1<NT),(t+1<NT));       ENDW(t);   RESC(); ROT();
    STEP(pA0,pA1,pB0,pB1,t+1,(t+4<NT),(t+2<NT),(t+2<NT));     ENDW(t+1); RESC(); ROT();
  }
  STEP(pB0,pB1,pA0,pA1,NT-1,false,false,false); RESC();
  { float sacc=pB0[0]+pB0[1]; _Pragma("unroll") for(int r=2;r<16;++r)sacc+=pB0[r]; _Pragma("unroll") for(int r=0;r<16;++r)sacc+=pB1[r]; l_reg+=sacc;
    pw0=(u32x4){PKW(pB0,0),PKW(pB0,2),PKW(pB0,4),PKW(pB0,6)};pw1=(u32x4){PKW(pB0,8),PKW(pB0,10),PKW(pB0,12),PKW(pB0,14)};pw2=(u32x4){PKW(pB1,0),PKW(pB1,2),PKW(pB1,4),PKW(pB1,6)};pw3=(u32x4){PKW(pB1,8),PKW(pB1,10),PKW(pB1,12),PKW(pB1,14)};
    SBAR(); pv(o,vb0+sl_cur,PAF(0),PAF(1),PAF(2),PAF(3)); }
  #undef PKW
  #undef PAF
  #undef VFR
  #undef PIN
  #undef MX3
  #undef GAPA
  #undef GAPB
  #undef EX
  #undef VRD
  #undef KRD
  #undef STEP
  #undef ENDW
  {auto rr=__builtin_amdgcn_permlane32_swap(__float_as_uint(l_reg),__float_as_uint(l_reg),false,false);l_reg=__uint_as_float(rr[0])+__uint_as_float(rr[1]);}
  if(hi==0)wsf[32+r32]=l_reg;asm volatile("s_waitcnt lgkmcnt(0)":::"memory");
  float rli[16];
  #pragma unroll
  for(int r=0;r<16;++r)rli[r]=__builtin_amdgcn_rcpf(wsf[32+crow(r,hi)]);
  bf16*Ow=O+(rowbase+q0+wid*QBLK)*OP;
  { bf16*stg=(bf16*)(shm+LDS_OST)+wid*2048;
    #pragma unroll
    for(int r=0;r<16;++r){const int orow=crow(r,hi);
      #pragma unroll
      for(int d0=0;d0<2;++d0)stg[orow*64+d0*32+r32]=__float2bfloat16(o[d0][r]*rli[r]);}
    asm volatile("s_waitcnt lgkmcnt(0)":::"memory");
    #pragma unroll
    for(int i=0;i<4;++i){const int row=i*8+(lane>>3),ch=lane&7; const u32x4 v=*(const u32x4*)(stg+row*64+ch*8); ATTN_STORE16(Ow+(long)row*OP+ch*8,v);} }
  asm volatile("s_waitcnt lgkmcnt(0)\n\ts_barrier":::"memory");
  #undef DMA_K
  #undef DMA_V
  #undef CMASK
  #undef START
  #undef RESC
  #undef ROT
}
constexpr int ATTN_LDS_BYTES=LDS_BYTES;
struct AttnTensors { const bf16* P; bf16* O; };
struct AttnUnit { int bh; int qb; };
struct StaticOrder {
  int vcu;
  __device__ __forceinline__ explicit StaticOrder(int grid,int block):vcu((block%8)*(grid/8)+block/8){}
  __device__ __forceinline__ bool next(int i,AttnUnit&u)const{ if(i>=16)return false; const int s=vcu&7,j=i&3; u.bh=(i>>2)*32+(vcu>>3); u.qb=(j==0)?s:(j==1)?15-s:(j==2)?16+s:31-s; return true; }
};
template<class Sched,int THRL=8> __device__ __forceinline__ void attn_phase(char*lds,const AttnTensors&T,const Sched&S){
  AttnUnit u;
  for(int i=0;S.next(i,u);++i){ const int b=u.bh>>5,v=u.bh&31,hc=v>>1,h=v>>2,vh=v&1;
    attn_unit<THRL>(b,u.qb,T.P+3072+hc*64,T.P+4096+hc*64,T.P+5120+h*128+vh*64,T.O+v*64,lds); }
}
constexpr int SLOTK=8192, SLOTV=16384;
constexpr int L2_K=0, L2_V=3*SLOTK, L2_WS=L2_V+3*SLOTV, L2_OST=L2_WS+NW*64*4, LDS2_BYTES=L2_OST+NW*8192;
template<int THRL> __device__ __forceinline__ void attn_unit2(int b,int qb,const bf16*Q,const bf16*__restrict__ K,const bf16*__restrict__ V,bf16*O,char*shm){
  const int tid=threadIdx.x,lane=tid&63,r32=lane&31,hi=lane>>5; const int wid=__builtin_amdgcn_readfirstlane(tid>>6);
  const long rowbase=(long)b*SEQ; const int q0=qb*QB;
  const bf16*Qw=Q+(rowbase+q0+wid*QBLK)*PP;
  const bf16*Kh=K+rowbase*PP,*Vh=V+rowbase*PP;
  const unsigned lds0=(unsigned)(uintptr_t)shm;
  float*wsf=(float*)(shm+L2_WS)+wid*64;
  const bf16*ksrc=Kh+(long)lane*PP+wid*8;
  const bf16*vsrc=Vh+(long)(16*(wid&3)+(lane>>2))*PP+(wid>>2)*32+(lane&3)*8;
  const unsigned kdst=lds0+L2_K+wid*1024, vdst=lds0+L2_V+wid*1024;
  #define DMA2_K(t,s) glds16(ksrc+(long)(t)*KVBLK*PP,(unsigned)__builtin_amdgcn_readfirstlane(kdst+(s)*SLOTK))
  #define DMA2_V(t,s) do{ glds16(vsrc+(long)(t)*KVBLK*PP,(unsigned)__builtin_amdgcn_readfirstlane(vdst+(s)*SLOTV)); glds16(vsrc+(long)(t)*KVBLK*PP+64,(unsigned)__builtin_amdgcn_readfirstlane(vdst+(s)*SLOTV+8192)); }while(0)
  const int vb0=(int)(lds0+L2_V)+((lane>>4)&1)*32+(lane&3)*8+(4*hi+((lane&15)>>2))*64;
  bf16x8 qr[4];
  #pragma unroll
  for(int d0=0;d0<4;++d0)qr[d0]=*reinterpret_cast<const bf16x8*>(&Qw[(long)r32*PP+d0*16+hi*8]);
  const int NT=(q0+QB)/KVBLK;
  DMA2_K(0,0);DMA2_V(0,0);DMA2_K(1,1);DMA2_V(1,1);
  float mhat=0.f,l_reg=0.f;f32x16 o[4];o[0]=f32x16{};o[1]=f32x16{};o[2]=f32x16{};o[3]=f32x16{};f32x16 negm=f32x16{};asm volatile("":"+v"(negm));
  const int qrel=wid*QBLK+r32;
  int slot=0;
  for(int t=0;t<NT;++t){
    if(t+1<NT){WAIT_BAR(3);}else{WAIT_BAR(0);}
    if(t+2<NT){const int s2=(slot==0)?2:slot-1; DMA2_K(t+2,s2);DMA2_V(t+2,s2);}
    f32x16 p0,p1;
    qkt(p0,p1,shm+L2_K+slot*SLOTK,qr,negm,r32,hi);
    asm volatile("s_nop 15\n\ts_nop 7":"+v"(p0),"+v"(p1));
    if(t>=NT-4)cmask(p0,p1,t-(NT-4),qrel,hi);
    const float rm=rowmax(p0,p1);
    const bool first=(t==0);
    if(first||__any(rm>(float)THRL)){
      const float dl=first?rm:__builtin_fmaxf(rm,0.f); mhat+=dl;
      #pragma unroll
      for(int r=0;r<16;++r){p0[r]-=dl;p1[r]-=dl;}
      #pragma unroll
      for(int r=0;r<16;++r)negm[r]=-mhat;
      asm volatile("":"+v"(negm));
      if(!first){ const float f=__builtin_amdgcn_exp2f(-dl); l_reg*=f; if(hi==0)wsf[r32]=f; asm volatile("s_waitcnt lgkmcnt(0)":::"memory");
        #pragma unroll
        for(int d_=0;d_<4;++d_)
          #pragma unroll
          for(int r=0;r<16;++r)o[d_][r]*=wsf[crow(r,hi)];
        asm volatile("s_waitcnt lgkmcnt(0)":::"memory"); }
    }
    #pragma unroll
    for(int r=0;r<16;++r){p0[r]=__builtin_amdgcn_exp2f(p0[r]);p1[r]=__builtin_amdgcn_exp2f(p1[r]);}
    { float sa=0.f,sb=0.f;
      #pragma unroll
      for(int r=0;r<16;++r){sa+=p0[r];sb+=p1[r];}
      l_reg+=sa+sb; }
    u32x4 pw0,pw1,pw2,pw3;
    pw0=(u32x4){cvtpk_s(p0[0],p0[1]),cvtpk_s(p0[2],p0[3]),cvtpk_s(p0[4],p0[5]),cvtpk_s(p0[6],p0[7])};
    pw1=(u32x4){cvtpk_s(p0[8],p0[9]),cvtpk_s(p0[10],p0[11]),cvtpk_s(p0[12],p0[13]),cvtpk_s(p0[14],p0[15])};
    pw2=(u32x4){cvtpk_s(p1[0],p1[1]),cvtpk_s(p1[2],p1[3]),cvtpk_s(p1[4],p1[5]),cvtpk_s(p1[6],p1[7])};
    pw3=(u32x4){cvtpk_s(p1[8],p1[9]),cvtpk_s(p1[10],p1[11]),cvtpk_s(p1[12],p1[13]),cvtpk_s(p1[14],p1[15])};
    SBAR();
    pv(o,vb0+slot*SLOTV,__builtin_bit_cast(bf16x8,pw0),__builtin_bit_cast(bf16x8,pw1),__builtin_bit_cast(bf16x8,pw2),__builtin_bit_cast(bf16x8,pw3));
    pv(o+2,vb0+slot*SLOTV+8192,__builtin_bit_cast(bf16x8,pw0),__builtin_bit_cast(bf16x8,pw1),__builtin_bit_cast(bf16x8,pw2),__builtin_bit_cast(bf16x8,pw3));
    slot=(slot==2)?0:slot+1;
  }
  {auto rr=__builtin_amdgcn_permlane32_swap(__float_as_uint(l_reg),__float_as_uint(l_reg),false,false);l_reg=__uint_as_float(rr[0])+__uint_as_float(rr[1]);}
  if(hi==0)wsf[32+r32]=l_reg;asm volatile("s_waitcnt lgkmcnt(0)":::"memory");
  float rli[16];
  #pragma unroll
  for(int r=0;r<16;++r)rli[r]=__builtin_amdgcn_rcpf(wsf[32+crow(r,hi)]);
  bf16*Ow=O+(rowbase+q0+wid*QBLK)*OP;
  { bf16*stg=(bf16*)(shm+L2_OST)+wid*4096;
    #pragma unroll
    for(int r=0;r<16;++r){const int orow=crow(r,hi);
      #pragma unroll
      for(int d0=0;d0<4;++d0)stg[orow*128+d0*32+r32]=__float2bfloat16(o[d0][r]*rli[r]);}
    asm volatile("s_waitcnt lgkmcnt(0)":::"memory");
    #pragma unroll
    for(int i=0;i<8;++i){const int row=i*4+(lane>>4),ch=lane&15; const u32x4 v=*(const u32x4*)(stg+row*128+ch*8); ATTN_STORE16(Ow+(long)row*OP+ch*8,v);} }
  asm volatile("s_waitcnt lgkmcnt(0)\n\ts_barrier":::"memory");
  #undef DMA2_K
  #undef DMA2_V
}
struct StaticOrder2 {
  int vcu;
  __device__ __forceinline__ explicit StaticOrder2(int grid,int block):vcu((block%8)*(grid/8)+block/8){}
  __device__ __forceinline__ bool next(int i,AttnUnit&u)const{ if(i>=8)return false; const int s=vcu&7,j=i&3; u.bh=(i>>2)*32+(vcu>>3); u.qb=(j==0)?s:(j==1)?15-s:(j==2)?16+s:31-s; return true; }
};
template<class Sched,int THRL=8> __device__ __forceinline__ void attn_phase2(char*lds,const AttnTensors&T,const Sched&S){
  AttnUnit u;
  for(int i=0;S.next(i,u);++i){ const int b=u.bh>>4,hc=u.bh&15,h=hc>>1;
    attn_unit2<THRL>(b,u.qb,T.P+3072+hc*64,T.P+4096+hc*64,T.P+5120+h*128,T.O+hc*128,lds); }
}

constexpr int NSK=4;
constexpr int L3_K=0, L3_V=NSK*SLOTK, L3_WS=L3_V+3*SLOTV, L3_Q=L3_WS+NW*64*4, LDS3_BYTES=L3_Q+NW*4096;
__device__ __forceinline__ float rowmax_c(const f32x16&p0,const f32x16&p1){
  #define MX3C(a,b,c) __builtin_fmaxf(__builtin_fmaxf((a),(b)),(c))
  float a=MX3C(p0[0],p0[1],p1[0]),b=MX3C(p0[2],p0[3],p1[1]);a=MX3C(a,p1[2],p1[3]);
  #pragma unroll
  for(int r=4;r<16;r+=4){a=MX3C(a,p0[r],p0[r+1]);b=MX3C(b,p0[r+2],p0[r+3]);a=MX3C(a,p1[r],p1[r+1]);b=MX3C(b,p1[r+2],p1[r+3]);}
  #undef MX3C
  const float m=__builtin_fmaxf(a,b);
  auto rr=__builtin_amdgcn_permlane32_swap(__float_as_uint(m),__float_as_uint(m),false,false);
  return __builtin_fmaxf(__uint_as_float(rr[0]),__uint_as_float(rr[1]));
}

__device__ __forceinline__ void qkt4(f32x16&p0,f32x16&p1,lds_cptr kp,lds_cptr qp,const f32x16&negm){
  #define KFR(off) (*(const __attribute__((address_space(3))) bf16x8*)(kp+(off)))
  #define QFR(d0) (*(const __attribute__((address_space(3))) bf16x8*)(qp+(d0)*1024))
  bf16x8 ka=KFR(0),kb=KFR(512),q0=QFR(0),kc=KFR(2048),kd=KFR(2560),q1=QFR(1); SBAR();
  p0=__builtin_amdgcn_mfma_f32_32x32x16_bf16(ka,q0,negm,0,0,0); ka=KFR(4096); SBAR();
  p1=__builtin_amdgcn_mfma_f32_32x32x16_bf16(kb,q0,negm,0,0,0); kb=KFR(4608); q0=QFR(2); SBAR();
  p0=__builtin_amdgcn_mfma_f32_32x32x16_bf16(kc,q1,p0,0,0,0);   kc=KFR(6144); SBAR();
  p1=__builtin_amdgcn_mfma_f32_32x32x16_bf16(kd,q1,p1,0,0,0);   kd=KFR(6656); q1=QFR(3); SBAR();
  p0=__builtin_amdgcn_mfma_f32_32x32x16_bf16(ka,q0,p0,0,0,0); SBAR();
  p1=__builtin_amdgcn_mfma_f32_32x32x16_bf16(kb,q0,p1,0,0,0); SBAR();
  p0=__builtin_amdgcn_mfma_f32_32x32x16_bf16(kc,q1,p0,0,0,0); SBAR();
  p1=__builtin_amdgcn_mfma_f32_32x32x16_bf16(kd,q1,p1,0,0,0); SBAR();
  #undef KFR
  #undef QFR
}
template<int THRL> __device__ __forceinline__ void attn_unit3(int b,int qb,const bf16*Q,const bf16*__restrict__ K,const bf16*__restrict__ V,bf16*O,char*shm){
  const int tid=threadIdx.x,lane=tid&63,r32=lane&31,hi=lane>>5; const int wid=__builtin_amdgcn_readfirstlane(tid>>6);
  const long rowbase=(long)b*SEQ; const int q0=qb*QB;
  const bf16*Qw=Q+(rowbase+q0+wid*QBLK)*PP;
  const bf16*Kh=K+rowbase*PP,*Vh=V+rowbase*PP;
  const unsigned lds0=(unsigned)(uintptr_t)shm;
  float*wsf=(float*)(shm+L3_WS)+wid*64;
  const bf16*ksrc=Kh+(long)lane*PP+wid*8;
  const bf16*vsrc=Vh+(long)(16*(wid&3)+(lane>>2))*PP+(wid>>2)*32+(lane&3)*8;
  const unsigned kdst=lds0+L3_K+wid*1024, vdst=lds0+L3_V+wid*1024;
  #define DMA3_K(t) glds16(ksrc+(long)(t)*KVBLK*PP,(unsigned)__builtin_amdgcn_readfirstlane(kdst+((t)&3)*SLOTK))
  #define DMA3_V(t,s) do{ glds16(vsrc+(long)(t)*KVBLK*PP,(unsigned)__builtin_amdgcn_readfirstlane(vdst+(s)*SLOTV)); glds16(vsrc+(long)(t)*KVBLK*PP+64,(unsigned)__builtin_amdgcn_readfirstlane(vdst+(s)*SLOTV+8192)); }while(0)
  const lds_cptr shm3=(lds_cptr)shm; const lds_cptr kp0=shm3+L3_K+hi*1024+r32*16; const lds_cptr vp0=shm3+L3_V+((lane>>4)&1)*32+(lane&3)*8+(4*hi+((lane&15)>>2))*64;
  const lds_cptr qp=shm3+L3_Q+wid*4096+lane*16;
  { bf16x8 qr[4];
    #pragma unroll
    for(int d0=0;d0<4;++d0)qr[d0]=*reinterpret_cast<const bf16x8*>(&Qw[(long)r32*PP+d0*16+hi*8]);
    #pragma unroll
    for(int d0=0;d0<4;++d0)*(__attribute__((address_space(3))) bf16x8*)((__attribute__((address_space(3))) char*)qp+d0*1024)=qr[d0]; }
  const int NT=(q0+QB)/KVBLK;
  DMA3_K(0);DMA3_V(0,0);DMA3_K(1);DMA3_V(1,1);DMA3_K(2);
  float mhat=0.f;f32x16 lacc=f32x16{};const bf16x8 ones={16256,16256,16256,16256,16256,16256,16256,16256};     f32x16 o[4];o[0]=f32x16{};o[1]=f32x16{};o[2]=f32x16{};o[3]=f32x16{};f32x16 negm=f32x16{};asm volatile("":"+v"(negm));
  const int qrel=wid*QBLK+r32;
  WAIT_BAR(3);
  DMA3_K(3);DMA3_V(2,2);
  f32x16 p0,p1; u32x4 pw0,pw1,pw2,pw3;
  qkt4(p0,p1,kp0,qp,negm);
  if(NT==4)cmask(p0,p1,0,qrel,hi);
  { const float rm=rowmax_c(p0,p1); mhat=rm;
    #pragma unroll
    for(int r=0;r<16;++r){p0[r]=__builtin_amdgcn_exp2f(p0[r]-rm);p1[r]=__builtin_amdgcn_exp2f(p1[r]-rm);}
    #pragma unroll
    for(int r=0;r<16;++r)negm[r]=-mhat;
    asm volatile("":"+v"(negm));
    pw0=(u32x4){cvtpk_s(p0[0],p0[1]),cvtpk_s(p0[2],p0[3]),cvtpk_s(p0[4],p0[5]),cvtpk_s(p0[6],p0[7])};
    pw1=(u32x4){cvtpk_s(p0[8],p0[9]),cvtpk_s(p0[10],p0[11]),cvtpk_s(p0[12],p0[13]),cvtpk_s(p0[14],p0[15])};
    pw2=(u32x4){cvtpk_s(p1[0],p1[1]),cvtpk_s(p1[2],p1[3]),cvtpk_s(p1[4],p1[5]),cvtpk_s(p1[6],p1[7])};
    pw3=(u32x4){cvtpk_s(p1[8],p1[9]),cvtpk_s(p1[10],p1[11]),cvtpk_s(p1[12],p1[13]),cvtpk_s(p1[14],p1[15])}; }
  int vs=0;
  #define VFL(dq,ks) ({ const s16x4 lo_=vtr(vp_+((dq)*4096+(ks)*1024)),hi_=vtr(vp_+((dq)*4096+(ks)*1024+512)); (bf16x8){lo_[0],lo_[1],lo_[2],lo_[3],hi_[0],hi_[1],hi_[2],hi_[3]}; })
  u32x4 n0=(u32x4){0u,0u,0u,0u},n1=n0,n2=n0,n3=n0;
  for(int t2=0;t2<NT;t2+=2){
   { const int t=t2;
    const bool more=(t+1<NT);
    if(t>0){
      if(t+2<NT){WAIT_BAR(3);}else if(more){WAIT_BAR(2);}else{WAIT_BAR(0);}
      if(t+3<NT)DMA3_K(t+3);
      if(t+2<NT){const int s2=(vs==0)?2:vs-1; DMA3_V(t+2,s2);}
    }
    bool resc=false;
    if(more){
      qkt4(p0,p1,kp0+((t+1)&3)*SLOTK,qp,negm);
      if(t+1>=NT-4)cmask(p0,p1,t+1-(NT-4),qrel,hi);
      const float rm=rowmax_c(p0,p1);
      if(__builtin_expect(__any(rm>(float)THRL),0)){ const float dl=__builtin_fmaxf(rm,0.f); mhat+=dl;
        #pragma unroll
        for(int r=0;r<16;++r){p0[r]-=dl;p1[r]-=dl;}
        #pragma unroll
        for(int r=0;r<16;++r)negm[r]=-mhat;
        asm volatile("":"+v"(negm));
        const float f=__builtin_amdgcn_exp2f(-dl); if(hi==0)wsf[r32]=f; resc=true; }
    }
    const lds_cptr vp_=vp0+vs*SLOTV;
    bf16x8 vf0=VFL(0,0),vf1=VFL(1,0),vf2=VFL(2,0),vf3=VFL(3,0);

    SBAR();
    o[0]=__builtin_amdgcn_mfma_f32_32x32x16_bf16(__builtin_bit_cast(bf16x8,pw0),vf0,o[0],0,0,0); vf0=VFL(0,1); asm volatile("":"+v"(p0)); { const float e0=__builtin_amdgcn_exp2f(p0[0]),e1=__builtin_amdgcn_exp2f(p0[1]); n0[0]=cvtpk_s(e0,e1); } asm volatile("":"+v"(n0)); SBAR();
    o[1]=__builtin_amdgcn_mfma_f32_32x32x16_bf16(__builtin_bit_cast(bf16x8,pw0),vf1,o[1],0,0,0); vf1=VFL(1,1); asm volatile("":"+v"(p0)); { const float e0=__builtin_amdgcn_exp2f(p0[2]),e1=__builtin_amdgcn_exp2f(p0[3]); n0[1]=cvtpk_s(e0,e1); } asm volatile("":"+v"(n0)); SBAR();
    o[2]=__builtin_amdgcn_mfma_f32_32x32x16_bf16(__builtin_bit_cast(bf16x8,pw0),vf2,o[2],0,0,0); vf2=VFL(2,1); asm volatile("":"+v"(p0)); { const float e0=__builtin_amdgcn_exp2f(p0[4]),e1=__builtin_amdgcn_exp2f(p0[5]); n0[2]=cvtpk_s(e0,e1); } asm volatile("":"+v"(n0)); SBAR();
    o[3]=__builtin_amdgcn_mfma_f32_32x32x16_bf16(__builtin_bit_cast(bf16x8,pw0),vf3,o[3],0,0,0); vf3=VFL(3,1); asm volatile("":"+v"(p0)); { const float e0=__builtin_amdgcn_exp2f(p0[6]),e1=__builtin_amdgcn_exp2f(p0[7]); n0[3]=cvtpk_s(e0,e1); } asm volatile("":"+v"(n0)); SBAR();
    lacc=__builtin_amdgcn_mfma_f32_32x32x16_bf16(__builtin_bit_cast(bf16x8,pw0),ones,lacc,0,0,0); SBAR();
    o[0]=__builtin_amdgcn_mfma_f32_32x32x16_bf16(__builtin_bit_cast(bf16x8,pw1),vf0,o[0],0,0,0); vf0=VFL(0,2); asm volatile("":"+v"(p0)); { const float e0=__builtin_amdgcn_exp2f(p0[8]),e1=__builtin_amdgcn_exp2f(p0[9]); n1[0]=cvtpk_s(e0,e1); } asm volatile("":"+v"(n1)); SBAR();
    o[1]=__builtin_amdgcn_mfma_f32_32x32x16_bf16(__builtin_bit_cast(bf16x8,pw1),vf1,o[1],0,0,0); vf1=VFL(1,2); asm volatile("":"+v"(p0)); { const float e0=__builtin_amdgcn_exp2f(p0[10]),e1=__builtin_amdgcn_exp2f(p0[11]); n1[1]=cvtpk_s(e0,e1); } asm volatile("":"+v"(n1)); SBAR();
    o[2]=__builtin_amdgcn_mfma_f32_32x32x16_bf16(__builtin_bit_cast(bf16x8,pw1),vf2,o[2],0,0,0); vf2=VFL(2,2); asm volatile("":"+v"(p0)); { const float e0=__builtin_amdgcn_exp2f(p0[12]),e1=__builtin_amdgcn_exp2f(p0[13]); n1[2]=cvtpk_s(e0,e1); } asm volatile("":"+v"(n1)); SBAR();
    o[3]=__builtin_amdgcn_mfma_f32_32x32x16_bf16(__builtin_bit_cast(bf16x8,pw1),vf3,o[3],0,0,0); vf3=VFL(3,2); asm volatile("":"+v"(p0)); { const float e0=__builtin_amdgcn_exp2f(p0[14]),e1=__builtin_amdgcn_exp2f(p0[15]); n1[3]=cvtpk_s(e0,e1); } asm volatile("":"+v"(n1)); SBAR();
    lacc=__builtin_amdgcn_mfma_f32_32x32x16_bf16(__builtin_bit_cast(bf16x8,pw1),ones,lacc,0,0,0); SBAR();
    o[0]=__builtin_amdgcn_mfma_f32_32x32x16_bf16(__builtin_bit_cast(bf16x8,pw2),vf0,o[0],0,0,0); vf0=VFL(0,3); asm volatile("":"+v"(p1)); { const float e0=__builtin_amdgcn_exp2f(p1[0]),e1=__builtin_amdgcn_exp2f(p1[1]); n2[0]=cvtpk_s(e0,e1); } asm volatile("":"+v"(n2)); SBAR();
    o[1]=__builtin_amdgcn_mfma_f32_32x32x16_bf16(__builtin_bit_cast(bf16x8,pw2),vf1,o[1],0,0,0); vf1=VFL(1,3); asm volatile("":"+v"(p1)); { const float e0=__builtin_amdgcn_exp2f(p1[2]),e1=__builtin_amdgcn_exp2f(p1[3]); n2[1]=cvtpk_s(e0,e1); } asm volatile("":"+v"(n2)); SBAR();
    o[2]=__builtin_amdgcn_mfma_f32_32x32x16_bf16(__builtin_bit_cast(bf16x8,pw2),vf2,o[2],0,0,0); vf2=VFL(2,3); asm volatile("":"+v"(p1)); { const float e0=__builtin_amdgcn_exp2f(p1[4]),e1=__builtin_amdgcn_exp2f(p1[5]); n2[2]=cvtpk_s(e0,e1); } asm volatile("":"+v"(n2)); SBAR();
    o[3]=__builtin_amdgcn_mfma_f32_32x32x16_bf16(__builtin_bit_cast(bf16x8,pw2),vf3,o[3],0,0,0); vf3=VFL(3,3); asm volatile("":"+v"(p1)); { const float e0=__builtin_amdgcn_exp2f(p1[6]),e1=__builtin_amdgcn_exp2f(p1[7]); n2[3]=cvtpk_s(e0,e1); } asm volatile("":"+v"(n2)); SBAR();
    lacc=__builtin_amdgcn_mfma_f32_32x32x16_bf16(__builtin_bit_cast(bf16x8,pw2),ones,lacc,0,0,0); SBAR();
    o[0]=__builtin_amdgcn_mfma_f32_32x32x16_bf16(__builtin_bit_cast(bf16x8,pw3),vf0,o[0],0,0,0); asm volatile("":"+v"(p1)); { const float e0=__builtin_amdgcn_exp2f(p1[8]),e1=__builtin_amdgcn_exp2f(p1[9]); n3[0]=cvtpk_s(e0,e1); } asm volatile("":"+v"(n3)); SBAR();
    o[1]=__builtin_amdgcn_mfma_f32_32x32x16_bf16(__builtin_bit_cast(bf16x8,pw3),vf1,o[1],0,0,0); asm volatile("":"+v"(p1)); { const float e0=__builtin_amdgcn_exp2f(p1[10]),e1=__builtin_amdgcn_exp2f(p1[11]); n3[1]=cvtpk_s(e0,e1); } asm volatile("":"+v"(n3)); SBAR();
    o[2]=__builtin_amdgcn_mfma_f32_32x32x16_bf16(__builtin_bit_cast(bf16x8,pw3),vf2,o[2],0,0,0); asm volatile("":"+v"(p1)); { const float e0=__builtin_amdgcn_exp2f(p1[12]),e1=__builtin_amdgcn_exp2f(p1[13]); n3[2]=cvtpk_s(e0,e1); } asm volatile("":"+v"(n3)); SBAR();
    o[3]=__builtin_amdgcn_mfma_f32_32x32x16_bf16(__builtin_bit_cast(bf16x8,pw3),vf3,o[3],0,0,0); asm volatile("":"+v"(p1)); { const float e0=__builtin_amdgcn_exp2f(p1[14]),e1=__builtin_amdgcn_exp2f(p1[15]); n3[3]=cvtpk_s(e0,e1); } asm volatile("":"+v"(n3)); SBAR();
    lacc=__builtin_amdgcn_mfma_f32_32x32x16_bf16(__builtin_bit_cast(bf16x8,pw3),ones,lacc,0,0,0); SBAR();
    if(resc){ asm volatile("s_waitcnt lgkmcnt(0)":::"memory");
      #pragma unroll
      for(int d_=0;d_<4;++d_)
        #pragma unroll
        for(int r=0;r<16;++r)o[d_][r]*=wsf[crow(r,hi)];
      #pragma unroll
      for(int r=0;r<16;++r)lacc[r]*=wsf[crow(r,hi)];
      asm volatile("s_waitcnt lgkmcnt(0)":::"memory"); }
    vs=(vs==2)?0:vs+1;
     }
   { const int t=t2+1;
    const bool more=(t+1<NT);
    if(t>0){
      if(t+2<NT){WAIT_BAR(3);}else if(more){WAIT_BAR(2);}else{WAIT_BAR(0);}
      if(t+3<NT)DMA3_K(t+3);
      if(t+2<NT){const int s2=(vs==0)?2:vs-1; DMA3_V(t+2,s2);}
    }
    bool resc=false;
    if(more){
      qkt4(p0,p1,kp0+((t+1)&3)*SLOTK,qp,negm);
      if(t+1>=NT-4)cmask(p0,p1,t+1-(NT-4),qrel,hi);
      const float rm=rowmax_c(p0,p1);
      if(__builtin_expect(__any(rm>(float)THRL),0)){ const float dl=__builtin_fmaxf(rm,0.f); mhat+=dl;
        #pragma unroll
        for(int r=0;r<16;++r){p0[r]-=dl;p1[r]-=dl;}
        #pragma unroll
        for(int r=0;r<16;++r)negm[r]=-mhat;
        asm volatile("":"+v"(negm));
        const float f=__builtin_amdgcn_exp2f(-dl); if(hi==0)wsf[r32]=f; resc=true; }
    }
    const lds_cptr vp_=vp0+vs*SLOTV;
    bf16x8 vf0=VFL(0,0),vf1=VFL(1,0),vf2=VFL(2,0),vf3=VFL(3,0);

    SBAR();
    o[0]=__builtin_amdgcn_mfma_f32_32x32x16_bf16(__builtin_bit_cast(bf16x8,n0),vf0,o[0],0,0,0); vf0=VFL(0,1); asm volatile("":"+v"(p0)); { const float e0=__builtin_amdgcn_exp2f(p0[0]),e1=__builtin_amdgcn_exp2f(p0[1]); pw0[0]=cvtpk_s(e0,e1); } asm volatile("":"+v"(pw0)); SBAR();
    o[1]=__builtin_amdgcn_mfma_f32_32x32x16_bf16(__builtin_bit_cast(bf16x8,n0),vf1,o[1],0,0,0); vf1=VFL(1,1); asm volatile("":"+v"(p0)); { const float e0=__builtin_amdgcn_exp2f(p0[2]),e1=__builtin_amdgcn_exp2f(p0[3]); pw0[1]=cvtpk_s(e0,e1); } asm volatile("":"+v"(pw0)); SBAR();
    o[2]=__builtin_amdgcn_mfma_f32_32x32x16_bf16(__builtin_bit_cast(bf16x8,n0),vf2,o[2],0,0,0); vf2=VFL(2,1); asm volatile("":"+v"(p0)); { const float e0=__builtin_amdgcn_exp2f(p0[4]),e1=__builtin_amdgcn_exp2f(p0[5]); pw0[2]=cvtpk_s(e0,e1); } asm volatile("":"+v"(pw0)); SBAR();
    o[3]=__builtin_amdgcn_mfma_f32_32x32x16_bf16(__builtin_bit_cast(bf16x8,n0),vf3,o[3],0,0,0); vf3=VFL(3,1); asm volatile("":"+v"(p0)); { const float e0=__builtin_amdgcn_exp2f(p0[6]),e1=__builtin_amdgcn_exp2f(p0[7]); pw0[3]=cvtpk_s(e0,e1); } asm volatile("":"+v"(pw0)); SBAR();
    lacc=__builtin_amdgcn_mfma_f32_32x32x16_bf16(__builtin_bit_cast(bf16x8,n0),ones,lacc,0,0,0); SBAR();
    o[0]=__builtin_amdgcn_mfma_f32_32x32x16_bf16(__builtin_bit_cast(bf16x8,n1),vf0,o[0],0,0,0); vf0=VFL(0,2); asm volatile("":"+v"(p0)); { const float e0=__builtin_amdgcn_exp2f(p0[8]),e1=__builtin_amdgcn_exp2f(p0[9]); pw1[0]=cvtpk_s(e0,e1); } asm volatile("":"+v"(pw1)); SBAR();
    o[1]=__builtin_amdgcn_mfma_f32_32x32x16_bf16(__builtin_bit_cast(bf16x8,n1),vf1,o[1],0,0,0); vf1=VFL(1,2); asm volatile("":"+v"(p0)); { const float e0=__builtin_amdgcn_exp2f(p0[10]),e1=__builtin_amdgcn_exp2f(p0[11]); pw1[1]=cvtpk_s(e0,e1); } asm volatile("":"+v"(pw1)); SBAR();
    o[2]=__builtin_amdgcn_mfma_f32_32x32x16_bf16(__builtin_bit_cast(bf16x8,n1),vf2,o[2],0,0,0); vf2=VFL(2,2); asm volatile("":"+v"(p0)); { const float e0=__builtin_amdgcn_exp2f(p0[12]),e1=__builtin_amdgcn_exp2f(p0[13]); pw1[2]=cvtpk_s(e0,e1); } asm volatile("":"+v"(pw1)); SBAR();
    o[3]=__builtin_amdgcn_mfma_f32_32x32x16_bf16(__builtin_bit_cast(bf16x8,n1),vf3,o[3],0,0,0); vf3=VFL(3,2); asm volatile("":"+v"(p0)); { const float e0=__builtin_amdgcn_exp2f(p0[14]),e1=__builtin_amdgcn_exp2f(p0[15]); pw1[3]=cvtpk_s(e0,e1); } asm volatile("":"+v"(pw1)); SBAR();
    lacc=__builtin_amdgcn_mfma_f32_32x32x16_bf16(__builtin_bit_cast(bf16x8,n1),ones,lacc,0,0,0); SBAR();
    o[0]=__builtin_amdgcn_mfma_f32_32x32x16_bf16(__builtin_bit_cast(bf16x8,n2),vf0,o[0],0,0,0); vf0=VFL(0,3); asm volatile("":"+v"(p1)); { const float e0=__builtin_amdgcn_exp2f(p1[0]),e1=__builtin_amdgcn_exp2f(p1[1]); pw2[0]=cvtpk_s(e0,e1); } asm volatile("":"+v"(pw2)); SBAR();
    o[1]=__builtin_amdgcn_mfma_f32_32x32x16_bf16(__builtin_bit_cast(bf16x8,n2),vf1,o[1],0,0,0); vf1=VFL(1,3); asm volatile("":"+v"(p1)); { const float e0=__builtin_amdgcn_exp2f(p1[2]),e1=__builtin_amdgcn_exp2f(p1[3]); pw2[1]=cvtpk_s(e0,e1); } asm volatile("":"+v"(pw2)); SBAR();
    o[2]=__builtin_amdgcn_mfma_f32_32x32x16_bf16(__builtin_bit_cast(bf16x8,n2),vf2,o[2],0,0,0); vf2=VFL(2,3); asm volatile("":"+v"(p1)); { const float e0=__builtin_amdgcn_exp2f(p1[4]),e1=__builtin_amdgcn_exp2f(p1[5]); pw2[2]=cvtpk_s(e0,e1); } asm volatile("":"+v"(pw2)); SBAR();
    o[3]=__builtin_amdgcn_mfma_f32_32x32x16_bf16(__builtin_bit_cast(bf16x8,n2),vf3,o[3],0,0,0); vf3=VFL(3,3); asm volatile("":"+v"(p1)); { const float e0=__builtin_amdgcn_exp2f(p1[6]),e1=__builtin_amdgcn_exp2f(p1[7]); pw2[3]=cvtpk_s(e0,e1); } asm volatile("":"+v"(pw2)); SBAR();
    lacc=__builtin_amdgcn_mfma_f32_32x32x16_bf16(__builtin_bit_cast(bf16x8,n2),ones,lacc,0,0,0); SBAR();
    o[0]=__builtin_amdgcn_mfma_f32_32x32x16_bf16(__builtin_bit_cast(bf16x8,n3),vf0,o[0],0,0,0); asm volatile("":"+v"(p1)); { const float e0=__builtin_amdgcn_exp2f(p1[8]),e1=__builtin_amdgcn_exp2f(p1[9]); pw3[0]=cvtpk_s(e0,e1); } asm volatile("":"+v"(pw3)); SBAR();
    o[1]=__builtin_amdgcn_mfma_f32_32x32x16_bf16(__builtin_bit_cast(bf16x8,n3),vf1,o[1],0,0,0); asm volatile("":"+v"(p1)); { const float e0=__builtin_amdgcn_exp2f(p1[10]),e1=__builtin_amdgcn_exp2f(p1[11]); pw3[1]=cvtpk_s(e0,e1); } asm volatile("":"+v"(pw3)); SBAR();
    o[2]=__builtin_amdgcn_mfma_f32_32x32x16_bf16(__builtin_bit_cast(bf16x8,n3),vf2,o[2],0,0,0); asm volatile("":"+v"(p1)); { const float e0=__builtin_amdgcn_exp2f(p1[12]),e1=__builtin_amdgcn_exp2f(p1[13]); pw3[2]=cvtpk_s(e0,e1); } asm volatile("":"+v"(pw3)); SBAR();
    o[3]=__builtin_amdgcn_mfma_f32_32x32x16_bf16(__builtin_bit_cast(bf16x8,n3),vf3,o[3],0,0,0); asm volatile("":"+v"(p1)); { const float e0=__builtin_amdgcn_exp2f(p1[14]),e1=__builtin_amdgcn_exp2f(p1[15]); pw3[3]=cvtpk_s(e0,e1); } asm volatile("":"+v"(pw3)); SBAR();
    lacc=__builtin_amdgcn_mfma_f32_32x32x16_bf16(__builtin_bit_cast(bf16x8,n3),ones,lacc,0,0,0); SBAR();
    if(resc){ asm volatile("s_waitcnt lgkmcnt(0)":::"memory");
      #pragma unroll
      for(int d_=0;d_<4;++d_)
        #pragma unroll
        for(int r=0;r<16;++r)o[d_][r]*=wsf[crow(r,hi)];
      #pragma unroll
      for(int r=0;r<16;++r)lacc[r]*=wsf[crow(r,hi)];
      asm volatile("s_waitcnt lgkmcnt(0)":::"memory"); }
    vs=(vs==2)?0:vs+1;
     }
  }
  #undef VFL
  WAIT_BAR(0);
  float rli[16];
  #pragma unroll
  for(int r=0;r<16;++r)rli[r]=__builtin_amdgcn_rcpf(lacc[r]);
  bf16*Ow=O+(rowbase+q0+wid*QBLK)*OP;
  { int ln=lane; asm volatile("":"+v"(ln));
    const int r32e=ln&31,hie=ln>>5;
    bf16*stg=(bf16*)shm+wid*4096;
    bf16*sw=stg+4*hie*128+r32e;
    #pragma unroll
    for(int r=0;r<16;++r){
      #pragma unroll
      for(int d0=0;d0<4;++d0)sw[((r&3)+8*(r>>2))*128+d0*32]=__float2bfloat16(o[d0][r]*rli[r]);}
    asm volatile("s_waitcnt lgkmcnt(0)":::"memory");
    const bf16*sr=stg+(ln>>4)*128+(ln&15)*8; bf16*gw_=Ow+(long)(ln>>4)*OP+(ln&15)*8;
    #pragma unroll
    for(int i=0;i<8;++i){ const u32x4 v=*(const u32x4*)(sr+i*4*128); ATTN_STORE16(gw_+(long)i*4*OP,v);} }
  asm volatile("s_waitcnt lgkmcnt(0)\n\ts_barrier":::"memory");
  #undef DMA3_K
  #undef DMA3_V
}
template<class Sched,int THRL=8> __device__ __forceinline__ void attn_phase3(char*lds,const AttnTensors&T,const Sched&S){
  AttnUnit u;
  for(int i=0;S.next(i,u);++i){ const int b=u.bh>>4,hc=u.bh&15,h=hc>>1;
    attn_unit3<THRL>(b,u.qb,T.P+3072+hc*64,T.P+4096+hc*64,T.P+5120+h*128,T.O+hc*128,lds); }
}
#undef SBAR
#undef WAIT_BAR
}
namespace cg = cooperative_groups;
constexpr int NWAVES = 8;
constexpr int BATCH = 4, SEQ = 8192, DMODEL = 2048, FFN = 5632, INC = 6144;
constexpr int M = BATCH * SEQ;
constexpr float RMS_EPS = 1e-6f;
constexpr size_t MiB = 1u << 20;
constexpr size_t WS_WGU1 = 2 * MiB, WS_WD1 = 46 * MiB, WS_WIN = 68 * MiB, WS_WOUT = 92 * MiB, WS_WGU2 = 100 * MiB, WS_WD2 = 144 * MiB;
constexpr size_t WS_XN = 168 * MiB, WS_O = 296 * MiB, WS_H = 424 * MiB, WS_Y = 808 * MiB, WS_END = 936 * MiB;
constexpr int LDS_BYTES = 147456 + 1024;
constexpr int MISC_OFF = 147456;
constexpr size_t WS_CTL = 0, CTL_ZERO_BYTES = 640 * 1024;
constexpr size_t WS_CNT = 64 * 1024, WS_SSQ3 = 512 * 1024;
constexpr size_t WS_SSQ0 = 128 * 1024, WS_SSQ1 = 256 * 1024, WS_SSQ2 = 384 * 1024;
constexpr int CW_BAR = 1024;
#ifndef REP_ATTN
#define REP_ATTN 1
#endif
#ifndef REP_LIGHT
#define REP_LIGHT 1
#endif
#ifndef REP_P0
#define REP_P0 1
#endif

#define GAS __attribute__((address_space(1)))
#define LAS __attribute__((address_space(3)))
typedef unsigned short bf16;
typedef unsigned v4u __attribute__((ext_vector_type(4)));
typedef float f32x4 __attribute__((ext_vector_type(4)));
#define LDS_WAIT() asm volatile("s_waitcnt lgkmcnt(0)" ::: "memory")
__device__ __forceinline__ unsigned f2bf(float f) { unsigned u = __builtin_bit_cast(unsigned, f); return (u + 0x7fffu + ((u >> 16) & 1u)) >> 16; }
__device__ __forceinline__ unsigned pk2(float lo, float hi) { return f2bf(lo) | (f2bf(hi) << 16); }
__device__ __forceinline__ float bflo(unsigned w) { return __uint_as_float(w << 16); }
__device__ __forceinline__ float bfhi(unsigned w) { return __uint_as_float(w & 0xffff0000u); }
__device__ __forceinline__ float wave_sum(float v) {
#pragma unroll
    for (int o = 1; o < 64; o <<= 1) v += __shfl_xor(v, o);
    return v;
}
__device__ __forceinline__ void p0_transpose_item(const float* W, int K, int N, bf16* WT, int mode, LAS float* scr, int item, int lane, const float* g = nullptr) {
    const int nblk = N / 32, kb = item / nblk, nb = item % nblk, k0 = 64 * kb, n0 = 32 * nb;
    const int drow0 = (mode == 0) ? n0 : (256 * (n0 >> 7) + (n0 & 127) + (mode == 2 ? 128 : 0));
#pragma unroll 8
    for (int i = 0; i < 32; ++i) { const int kk = 2 * i + (lane >> 5); const float gk = g ? g[k0 + kk] : 1.0f; scr[kk * 33 + (lane & 31)] = W[(size_t)(k0 + kk) * N + n0 + (lane & 31)] * gk; }
    LDS_WAIT(); asm volatile("" ::: "memory");
    const int c = lane & 7;
#pragma unroll
    for (int j = 0; j < 4; ++j) { const int n = (lane >> 3) + 8 * j; const LAS float* s = scr + (8 * c) * 33 + n;
        v4u o; o.x = pk2(s[0 * 33], s[1 * 33]); o.y = pk2(s[2 * 33], s[3 * 33]); o.z = pk2(s[4 * 33], s[5 * 33]); o.w = pk2(s[6 * 33], s[7 * 33]);
        *(GAS v4u*)(WT + (size_t)(drow0 + n) * K + k0 + 8 * c) = o; }
    LDS_WAIT(); asm volatile("" ::: "memory");
}
__device__ __forceinline__ void rms_row_to_bf16(const float* xrow, const float* g, bf16* orow, float* ssq_row, int lane) {
    const GAS f32x4* xr = (const GAS f32x4*)xrow + lane; (void)g;
    f32x4 v[8]; float s = 0.f;
#pragma unroll
    for (int j = 0; j < 8; ++j) { v[j] = xr[64 * j]; s += (v[j].x * v[j].x + v[j].y * v[j].y) + (v[j].z * v[j].z + v[j].w * v[j].w); }
    s = wave_sum(s); if (lane == 0) *ssq_row = s;
    GAS unsigned long long* o8 = (GAS unsigned long long*)orow + lane;
#pragma unroll
    for (int j = 0; j < 8; ++j) { const f32x4 y = v[j];
        o8[64 * j] = (unsigned long long)pk2(y.x, y.y) | ((unsigned long long)pk2(y.z, y.w) << 32); }
}
__device__ __forceinline__ void rms_row_f32(const float* xrow, const float* g, float* orow, int lane) {
    const GAS f32x4* xr = (const GAS f32x4*)xrow + lane; const GAS f32x4* gr = (const GAS f32x4*)g + lane;
    f32x4 v[8]; float s = 0.f;
#pragma unroll
    for (int j = 0; j < 8; ++j) { v[j] = xr[64 * j]; s += (v[j].x * v[j].x + v[j].y * v[j].y) + (v[j].z * v[j].z + v[j].w * v[j].w); }
    const float rstd = 1.0f / sqrtf(wave_sum(s) * (1.f / DMODEL) + RMS_EPS);
    GAS f32x4* o = (GAS f32x4*)orow + lane;
#pragma unroll
    for (int j = 0; j < 8; ++j) { const f32x4 gv = gr[64 * j]; o[64 * j] = v[j] * rstd * gv; }
}
__device__ __forceinline__ void mix_row(const bf16* P, const bf16* O, bf16* Y, const float* convw, const float* subln, float lam, int m, int lane) {
    const int t = m & (SEQ - 1);
    const bf16* pr = P + (size_t)m * INC; bf16* yr = Y + (size_t)m * DMODEL;
#pragma unroll
    for (int i = 0; i < 2; ++i) {
        const int j = lane * 8 + 512 * i;
        const v4u bq = *(const GAS v4u*)(pr + j), c0 = *(const GAS v4u*)(pr + 1024 + j), x0 = *(const GAS v4u*)(pr + 2048 + j);
        v4u c1 = (v4u){0u, 0u, 0u, 0u}, x1 = c1, c2 = c1, x2 = c1;
        if (t >= 1) { c1 = *(const GAS v4u*)(pr - INC + 1024 + j); x1 = *(const GAS v4u*)(pr - INC + 2048 + j); }
        if (t >= 2) { c2 = *(const GAS v4u*)(pr - 2 * INC + 1024 + j); x2 = *(const GAS v4u*)(pr - 2 * INC + 2048 + j); }
        const f32x4 wa0 = *(const GAS f32x4*)(convw + j), wa1 = *(const GAS f32x4*)(convw + j + 4);
        const f32x4 wb0 = *(const GAS f32x4*)(convw + 1024 + j), wb1 = *(const GAS f32x4*)(convw + 1024 + j + 4);
        const f32x4 wc0 = *(const GAS f32x4*)(convw + 2048 + j), wc1 = *(const GAS f32x4*)(convw + 2048 + j + 4);
        v4u o;
#define MIXPAIR(q, WA, WB, WC, e0, e1) pk2( \
            bflo(bq[q]) * (WA[e0] * (bflo(c2[q]) * bflo(x2[q])) + WB[e0] * (bflo(c1[q]) * bflo(x1[q])) + WC[e0] * (bflo(c0[q]) * bflo(x0[q]))), \
            bfhi(bq[q]) * (WA[e1] * (bfhi(c2[q]) * bfhi(x2[q])) + WB[e1] * (bfhi(c1[q]) * bfhi(x1[q])) + WC[e1] * (bfhi(c0[q]) * bfhi(x0[q]))))
        o.x = MIXPAIR(0, wa0, wb0, wc0, 0, 1); o.y = MIXPAIR(1, wa0, wb0, wc0, 2, 3); o.z = MIXPAIR(2, wa1, wb1, wc1, 0, 1); o.w = MIXPAIR(3, wa1, wb1, wc1, 2, 3);
#undef MIXPAIR
        *(GAS v4u*)(yr + j) = o;
    }
    {
        const int h = lane >> 3, d0 = (lane & 7) * 16;
        const bf16* o1p = O + (size_t)m * DMODEL + h * 256 + d0; const bf16* o2p = o1p + 128;
        const v4u a0 = *(const GAS v4u*)o1p, a1 = *(const GAS v4u*)(o1p + 8), b0 = *(const GAS v4u*)o2p, b1 = *(const GAS v4u*)(o2p + 8);
        float o[16]; float ss = 0.f;
#pragma unroll
        for (int q = 0; q < 4; ++q) { o[2 * q] = bflo(a0[q]) - lam * bflo(b0[q]); o[2 * q + 1] = bfhi(a0[q]) - lam * bfhi(b0[q]);
            o[8 + 2 * q] = bflo(a1[q]) - lam * bflo(b1[q]); o[8 + 2 * q + 1] = bfhi(a1[q]) - lam * bfhi(b1[q]); }
#pragma unroll
        for (int e = 0; e < 16; ++e) ss += o[e] * o[e];
        ss += __shfl_xor(ss, 1); ss += __shfl_xor(ss, 2); ss += __shfl_xor(ss, 4);
        const float rs = 0.8f / sqrtf(ss * (1.f / 128.f) + RMS_EPS);
        const f32x4 g0 = *(const GAS f32x4*)(subln + d0), g1 = *(const GAS f32x4*)(subln + d0 + 4), g2 = *(const GAS f32x4*)(subln + d0 + 8), g3 = *(const GAS f32x4*)(subln + d0 + 12);
        v4u w0, w1;
        w0.x = pk2(o[0] * rs * g0[0], o[1] * rs * g0[1]); w0.y = pk2(o[2] * rs * g0[2], o[3] * rs * g0[3]); w0.z = pk2(o[4] * rs * g1[0], o[5] * rs * g1[1]); w0.w = pk2(o[6] * rs * g1[2], o[7] * rs * g1[3]);
        w1.x = pk2(o[8] * rs * g2[0], o[9] * rs * g2[1]); w1.y = pk2(o[10] * rs * g2[2], o[11] * rs * g2[3]); w1.z = pk2(o[12] * rs * g3[0], o[13] * rs * g3[1]); w1.w = pk2(o[14] * rs * g3[2], o[15] * rs * g3[3]);
        bf16* yo = yr + 1024 + h * 128 + d0;
        *(GAS v4u*)yo = w0; *(GAS v4u*)(yo + 8) = w1;
    }
}

#define XB_TMO      128
#define XB_XCNT(j)  (256  + 64 * (j))
#define XB_XSUB(j)  (1280 + 64 * (j))
#define XB_XGEN(j)  (2304 + 64 * (j))
#define XB_TOP      3328
#define XB_TOPGEN   3392
#define XCD_BAR_WORDS 3456
#define XB_SPIN_CAP (1u << 18)

__device__ __forceinline__ unsigned xb_ld(unsigned* p)              { return __hip_atomic_load(p, __ATOMIC_RELAXED, __HIP_MEMORY_SCOPE_AGENT); }
__device__ __forceinline__ unsigned xb_add(unsigned* p, unsigned v) { return __hip_atomic_fetch_add(p, v, __ATOMIC_RELAXED, __HIP_MEMORY_SCOPE_AGENT); }
__device__ __forceinline__ unsigned xb_xcc_id() { return (unsigned)__builtin_amdgcn_s_getreg((3 << 11) | 20) & 0xFu; }
#define XB_SPIN(cond, bar) do { unsigned _sp = 0; while (cond) { __builtin_amdgcn_s_sleep(1); \
    if ((++_sp & 255u) == 0u) { if (xb_ld(&(bar)[XB_TMO])) break; if (_sp > XB_SPIN_CAP) { atomicAdd(&(bar)[XB_TMO], 1u); break; } } } } while (0)

struct XcdBarrier {
    unsigned* bar; unsigned x;
    volatile LAS unsigned* st;
};

__device__ __forceinline__ XcdBarrier xcd_barrier_post(unsigned* bar, volatile LAS unsigned* st) {
    XcdBarrier b; b.bar = bar; b.x = xb_xcc_id(); b.st = st;
    if (threadIdx.x == 0) (void)xb_add(&bar[XB_XCNT(b.x)], 1u);
    return b;
}
__device__ __forceinline__ void xcd_barrier_complete(unsigned* bar, unsigned x, unsigned& nloc, unsigned& nx) {
    const unsigned G = gridDim.x * gridDim.y * gridDim.z;
    unsigned sum, cnt, mine, sp = 0u;
    for (;;) {
        sum = 0u; cnt = 0u; mine = 0u;
#pragma unroll
        for (unsigned j = 0; j < 16; ++j) { const unsigned c = xb_ld(&bar[XB_XCNT(j)]); sum += c; cnt += (c > 0u) ? 1u : 0u; mine = (j == x) ? c : mine; }
        if (sum == G) break;
        __builtin_amdgcn_s_sleep(1);
        if ((++sp & 255u) == 0u) { if (xb_ld(&bar[XB_TMO])) break; if (sp > XB_SPIN_CAP) { atomicAdd(&bar[XB_TMO], 1u); break; } }
    }
    nloc = mine > 0u ? mine : 1u; nx = cnt > 0u ? cnt : 1u;
}

__device__ __forceinline__ void xcd_barrier(const XcdBarrier& b) {
    asm volatile("s_waitcnt vmcnt(0)" ::: "memory");
    __syncthreads();
    if (threadIdx.x == 0) {
        unsigned* bar = b.bar;
        __builtin_amdgcn_s_waitcnt(0);
        unsigned nloc = b.st[0], nx = b.st[1];
        if (nloc == 0u) { xcd_barrier_complete(bar, b.x, nloc, nx); b.st[0] = nloc; b.st[1] = nx; }
        const unsigned old = xb_add(&bar[XB_XSUB(b.x)], 1u);
        const unsigned gen = old / nloc;
        if (old + 1u == (gen + 1u) * nloc) {
            __builtin_amdgcn_fence(__ATOMIC_RELEASE, "agent");
            asm volatile("s_waitcnt vmcnt(0)" ::: "memory");
            const unsigned og = xb_add(&bar[XB_TOP], 1u);
            const unsigned tg = og / nx;
            if (og + 1u == (tg + 1u) * nx) xb_add(&bar[XB_TOPGEN], 1u);
            else XB_SPIN(xb_ld(&bar[XB_TOPGEN]) == tg, bar);
            __builtin_amdgcn_fence(__ATOMIC_ACQUIRE, "agent");
            xb_add(&bar[XB_XGEN(b.x)], 1u);
            asm volatile("s_waitcnt vmcnt(0)" ::: "memory");
        } else {
            XB_SPIN(xb_ld(&bar[XB_XGEN(b.x)]) == gen, bar);
            __builtin_amdgcn_fence(__ATOMIC_ACQUIRE, "agent");
            asm volatile("s_waitcnt vmcnt(0)" ::: "memory");
        }
    }
    __syncthreads();
}

struct Args { const float* in[19]; float* out; unsigned char* ws; };
__global__ void __launch_bounds__(NWAVES * 64, 2) mega_fwd(Args args) {
    extern __shared__ __attribute__((aligned(16))) unsigned char lds[];
    cg::grid_group grid = cg::this_grid();
    LAS unsigned char* ldsp = (LAS unsigned char*)lds;
    const int tid = threadIdx.x, wave = __builtin_amdgcn_readfirstlane(tid >> 6);
    const int G = gridDim.x, bx = blockIdx.x;
    const int vcu = (G % 8 == 0) ? (bx % 8) * (G / 8) + bx / 8 : bx;
    const int gw = vcu * NWAVES + wave, NGW = G * NWAVES;
    for (int u = tid; u < (LDS_BYTES - MISC_OFF) / 4; u += NWAVES * 64) ((LAS unsigned*)(ldsp + MISC_OFF))[u] = 0u;
    __syncthreads();
    const XcdBarrier bar = xcd_barrier_post((unsigned*)(args.ws + WS_CTL) + CW_BAR, (volatile LAS unsigned*)(ldsp + MISC_OFF) + 8);
    typedef const Args __attribute__((address_space(4)))* kargp_t;
#define KARG(field) ({ kargp_t _ka = (kargp_t)__builtin_amdgcn_kernarg_segment_ptr(); asm volatile("" : "+s"(_ka)); _ka->field; })
#define IN(i) KARG(in[i])
#define WSP(off) (KARG(ws) + (off))
#define WGU1 ((bf16*)WSP(WS_WGU1))
#define WD1 ((bf16*)WSP(WS_WD1))
#define WIN ((bf16*)WSP(WS_WIN))
#define WOUT ((bf16*)WSP(WS_WOUT))
#define WGU2 ((bf16*)WSP(WS_WGU2))
#define WD2 ((bf16*)WSP(WS_WD2))
#define XN ((bf16*)WSP(WS_XN))
#define OB ((bf16*)WSP(WS_O))
#define HB ((bf16*)WSP(WS_H))
#define PROJ HB
#define YB ((bf16*)WSP(WS_Y))

#define FRESH_LANE() ({ int _l = threadIdx.x & 63; asm volatile("" : "+v"(_l)); _l; })
    for (int rep = 0; rep < REP_P0; ++rep) {
        const int lane = FRESH_LANE();
        LAS float* scr = (LAS float*)(ldsp + wave * 16384);
        constexpr int I_G = (DMODEL / 64) * (FFN / 32), I_D = (FFN / 64) * (DMODEL / 32), I_IN = (DMODEL / 64) * (INC / 32), I_O = (DMODEL / 64) * (DMODEL / 32);
        constexpr int NITEMS = 4 * I_G + 2 * I_D + I_IN + I_O;
        for (int it = gw; it < NITEMS; it += NGW) {
            int r = it;
            if (r < I_G) { p0_transpose_item(IN(2), DMODEL, FFN, WGU1, 1, scr, r, lane, IN(1)); continue; } r -= I_G;
            if (r < I_G) { p0_transpose_item(IN(3), DMODEL, FFN, WGU1, 2, scr, r, lane, IN(1)); continue; } r -= I_G;
            if (r < I_D) { p0_transpose_item(IN(4), FFN, DMODEL, WD1, 0, scr, r, lane); continue; } r -= I_D;
            if (r < I_IN) { p0_transpose_item(IN(6), DMODEL, INC, WIN, 0, scr, r, lane, IN(5)); continue; } r -= I_IN;
            if (r < I_O) { p0_transpose_item(IN(13), DMODEL, DMODEL, WOUT, 0, scr, r, lane); continue; } r -= I_O;
            if (r < I_G) { p0_transpose_item(IN(15), DMODEL, FFN, WGU2, 1, scr, r, lane, IN(14)); continue; } r -= I_G;
            if (r < I_G) { p0_transpose_item(IN(16), DMODEL, FFN, WGU2, 2, scr, r, lane, IN(14)); continue; } r -= I_G;
            p0_transpose_item(IN(17), FFN, DMODEL, WD2, 0, scr, r, lane);
        }
        { const float* xi = IN(0); const float* gn = IN(1); bf16* xn = XN; float* sq = (float*)WSP(WS_SSQ0); for (int m = gw; m < M; m += NGW) rms_row_to_bf16(xi + (size_t)m * DMODEL, gn, xn + (size_t)m * DMODEL, sq + m, lane); }
    }
    grid.sync();
    {
        pg8::Gemm g{XN, WGU1, M, 2 * FFN, DMODEL}; pg8::StaticOrder S; S.init(M, 2 * FFN, G, bx);
        pg8::EpiSwiGLU E{HB, FFN, (const float*)WSP(WS_SSQ0)};
        pg8::gemm_phase<pg8::EpiSwiGLU, pg8::StaticOrder, PG8_ALIGN, PG8_SP2>(ldsp, g, S, E);
    }
    xcd_barrier(bar);
    {
        pg8::Gemm g{HB, WD1, M, DMODEL, FFN}; pg8::StaticOrderW<4> S; S.init(M, DMODEL, G, bx);
        pg8::EpiRes<1> E{XN, XN, DMODEL, 0.5f, (float*)WSP(WS_SSQ1)};
        pg8::gemm_phase<pg8::EpiRes<1>, pg8::StaticOrderW<4>, PG8_ALIGN, PG8_SP2>(ldsp, g, S, E);
    }
    xcd_barrier(bar);
    {
        pg8::Gemm g{XN, WIN, M, INC, DMODEL}; pg8::StaticOrder S; S.init(M, INC, G, bx);
        pg8::EpiProj E{PROJ, INC, 3072, 4096, attn_body::C2, (const float*)WSP(WS_SSQ1)};
        pg8::gemm_phase<pg8::EpiProj, pg8::StaticOrder, PG8_ALIGN, PG8_SP2>(ldsp, g, S, E);
    }
    xcd_barrier(bar);
    {
        const attn_body::AttnTensors AT{(const attn_body::bf16*)PROJ, (attn_body::bf16*)OB};
        static_assert(attn_body::LDS3_BYTES <= MISC_OFF, "attention LDS");
        const attn_body::StaticOrder2 S(G, bx);
        attn_body::attn_phase3<attn_body::StaticOrder2>((char*)lds, AT, S);
    }
    xcd_barrier(bar);
    for (int rep = 0; rep < REP_LIGHT; ++rep) {
        const int lane = FRESH_LANE();
        const float s1 = wave_sum(IN(8)[lane] * IN(9)[lane]), s2 = wave_sum(IN(10)[lane] * IN(11)[lane]);
        const float lam = expf(s1) - expf(s2) + 0.2f;
        const bf16* pj = PROJ; const bf16* ob = OB; bf16* yb = YB; const float* cw = IN(7); const float* sl = IN(12);
        for (int m = gw; m < M; m += NGW) mix_row(pj, ob, yb, cw, sl, lam, m, lane);
    }
    xcd_barrier(bar);
    {
        pg8::Gemm g{YB, WOUT, M, DMODEL, DMODEL}; pg8::StaticOrderW<4> S; S.init(M, DMODEL, G, bx);
        pg8::EpiRes<1> E{XN, OB, DMODEL, 1.0f, (float*)WSP(WS_SSQ2)};
        pg8::gemm_phase<pg8::EpiRes<1>, pg8::StaticOrderW<4>, PG8_ALIGN, PG8_SP2>(ldsp, g, S, E);
    }
    xcd_barrier(bar);
    {
        pg8::Gemm g{OB, WGU2, M, 2 * FFN, DMODEL}; pg8::StaticOrder S; S.init(M, 2 * FFN, G, bx);
        pg8::EpiSwiGLU E{HB, FFN, (const float*)WSP(WS_SSQ2)};
        pg8::gemm_phase<pg8::EpiSwiGLU, pg8::StaticOrder, PG8_ALIGN, PG8_SP2>(ldsp, g, S, E);
    }
    xcd_barrier(bar);
    {
        pg8::Gemm g{HB, WD2, M, DMODEL, FFN}; pg8::StaticOrderW<4> S; S.init(M, DMODEL, G, bx);
        float* outp = KARG(out); pg8::EpiRes<3> E{OB, outp, DMODEL, 0.5f, (float*)WSP(WS_SSQ3), (unsigned*)WSP(WS_CNT), IN(18)};
        pg8::gemm_phase<pg8::EpiRes<3>, pg8::StaticOrderW<4>, PG8_ALIGN, PG8_SP2>(ldsp, g, S, E);
    }
}

#undef KARG
#undef FRESH_LANE
#undef IN
#undef WSP
#undef WGU1
#undef WD1
#undef WIN
#undef WOUT
#undef WGU2
#undef WD2
#undef XN
#undef OB
#undef HB
#undef PROJ
#undef YB
extern "C" void kernel_launch(void* const* d_in, const int* in_sizes, int n_in, void* d_out, int out_size, void* d_ws, size_t ws_size, hipStream_t stream) {
    static int grid = 0;
    if (grid == 0) {
        if (n_in != 19 || in_sizes[0] != M * DMODEL || out_size != M * DMODEL || ws_size < WS_END) { fprintf(stderr, "kernel_launch: unexpected shapes (n_in %d, in0 %d, out %d, ws %zu); nothing launched\n", n_in, n_in > 0 ? in_sizes[0] : -1, out_size, ws_size); grid = -1; return; }
        int dev = 0, cus = 0, per_cu = 0;
        if (hipGetDevice(&dev) != hipSuccess || hipDeviceGetAttribute(&cus, hipDeviceAttributeMultiprocessorCount, dev) != hipSuccess) { grid = -1; return; }
        if (hipFuncSetAttribute((const void*)mega_fwd, hipFuncAttributeMaxDynamicSharedMemorySize, LDS_BYTES) != hipSuccess) { fprintf(stderr, "kernel_launch: hipFuncSetAttribute failed\n"); grid = -1; return; }
        if (hipOccupancyMaxActiveBlocksPerMultiprocessor(&per_cu, (const void*)mega_fwd, NWAVES * 64, LDS_BYTES) != hipSuccess) per_cu = 0;
        (void)hipGetLastError();
        if (cus * per_cu < 256) { fprintf(stderr, "kernel_launch: resident capacity %d x %d < 256 workgroups; nothing launched\n", cus, per_cu); grid = -1; return; }
        grid = 256;
    }
    if (grid < 0) return;
    if (hipMemsetAsync((char*)d_ws + WS_CTL, 0, CTL_ZERO_BYTES, stream) != hipSuccess) { fprintf(stderr, "kernel_launch: hipMemsetAsync failed\n"); return; }
    Args a{};
    for (int i = 0; i < 19; ++i) a.in[i] = (const float*)d_in[i];
    a.out = (float*)d_out; a.ws = (unsigned char*)d_ws;
    void* kargs[] = {&a};
    const hipError_t le = hipLaunchCooperativeKernel((const void*)mega_fwd, dim3(grid), dim3(NWAVES * 64), kargs, LDS_BYTES, stream);
    if (le != hipSuccess) fprintf(stderr, "kernel_launch: cooperative launch failed: %s\n", hipGetErrorName(le));
}
```

```cpp
#include <hip/hip_runtime.h>
#include <hip/hip_cooperative_groups.h>
#include <cstdio>
#include <cstdint>

namespace pg8 {
#define PG8_LAS __attribute__((address_space(3)))
typedef unsigned short bf16_t;
typedef short bf16x8 __attribute__((ext_vector_type(8)));
typedef float f32x4 __attribute__((ext_vector_type(4)));
typedef unsigned u32x4 __attribute__((ext_vector_type(4)));
constexpr int BM = 256, BK = 64, HALF = 128, HTB = HALF * BK * 2  , STAGE_BYTES = 8 * HTB, NXCD = 8, WGM = 8;

__host__ __device__ __forceinline__ int lds_byte(int r, int c) { const int st = (r >> 4) * 2 + (c >> 5), rr = r & 15, cc = c & 31, ob = rr * 64 + cc * 2; return st * 1024 + (ob ^ (((ob >> 9) & 1) << 5)); }
__host__ __device__ __forceinline__ void stage_rc(int b, int& R, int& C) { const int st = b / 1024, sb = b % 1024, swz = sb ^ (((sb >> 9) & 1) << 5); R = (st >> 1) * 16 + swz / 64; C = (st & 1) * 32 + (swz % 64) / 2; }
__host__ __device__ __forceinline__ int perm32(int rho) { const int n = rho >> 4, i = rho & 15; return 8 * (i >> 2) + 4 * n + (i & 3); }

struct Unit { int pm, pn, par; };
struct Gemm { const bf16_t* A; const bf16_t* Bt; int M, N, K; };

struct StaticOrder {
    int nM, nN, nwg, G, c;
    __host__ __device__ void init(int M, int N, int G_, int c_) { nM = M / BM; nN = N / BM; nwg = nM * nN; G = G_; c = c_; }
    __host__ __device__ bool next(int i, Unit& u) const {
        const long L = (long)i * G + c; if (L >= nwg) return false;
        int wgid = (int)L; { const int q = nwg / NXCD, r = nwg % NXCD, xcd = wgid % NXCD, off = wgid / NXCD; wgid = (xcd < r ? xcd * (q + 1) : r * (q + 1) + (xcd - r) * q) + off; }
        const int nig = WGM * nN, gid = wgid / nig, fm = gid * WGM, gsz = (nM - fm) < WGM ? (nM - fm) : WGM;
        u.pm = fm + ((wgid % nig) % gsz); u.pn = (wgid % nig) / gsz; return true;
    }
    __device__ __forceinline__ void a_ready(const Unit&) const {}
    __device__ __forceinline__ void done(const Unit&) const {}
};

__device__ __forceinline__ unsigned cvt_pk_bf16(float lo, float hi) { unsigned r; asm volatile("v_cvt_pk_bf16_f32 %0, %1, %2" : "=v"(r) : "v"(lo), "v"(hi)); return r; }
typedef float f32x2 __attribute__((ext_vector_type(2)));
__device__ __forceinline__ f32x2 gelu_pk(f32x2 v) {
    const f32x2 av = __builtin_elementwise_abs(v), d = av * 0.2316418882f + 1.0f;
    f32x2 t; t.x = __builtin_amdgcn_rcpf(d.x); t.y = __builtin_amdgcn_rcpf(d.y);
    f32x2 q = t * 0.5307027145f + (-0.7265760135f); q = q * t + 0.7107068705f; q = q * t + (-0.142248368f); q = q * t + 0.127414796f; q = q * t;
    const f32x2 s = (v * v) * (-0.72134752044f);
    f32x2 e; e.x = __builtin_amdgcn_exp2f(s.x); e.y = __builtin_amdgcn_exp2f(s.y);
    const f32x2 m = v * (q * e), r = v - m;
    f32x2 o; o.x = v.x < 0.f ? m.x : r.x; o.y = v.y < 0.f ? m.y : r.y; return o;
}

template <int ACT  > struct EpiBf16 {
    static constexpr bool PERM = true, AFTER_DRAIN = false; static_assert(ACT == 0 || ACT == 1, "EpiBf16: ACT is 0 (none) or 1 (gelu_pk)");
    bf16_t* O; int ldc; const float* bias; int split_cols; size_t split_stride; float scale0;
    __device__ __forceinline__ void operator()(const f32x4 (&acc)[2][2][4][2], const Unit& u, int wr, int wc, int fr, int fq) const {
        const int row0 = u.pm * BM + wr * 64 + fr; int colt = u.pn * BM; bf16_t* base = O;
        float sc = 1.f; if (split_cols) { const int t = colt / split_cols; base += (size_t)t * split_stride; colt -= t * split_cols; if (t == 0) sc = scale0; }
        const int col0 = colt + wc * 32 + 8 * fq, bcol0 = u.pn * BM + wc * 32 + 8 * fq;
        f32x4 bv[2][2];
#pragma unroll
        for (int bj = 0; bj < 2; ++bj)
#pragma unroll
            for (int n = 0; n < 2; ++n) bv[bj][n] = bias ? *(const f32x4*)(bias + bcol0 + bj * HALF + 4 * n) : (f32x4){0.f, 0.f, 0.f, 0.f};
#pragma unroll
        for (int ai = 0; ai < 2; ++ai)
#pragma unroll
            for (int m = 0; m < 4; ++m) { bf16_t* rowp = base + (size_t)(row0 + ai * HALF + m * 16) * ldc + col0;
#pragma unroll
                for (int bj = 0; bj < 2; ++bj) { f32x4 v0 = acc[ai][bj][m][0] + bv[bj][0], v1 = acc[ai][bj][m][1] + bv[bj][1];
                    if (ACT == 1) { f32x2 a = gelu_pk((f32x2){v0[0], v0[1]}), b = gelu_pk((f32x2){v0[2], v0[3]}), c = gelu_pk((f32x2){v1[0], v1[1]}), d = gelu_pk((f32x2){v1[2], v1[3]});
                        v0 = (f32x4){a.x, a.y, b.x, b.y}; v1 = (f32x4){c.x, c.y, d.x, d.y}; }
                    v0 = v0 * sc; v1 = v1 * sc; u32x4 w; w.x = cvt_pk_bf16(v0[0], v0[1]); w.y = cvt_pk_bf16(v0[2], v0[3]); w.z = cvt_pk_bf16(v1[0], v1[1]); w.w = cvt_pk_bf16(v1[2], v1[3]);
                    *(u32x4*)(rowp + bj * HALF) = w; } }
    }
};
template <int W> struct StaticOrderW : StaticOrder {
    __host__ __device__ bool next(int i, Unit& u) const {
        const long L = (long)i * G + c; if (L >= nwg) return false;
        int wgid = (int)L; { const int q = nwg / NXCD, r = nwg % NXCD, xcd = wgid % NXCD, off = wgid / NXCD; wgid = (xcd < r ? xcd * (q + 1) : r * (q + 1) + (xcd - r) * q) + off; }
        const int nig = W * nN, gid = wgid / nig, fm = gid * W, gsz = (nM - fm) < W ? (nM - fm) : W;
        u.pm = fm + ((wgid % nig) % gsz); u.pn = (wgid % nig) / gsz; return true;
    }
};
struct EpiSwiGLU {
    static constexpr bool PERM = true, AFTER_DRAIN = false;
    bf16_t* O; int ldc; const float* ssq;
    typedef float f32x2 __attribute__((ext_vector_type(2)));
    __device__ __forceinline__ static unsigned sg2(f32x2 g, f32x2 up, float c, float rs2) {
        const f32x2 m = g * c; f32x2 e; e.x = __builtin_amdgcn_exp2f(m.x); e.y = __builtin_amdgcn_exp2f(m.y);
        const f32x2 d = e + 1.0f; f32x2 r; r.x = __builtin_amdgcn_rcpf(d.x); r.y = __builtin_amdgcn_rcpf(d.y);
        const f32x2 h = (g * up) * rs2 * r; return cvt_pk_bf16(h.x, h.y); }
    __device__ __forceinline__ void operator()(const f32x4 (&acc)[2][2][4][2], const Unit& u, int wr, int wc, int fr, int fq) const {
        const int row0 = u.pm * BM + wr * 64 + fr, col0 = u.pn * HALF + wc * 32 + 8 * fq;
        float rsv[2][4];
#pragma unroll
        for (int ai = 0; ai < 2; ++ai)
#pragma unroll
            for (int m = 0; m < 4; ++m) rsv[ai][m] = ssq[row0 + ai * HALF + m * 16];
        asm volatile("" ::: "memory");
#pragma unroll
        for (int ai = 0; ai < 2; ++ai)
#pragma unroll
            for (int m = 0; m < 4; ++m) {
                bf16_t* rowp = O + (size_t)(row0 + ai * HALF + m * 16) * ldc + col0;
                const float rs = __builtin_amdgcn_rsqf(rsv[ai][m] * (1.0f / 2048.0f) + 1e-6f), c = -1.4426950408889634f * rs, rs2 = rs * rs;
                const f32x4 g0 = acc[ai][0][m][0], g1 = acc[ai][0][m][1], u0 = acc[ai][1][m][0], u1 = acc[ai][1][m][1];
                u32x4 w; w.x = sg2((f32x2){g0[0], g0[1]}, (f32x2){u0[0], u0[1]}, c, rs2); w.y = sg2((f32x2){g0[2], g0[3]}, (f32x2){u0[2], u0[3]}, c, rs2);
                w.z = sg2((f32x2){g1[0], g1[1]}, (f32x2){u1[0], u1[1]}, c, rs2); w.w = sg2((f32x2){g1[2], g1[3]}, (f32x2){u1[2], u1[3]}, c, rs2);
                *(u32x4*)rowp = w; }
    }
};
template <int MODE> struct EpiRes {
    static constexpr bool PERM = true, AFTER_DRAIN = false;
    const void* base; void* out; int ldc; float s; float* ssq; unsigned* cnt; const float* gain;
    __device__ __forceinline__ static f32x4 lo4(unsigned a, unsigned b) { return (f32x4){__uint_as_float(a << 16), __uint_as_float(a & 0xffff0000u), __uint_as_float(b << 16), __uint_as_float(b & 0xffff0000u)}; }
    __device__ __forceinline__ void operator()(const f32x4 (&acc)[2][2][4][2], const Unit& u, int wr, int wc, int fr, int fq) const {
        const int col0 = u.pn * BM + wc * 32 + 8 * fq;
        if constexpr (MODE == 0) {
            const float* bs = (const float*)base; bf16_t* o = (bf16_t*)out;
#pragma unroll
            for (int ai = 0; ai < 2; ++ai) {
                f32x4 pre[4][2][2];
#pragma unroll
                for (int m = 0; m < 4; ++m) { const size_t off = (size_t)(u.pm * BM + ai * HALF + wr * 64 + m * 16 + fr) * ldc + col0;
#pragma unroll
                    for (int bj = 0; bj < 2; ++bj) { pre[m][bj][0] = *(const f32x4*)(bs + off + bj * HALF); pre[m][bj][1] = *(const f32x4*)(bs + off + bj * HALF + 4); } }
                asm volatile("" ::: "memory");
#pragma unroll
                for (int m = 0; m < 4; ++m) { const int row = u.pm * BM + ai * HALF + wr * 64 + m * 16 + fr; const size_t off = (size_t)row * ldc + col0; float ss = 0.f;
#pragma unroll
                    for (int bj = 0; bj < 2; ++bj) { const f32x4 v0 = pre[m][bj][0] + acc[ai][bj][m][0] * s, v1 = pre[m][bj][1] + acc[ai][bj][m][1] * s;
                        ss += (v0[0] * v0[0] + v0[1] * v0[1]) + (v0[2] * v0[2] + v0[3] * v0[3]) + (v1[0] * v1[0] + v1[1] * v1[1]) + (v1[2] * v1[2] + v1[3] * v1[3]);
                        u32x4 w; w.x = cvt_pk_bf16(v0[0], v0[1]); w.y = cvt_pk_bf16(v0[2], v0[3]); w.z = cvt_pk_bf16(v1[0], v1[1]); w.w = cvt_pk_bf16(v1[2], v1[3]);
                        *(u32x4*)(o + off + bj * HALF) = w; }
                    ss += __shfl_xor(ss, 16); ss += __shfl_xor(ss, 32); if (fq == 0) atomicAdd(ssq + row, ss); }
            }
        } else if constexpr (MODE == 3) {
            auto& A = const_cast<f32x4 (&)[2][2][4][2]>(acc);
            const bf16_t* bs = (const bf16_t*)base;
            { u32x4 pre[2][4][2];
#pragma unroll
              for (int ai = 0; ai < 2; ++ai)
#pragma unroll
                for (int m = 0; m < 4; ++m) { const size_t off = (size_t)(u.pm * BM + ai * HALF + wr * 64 + m * 16 + fr) * ldc + col0;
#pragma unroll
                    for (int bj = 0; bj < 2; ++bj) pre[ai][m][bj] = *(const u32x4*)(bs + off + bj * HALF); }
              asm volatile("" ::: "memory");
#pragma unroll
              for (int ai = 0; ai < 2; ++ai)
#pragma unroll
                for (int m = 0; m < 4; ++m) { const int row = u.pm * BM + ai * HALF + wr * 64 + m * 16 + fr; float ss = 0.f;
#pragma unroll
                    for (int bj = 0; bj < 2; ++bj) { const u32x4 pb = pre[ai][m][bj];
                        const f32x4 v0 = lo4(pb.x, pb.y) + acc[ai][bj][m][0] * s, v1 = lo4(pb.z, pb.w) + acc[ai][bj][m][1] * s;
                        ss += (v0[0] * v0[0] + v0[1] * v0[1]) + (v0[2] * v0[2] + v0[3] * v0[3]) + (v1[0] * v1[0] + v1[1] * v1[1]) + (v1[2] * v1[2] + v1[3] * v1[3]);
                        A[ai][bj][m][0] = v0; A[ai][bj][m][1] = v1; }
                    ss += __shfl_xor(ss, 16); ss += __shfl_xor(ss, 32); if (fq == 0) atomicAdd(ssq + row, ss); } }
            asm volatile("s_waitcnt vmcnt(0)" ::: "memory");
            unsigned* c = cnt + 64 * u.pm;
            if ((threadIdx.x & 63) == 0) __hip_atomic_fetch_add(c, 1u, __ATOMIC_RELAXED, __HIP_MEMORY_SCOPE_AGENT);
            { unsigned spins = 0;
              while ((unsigned)__builtin_amdgcn_readfirstlane(__hip_atomic_load(c, __ATOMIC_RELAXED, __HIP_MEMORY_SCOPE_AGENT)) < 64u) { __builtin_amdgcn_s_sleep(4); if (++spins > (1u << 22)) break; } }
            float rsv[2][4];
#pragma unroll
            for (int ai = 0; ai < 2; ++ai)
#pragma unroll
                for (int m = 0; m < 4; ++m) rsv[ai][m] = __hip_atomic_load(ssq + u.pm * BM + ai * HALF + wr * 64 + m * 16 + fr, __ATOMIC_RELAXED, __HIP_MEMORY_SCOPE_AGENT);
            f32x4 gv[2][2];
#pragma unroll
            for (int bj = 0; bj < 2; ++bj)
#pragma unroll
                for (int n = 0; n < 2; ++n) gv[bj][n] = *(const f32x4*)(gain + col0 + bj * HALF + 4 * n);
#pragma unroll
            for (int ai = 0; ai < 2; ++ai)
#pragma unroll
                for (int m = 0; m < 4; ++m) { const size_t off = (size_t)(u.pm * BM + ai * HALF + wr * 64 + m * 16 + fr) * ldc + col0;
                    const float rs = __builtin_amdgcn_rsqf(rsv[ai][m] * (1.0f / 2048.0f) + 1e-6f);
#pragma unroll
                    for (int bj = 0; bj < 2; ++bj) { *(f32x4*)((float*)out + off + bj * HALF) = acc[ai][bj][m][0] * rs * gv[bj][0]; *(f32x4*)((float*)out + off + bj * HALF + 4) = acc[ai][bj][m][1] * rs * gv[bj][1]; } }
        } else {
            const bf16_t* bs = (const bf16_t*)base;
            u32x4 pre[2][4][2];
#pragma unroll
            for (int ai = 0; ai < 2; ++ai)
#pragma unroll
                for (int m = 0; m < 4; ++m) { const size_t off = (size_t)(u.pm * BM + ai * HALF + wr * 64 + m * 16 + fr) * ldc + col0;
#pragma unroll
                    for (int bj = 0; bj < 2; ++bj) pre[ai][m][bj] = *(const u32x4*)(bs + off + bj * HALF); }
            asm volatile("" ::: "memory");
#pragma unroll
            for (int ai = 0; ai < 2; ++ai)
#pragma unroll
                for (int m = 0; m < 4; ++m) { const int row = u.pm * BM + ai * HALF + wr * 64 + m * 16 + fr; const size_t off = (size_t)row * ldc + col0; float ss = 0.f;
#pragma unroll
                    for (int bj = 0; bj < 2; ++bj) { const u32x4 pb = pre[ai][m][bj];
                        const f32x4 v0 = lo4(pb.x, pb.y) + acc[ai][bj][m][0] * s, v1 = lo4(pb.z, pb.w) + acc[ai][bj][m][1] * s;
                        if constexpr (MODE == 1) {
                            ss += (v0[0] * v0[0] + v0[1] * v0[1]) + (v0[2] * v0[2] + v0[3] * v0[3]) + (v1[0] * v1[0] + v1[1] * v1[1]) + (v1[2] * v1[2] + v1[3] * v1[3]);
                            u32x4 w; w.x = cvt_pk_bf16(v0[0], v0[1]); w.y = cvt_pk_bf16(v0[2], v0[3]); w.z = cvt_pk_bf16(v1[0], v1[1]); w.w = cvt_pk_bf16(v1[2], v1[3]);
                            *(u32x4*)((bf16_t*)out + off + bj * HALF) = w;
                        } else { *(f32x4*)((float*)out + off + bj * HALF) = v0; *(f32x4*)((float*)out + off + bj * HALF + 4) = v1; } }
                    if constexpr (MODE == 1) { ss += __shfl_xor(ss, 16); ss += __shfl_xor(ss, 32); if (fq == 0) atomicAdd(ssq + row, ss); } }
        }
    }
};
struct EpiProj {
    static constexpr bool PERM = true, AFTER_DRAIN = false;
    bf16_t* O; int ldc; int q_lo, q_hi; float qscale; const float* ssq;
    __device__ __forceinline__ void operator()(const f32x4 (&acc)[2][2][4][2], const Unit& u, int wr, int wc, int fr, int fq) const {
        const int row0 = u.pm * BM + wr * 64 + fr, colt = u.pn * BM, col0 = colt + wc * 32 + 8 * fq;
        const float sc = (colt >= q_lo && colt < q_hi) ? qscale : 1.0f;
        float rsv[2][4];
#pragma unroll
        for (int ai = 0; ai < 2; ++ai)
#pragma unroll
            for (int m = 0; m < 4; ++m) rsv[ai][m] = ssq[row0 + ai * HALF + m * 16];
        asm volatile("" ::: "memory");
#pragma unroll
        for (int ai = 0; ai < 2; ++ai)
#pragma unroll
            for (int m = 0; m < 4; ++m) { bf16_t* rowp = O + (size_t)(row0 + ai * HALF + m * 16) * ldc + col0;
                const float rs = sc * __builtin_amdgcn_rsqf(rsv[ai][m] * (1.0f / 2048.0f) + 1e-6f);
#pragma unroll
                for (int bj = 0; bj < 2; ++bj) { const f32x4 v0 = acc[ai][bj][m][0] * rs, v1 = acc[ai][bj][m][1] * rs;
                    u32x4 w; w.x = cvt_pk_bf16(v0[0], v0[1]); w.y = cvt_pk_bf16(v0[2], v0[3]); w.z = cvt_pk_bf16(v1[0], v1[1]); w.w = cvt_pk_bf16(v1[2], v1[3]);
                    *(u32x4*)(rowp + bj * HALF) = w; } }
    }
};

template <class Epi, class Sched, bool ALIGN_EPI = false, bool SP2 = false>
__device__ __forceinline__ void gemm_phase(PG8_LAS unsigned char* lds, const Gemm g, const Sched& S, const Epi& E) {
    int tid_ = threadIdx.x; asm volatile("" : "+v"(tid_)); const int tid = tid_, wid = __builtin_amdgcn_readfirstlane(tid >> 6), lane = tid & 63, wr = wid >> 2, wc = wid & 3, fr = lane & 15, fq = lane >> 4;
    const int K = g.K, nt = K / BK;
    unsigned voffA[2], voffB[2];
#pragma unroll
    for (int i = 0; i < 2; ++i) { int R, C; stage_rc(tid * 16 + i * 8192, R, C); const int Rb = Epi::PERM ? ((R & ~31) + perm32(R & 31)) : R;
        voffA[i] = (unsigned)(R * K + C) * 2u; voffB[i] = (unsigned)(Rb * K + C) * 2u; }
    const size_t kstep = (size_t)(BK * 2);
    const size_t hstep = (size_t)HALF * K * 2;
    const size_t tstep = 2 * hstep;
    const unsigned ldsw = (unsigned)wid * 1024u;
    const int aoff = lds_byte(wr * 64 + fr, fq * 8), boff = lds_byte(wc * 32 + fr, fq * 8);
#define PG8_SA(b, h) (((b) * 2 + (h)) * HTB)
#define PG8_SB(b, h) ((4 + (b) * 2 + (h)) * HTB)
#define PG8_STAGE(bufoff, gbase, voff) do { _Pragma("unroll") for (int _i = 0; _i < 2; ++_i) \
        __builtin_amdgcn_global_load_lds((const unsigned*)((const char*)(gbase) + (voff)[_i]), (PG8_LAS unsigned*)(lds + (bufoff) + ldsw + _i * 8192), 16, 0, 0); } while (0)
#define PG8_LDA(dst, b, h) do { _Pragma("unroll") for (int m = 0; m < 4; ++m) _Pragma("unroll") for (int k = 0; k < 2; ++k) dst[m][k] = *(const PG8_LAS bf16x8*)(lds + PG8_SA(b, h) + aoff + m * 2048 + k * 1024); } while (0)
#define PG8_LDB(dst, b, h) do { _Pragma("unroll") for (int n = 0; n < 2; ++n) _Pragma("unroll") for (int k = 0; k < 2; ++k) dst[n][k] = *(const PG8_LAS bf16x8*)(lds + PG8_SB(b, h) + boff + n * 2048 + k * 1024); } while (0)
#define PG8_MMA(ai, bj, At, Bt) do { __builtin_amdgcn_s_setprio(1); _Pragma("unroll") for (int m = 0; m < 4; ++m) _Pragma("unroll") for (int n = 0; n < 2; ++n) _Pragma("unroll") for (int k = 0; k < 2; ++k) \
        acc[ai][bj][m][n] = __builtin_amdgcn_mfma_f32_16x16x32_bf16(Bt[n][k], At[m][k], acc[ai][bj][m][n], 0, 0, 0); __builtin_amdgcn_s_setprio(0); } while (0)
#define PG8_WAIT_V(n) asm volatile("s_waitcnt vmcnt(" #n ")" ::: "memory")
#define PG8_WAIT_L(n) asm volatile("s_waitcnt lgkmcnt(" #n ")" ::: "memory")
#define PG8_BAR __builtin_amdgcn_s_barrier()
#define PG8_SCHED __builtin_amdgcn_sched_barrier(0)
    Unit cur, nxt; int ui = 0;
    if (!S.next(0, cur)) return;
    f32x4 acc[2][2][4][2];
#pragma unroll
    for (int a = 0; a < 2; ++a)
#pragma unroll
        for (int b = 0; b < 2; ++b)
#pragma unroll
            for (int m = 0; m < 4; ++m)
#pragma unroll
                for (int n = 0; n < 2; ++n) acc[a][b][m][n] = (f32x4){0.f, 0.f, 0.f, 0.f};
    bf16x8 At[4][2], B0[2][2], B1[2][2];
    const char* cA = (const char*)g.A + (size_t)cur.pm * tstep; const char* cB = (const char*)g.Bt + (size_t)cur.pn * tstep;
    S.a_ready(cur);
    if constexpr (SP2) {
        PG8_STAGE(PG8_SB(0, 0), cB, voffB); PG8_STAGE(PG8_SB(0, 1), cB + hstep, voffB); PG8_STAGE(PG8_SA(0, 0), cA, voffA); PG8_STAGE(PG8_SA(0, 1), cA + hstep, voffA);
        if (wr == 1) PG8_BAR;
        PG8_WAIT_V(2); PG8_BAR;
        PG8_STAGE(PG8_SB(1, 0), cB + kstep, voffB); PG8_STAGE(PG8_SA(1, 0), cA + kstep, voffA); PG8_STAGE(PG8_SB(1, 1), cB + hstep + kstep, voffB);
        PG8_WAIT_V(6); PG8_BAR;
    } else {
        PG8_STAGE(PG8_SB(0, 0), cB, voffB); PG8_STAGE(PG8_SA(0, 0), cA, voffA); PG8_STAGE(PG8_SB(0, 1), cB + hstep, voffB); PG8_STAGE(PG8_SA(0, 1), cA + hstep, voffA);
        if (wr == 1) PG8_BAR;
        PG8_WAIT_V(4); PG8_BAR;
        PG8_STAGE(PG8_SB(1, 0), cB + kstep, voffB); PG8_STAGE(PG8_SA(1, 0), cA + kstep, voffA); PG8_STAGE(PG8_SB(1, 1), cB + hstep + kstep, voffB);
        PG8_WAIT_V(6); PG8_BAR;
    }
    for (;;) {
        const bool has_next = S.next(ui + 1, nxt);
        const char* nA = has_next ? (const char*)g.A + (size_t)nxt.pm * tstep : cA; const char* nB = has_next ? (const char*)g.Bt + (size_t)nxt.pn * tstep : cB;
        for (int t = 0; t < nt; t += 2) {
            const bool last = (t == nt - 2);
            const char* a1 = cA + (size_t)(t + 1) * kstep;
            const char* a2 = last ? nA : cA + (size_t)(t + 2) * kstep; const char* b2 = last ? nB : cB + (size_t)(t + 2) * kstep;
            const char* a3 = a2 + kstep; const char* b3 = b2 + kstep;
            if (last && has_next) S.a_ready(nxt);
            if constexpr (SP2) {
            PG8_LDB(B0, 0, 0); PG8_LDB(B1, 0, 1); PG8_SCHED; PG8_LDA(At, 0, 0); PG8_STAGE(PG8_SA(1, 1), a1 + hstep, voffA);
            PG8_WAIT_V(8); PG8_WAIT_L(0); PG8_BAR; PG8_MMA(0, 0, At, B0); PG8_MMA(0, 1, At, B1); PG8_BAR; PG8_SCHED;
            PG8_LDA(At, 0, 1); PG8_STAGE(PG8_SB(0, 0), b2, voffB); PG8_STAGE(PG8_SB(0, 1), b2 + hstep, voffB); PG8_STAGE(PG8_SA(0, 0), a2, voffA);
            PG8_WAIT_V(8); PG8_WAIT_L(0); PG8_BAR; PG8_MMA(1, 0, At, B0); PG8_MMA(1, 1, At, B1); PG8_BAR; PG8_SCHED;
            PG8_LDB(B0, 1, 0); PG8_LDB(B1, 1, 1); PG8_SCHED; PG8_LDA(At, 1, 0); PG8_STAGE(PG8_SA(0, 1), a2 + hstep, voffA);
            PG8_WAIT_V(8); PG8_WAIT_L(0); PG8_BAR; PG8_MMA(0, 0, At, B0); PG8_MMA(0, 1, At, B1); PG8_BAR; PG8_SCHED;
            PG8_LDA(At, 1, 1); PG8_STAGE(PG8_SB(1, 0), b3, voffB); PG8_STAGE(PG8_SB(1, 1), b3 + hstep, voffB); PG8_STAGE(PG8_SA(1, 0), a3, voffA);
            PG8_WAIT_V(8); PG8_WAIT_L(0); PG8_BAR; PG8_MMA(1, 0, At, B0); PG8_MMA(1, 1, At, B1); PG8_BAR; PG8_SCHED;
            } else {
            PG8_LDB(B0, 0, 0); PG8_SCHED; PG8_LDA(At, 0, 0); PG8_STAGE(PG8_SA(1, 1), a1 + hstep, voffA);
            PG8_WAIT_L(8); PG8_BAR; PG8_WAIT_L(0); PG8_MMA(0, 0, At, B0); PG8_BAR; PG8_SCHED;
            PG8_LDB(B1, 0, 1); PG8_STAGE(PG8_SB(0, 0), b2, voffB);
            PG8_BAR; PG8_WAIT_L(0); PG8_MMA(0, 1, At, B1); PG8_BAR;
            PG8_LDA(At, 0, 1); PG8_STAGE(PG8_SA(0, 0), a2, voffA);
            PG8_BAR; PG8_WAIT_L(0); PG8_MMA(1, 0, At, B0); PG8_BAR; PG8_SCHED;
            PG8_STAGE(PG8_SB(0, 1), b2 + hstep, voffB);
            PG8_WAIT_V(6); PG8_BAR; PG8_MMA(1, 1, At, B1); PG8_BAR;
            PG8_LDB(B0, 1, 0); PG8_SCHED; PG8_LDA(At, 1, 0); PG8_STAGE(PG8_SA(0, 1), a2 + hstep, voffA);
            PG8_WAIT_L(8); PG8_BAR; PG8_WAIT_L(0); PG8_MMA(0, 0, At, B0); PG8_BAR; PG8_SCHED;
            PG8_LDB(B1, 1, 1); PG8_STAGE(PG8_SB(1, 0), b3, voffB);
            PG8_BAR; PG8_WAIT_L(0); PG8_MMA(0, 1, At, B1); PG8_BAR;
            PG8_LDA(At, 1, 1); PG8_STAGE(PG8_SA(1, 0), a3, voffA);
            PG8_BAR; PG8_WAIT_L(0); PG8_MMA(1, 0, At, B0); PG8_BAR; PG8_SCHED;
            PG8_STAGE(PG8_SB(1, 1), b3 + hstep, voffB);
            PG8_WAIT_V(6); PG8_BAR; PG8_MMA(1, 1, At, B1); PG8_BAR;
            }
        }
        if constexpr (ALIGN_EPI) { if (wr == 0) PG8_BAR; }
        if constexpr (!Epi::AFTER_DRAIN) { E(acc, cur, wr, wc, fr, fq); S.done(cur); }
        if (!has_next) break;
#pragma unroll
        for (int a = 0; a < 2; ++a)
#pragma unroll
            for (int b = 0; b < 2; ++b)
#pragma unroll
                for (int m = 0; m < 4; ++m)
#pragma unroll
                    for (int n = 0; n < 2; ++n) acc[a][b][m][n] = (f32x4){0.f, 0.f, 0.f, 0.f};
        cur = nxt; cA = nA; cB = nB; ++ui;
        if constexpr (ALIGN_EPI) { if (wr == 1) PG8_BAR; }
    }
    PG8_WAIT_V(0);
    if constexpr (!ALIGN_EPI) { if (wr == 0) PG8_BAR; }
    PG8_BAR;
    if constexpr (Epi::AFTER_DRAIN) { E.fused(acc, cur, wr, wc, fr, fq, lds, wid, lane); S.done(cur); }
#undef PG8_SA
#undef PG8_SB
#undef PG8_STAGE
#undef PG8_LDA
#undef PG8_LDB
#undef PG8_MMA
#undef PG8_WAIT_V
#undef PG8_WAIT_L
#undef PG8_BAR
#undef PG8_SCHED
}
}

#ifndef PG8_SP2
#define PG8_SP2 true
#endif
#ifndef PG8_ALIGN
#define PG8_ALIGN true
#endif
#include <hip/hip_bf16.h>
#include <cmath>
namespace attn_body {
using bf16=__hip_bfloat16;
using bf16x8=__attribute__((ext_vector_type(8)))short;
using s16x4=__attribute__((ext_vector_type(4)))short;
using f32x16=__attribute__((ext_vector_type(16)))float;
using u32x4=__attribute__((ext_vector_type(4)))unsigned;
constexpr int BATCH=4,SEQ=8192,D=64,PP=6144,OP=2048;
constexpr int NW=8,QBLK=32,QB=QBLK*NW,KVBLK=64,NQB=SEQ/QB;
constexpr int ATTN_UNIT_ROWS=QB;
__device__ __forceinline__ int crow(int r,int hi){return (r&3)+8*(r>>2)+4*hi;}
#define SBAR() __builtin_amdgcn_sched_barrier(0)
__device__ __forceinline__ void cmask(f32x16&p0,f32x16&p1,int jb,int qrel,int hi){
  const float NEG=-INFINITY; int kb=64*jb+4*hi;
  #pragma unroll
  for(int r=0;r<16;++r){int kv=kb+(r&3)+8*(r>>2); if(kv>qrel)p0[r]=NEG; if(kv+32>qrel)p1[r]=NEG;}
}

constexpr int NSLOT=3, SLOTB=8192;
constexpr int LDS_K=0, LDS_V=NSLOT*SLOTB, LDS_WS=2*NSLOT*SLOTB, LDS_OST=LDS_WS+NW*64*4, LDS_BYTES=LDS_OST+NW*4096;
constexpr float C2=0.125f*1.4426950408889634f;
__device__ __forceinline__ void glds16(const void*gsrc,unsigned lds_dst){unsigned keep;
  asm volatile("s_mov_b32 %0, m0\n\ts_mov_b32 m0, %2\n\ts_nop 0\n\tglobal_load_lds_dwordx4 %1, off\n\ts_mov_b32 m0, %0":"=&s"(keep):"v"(gsrc),"s"(lds_dst):"memory");}
__device__ __forceinline__ float max3f(float a,float b,float c){float r;asm("v_max3_f32 %0, %1, %2, %3":"=v"(r):"v"(a),"v"(b),"v"(c));return r;}
__device__ __forceinline__ float max2f(float a,float b){float r;asm("v_max_f32_e32 %0, %1, %2":"=v"(r):"v"(a),"v"(b));return r;}
__device__ __forceinline__ float fadd_s(float a,float b){float r;asm("v_add_f32_e32 %0, %1, %2":"=v"(r):"v"(a),"v"(b));return r;}
__device__ __forceinline__ float fsub_s(float a,float b){float r;asm("v_sub_f32_e32 %0, %1, %2":"=v"(r):"v"(a),"v"(b));return r;}
typedef float f32x2_t __attribute__((ext_vector_type(2))); typedef __bf16 bf16x2_t __attribute__((ext_vector_type(2)));
__device__ __forceinline__ unsigned cvtpk_s(float lo,float hi){f32x2_t v={lo,hi};bf16x2_t b=__builtin_convertvector(v,bf16x2_t);return __builtin_bit_cast(unsigned,b);}
#define WAIT_BAR(N) asm volatile("s_waitcnt vmcnt(" #N ") lgkmcnt(0)\n\ts_barrier":::"memory")

__device__ __forceinline__ void qkt(f32x16&p0,f32x16&p1,const char*Kslot,const bf16x8*qr,const f32x16&negm,int r32,int hi){
  const char*kb=Kslot+hi*1024+r32*16;
  #pragma unroll
  for(int d0=0;d0<4;++d0){
    const bf16x8 b0=*reinterpret_cast<const bf16x8*>(kb+d0*2048);
    const bf16x8 b1=*reinterpret_cast<const bf16x8*>(kb+d0*2048+512);
    if(d0==0){p0=__builtin_amdgcn_mfma_f32_32x32x16_bf16(b0,qr[0],negm,0,0,0);p1=__builtin_amdgcn_mfma_f32_32x32x16_bf16(b1,qr[0],negm,0,0,0);}
    else{p0=__builtin_amdgcn_mfma_f32_32x32x16_bf16(b0,qr[d0],p0,0,0,0);p1=__builtin_amdgcn_mfma_f32_32x32x16_bf16(b1,qr[d0],p1,0,0,0);}}
}
typedef __attribute__((address_space(3))) const char* lds_cptr;
typedef short v4i16_t __attribute__((ext_vector_type(4)));
__device__ __forceinline__ void kload8(bf16x8*kf,lds_cptr kp){
  kf[0]=*(const __attribute__((address_space(3))) bf16x8*)(kp);      kf[1]=*(const __attribute__((address_space(3))) bf16x8*)(kp+512);
  kf[2]=*(const __attribute__((address_space(3))) bf16x8*)(kp+2048); kf[3]=*(const __attribute__((address_space(3))) bf16x8*)(kp+2560);
  kf[4]=*(const __attribute__((address_space(3))) bf16x8*)(kp+4096); kf[5]=*(const __attribute__((address_space(3))) bf16x8*)(kp+4608);
  kf[6]=*(const __attribute__((address_space(3))) bf16x8*)(kp+6144); kf[7]=*(const __attribute__((address_space(3))) bf16x8*)(kp+6656);
}
__device__ __forceinline__ void kload2(bf16x8*kf,lds_cptr kp,int j){ kf[2*j]=*(const __attribute__((address_space(3))) bf16x8*)(kp+j*2048); kf[2*j+1]=*(const __attribute__((address_space(3))) bf16x8*)(kp+j*2048+512); }
__device__ __forceinline__ s16x4 vtr(lds_cptr p){ return __builtin_bit_cast(s16x4,__builtin_amdgcn_ds_read_tr16_b64_v4i16((__attribute__((address_space(3))) v4i16_t*)p)); }
__device__ __forceinline__ float rowmax(const f32x16&p0,const f32x16&p1){
  float a=max3f(p0[0],p0[1],p1[0]),b=max3f(p0[2],p0[3],p1[1]);a=max3f(a,p1[2],p1[3]);
  #pragma unroll
  for(int r=4;r<16;r+=4){a=max3f(a,p0[r],p0[r+1]);b=max3f(b,p0[r+2],p0[r+3]);a=max3f(a,p1[r],p1[r+1]);b=max3f(b,p1[r+2],p1[r+3]);}
  const float m=max2f(a,b);
  auto rr=__builtin_amdgcn_permlane32_swap(__float_as_uint(m),__float_as_uint(m),false,false);
  return max2f(__uint_as_float(rr[0]),__uint_as_float(rr[1]));
}
__device__ __forceinline__ void pv(f32x16*o,int vb,bf16x8 pa0,bf16x8 pa1,bf16x8 pa2,bf16x8 pa3){
  #pragma unroll
  for(int d0=0;d0<2;++d0){s16x4 lo[4],hi[4];
    #pragma unroll
    for(int ks=0;ks<4;++ks){
      asm volatile("ds_read_b64_tr_b16 %0,%1 offset:%c2":"=&v"(lo[ks]):"v"(vb),"i"(d0*4096+ks*1024):"memory");
      asm volatile("ds_read_b64_tr_b16 %0,%1 offset:%c2":"=&v"(hi[ks]):"v"(vb),"i"(d0*4096+ks*1024+512):"memory");}
    asm volatile("s_waitcnt lgkmcnt(0)":::"memory");SBAR();
    #define PK(k) (bf16x8){lo[k][0],lo[k][1],lo[k][2],lo[k][3],hi[k][0],hi[k][1],hi[k][2],hi[k][3]}
    o[d0]=__builtin_amdgcn_mfma_f32_32x32x16_bf16(pa0,PK(0),o[d0],0,0,0);
    o[d0]=__builtin_amdgcn_mfma_f32_32x32x16_bf16(pa1,PK(1),o[d0],0,0,0);
    o[d0]=__builtin_amdgcn_mfma_f32_32x32x16_bf16(pa2,PK(2),o[d0],0,0,0);
    o[d0]=__builtin_amdgcn_mfma_f32_32x32x16_bf16(pa3,PK(3),o[d0],0,0,0);
    #undef PK
  }
}

#ifndef ATTN_STORE16
#define ATTN_STORE16(p,v) (*(u32x4*)(p)=(v))
#endif
template<int THRL> __device__ __forceinline__ void attn_unit(int b,int qb,const bf16*Q,const bf16*__restrict__ K,const bf16*__restrict__ V,bf16*O,char*shm){
  const int tid=threadIdx.x,lane=tid&63,r32=lane&31,hi=lane>>5; const int wid=__builtin_amdgcn_readfirstlane(tid>>6);
  const long rowbase=(long)b*SEQ; const int q0=qb*QB;
  const bf16*Qw=Q+(rowbase+q0+wid*QBLK)*PP;
  const bf16*Kh=K+rowbase*PP,*Vh=V+rowbase*PP;
  const unsigned lds0=(unsigned)(uintptr_t)shm;
  float*wsf=(float*)(shm+LDS_WS)+wid*64;
  const bf16*ksrc=Kh+(long)lane*PP+wid*8;
  const bf16*vsrc=Vh+(long)(16*(wid&3)+(lane>>2))*PP+(wid>>2)*32+(lane&3)*8;
  const unsigned kdst=lds0+LDS_K+wid*1024, vdst=lds0+LDS_V+wid*1024;
  #define DMA_K(t,slot) glds16(ksrc+(long)(t)*KVBLK*PP,(unsigned)__builtin_amdgcn_readfirstlane(kdst+(slot)))
  #define DMA_V(t,slot) glds16(vsrc+(long)(t)*KVBLK*PP,(unsigned)__builtin_amdgcn_readfirstlane(vdst+(slot)))
  const int vb0=(int)(lds0+LDS_V)+((lane>>4)&1)*32+(lane&3)*8+(4*hi+((lane&15)>>2))*64;
  const char*Kbase=shm+LDS_K; bf16x8 kf[8];
  const lds_cptr shm3=(lds_cptr)shm; const lds_cptr kp0=shm3+LDS_K+hi*1024+r32*16; const lds_cptr vp0=shm3+LDS_V+((lane>>4)&1)*32+(lane&3)*8+(4*hi+((lane&15)>>2))*64;
  const int NT=(q0+QB)/KVBLK;
  DMA_K(0,0);DMA_V(0,0);DMA_K(1,SLOTB);
  bf16x8 qr[4];
  #pragma unroll
  for(int d0=0;d0<4;++d0)qr[d0]=*reinterpret_cast<const bf16x8*>(&Qw[(long)r32*PP+d0*16+hi*8]);
  float mhat=0.f,l_reg=0.f;f32x16 o[2];o[0]=f32x16{};o[1]=f32x16{};f32x16 negm=f32x16{};asm volatile("":"+v"(negm));
  const int qrel=wid*QBLK+r32;
  #define CMASK(P0,P1,t) do{int jb_=(t)-(NT-4); if(jb_>=0)cmask(P0,P1,jb_,qrel,hi);}while(0)
  bool resc=false;
  #define START(P0,P1) do{ const float rm=rowmax(P0,P1); resc=false; \
    { const float dl=rm; mhat=fadd_s(mhat,dl); \
      _Pragma("unroll") for(int r=0;r<16;++r){P0[r]=fsub_s(P0[r],dl);P1[r]=fsub_s(P1[r],dl);} \
      _Pragma("unroll") for(int r=0;r<16;++r)negm[r]=-mhat; asm volatile("":"+v"(negm)); } \
    _Pragma("unroll") for(int r=0;r<16;++r)P0[r]=__builtin_amdgcn_exp2f(P0[r]); }while(0)
  #define RESC() do{ if(resc){ asm volatile("s_waitcnt lgkmcnt(0)":::"memory"); \
      _Pragma("unroll") for(int d_=0;d_<2;++d_) _Pragma("unroll") for(int r=0;r<16;++r)o[d_][r]*=wsf[crow(r,hi)]; } }while(0)
  f32x16 pA0,pA1,pB0,pB1;
  int sl_prev=0,sl_cur=0,sl_next=SLOTB;
  #define ROT() do{sl_prev=sl_cur;sl_cur=sl_next;sl_next=(sl_next==(NSLOT-1)*SLOTB)?0:sl_next+SLOTB;}while(0)
  DMA_K(2,2*SLOTB);
  WAIT_BAR(3);
  qkt(pA0,pA1,Kbase,qr,negm,r32,hi);asm volatile("s_nop 15\n\ts_nop 7":"+v"(pA0),"+v"(pA1));CMASK(pA0,pA1,0);
  START(pA0,pA1);
  _Pragma("unroll") for(int r=0;r<16;++r)pA1[r]=__builtin_amdgcn_exp2f(pA1[r]);
  WAIT_BAR(0);
  DMA_K(3,0);DMA_V(1,SLOTB);
  ROT();
  kload8(kf,kp0+sl_cur);
  WAIT_BAR(2);
  s16x4 vlo[8],vhi[8]; u32x4 pw0,pw1,pw2,pw3;
  #define PKW(P,B) cvtpk_s(P[B],P[B+1])
  #define PAF(k) __builtin_bit_cast(bf16x8,pw##k)
  #define VFR(i) (bf16x8){vlo[i][0],vlo[i][1],vlo[i][2],vlo[i][3],vhi[i][0],vhi[i][1],vhi[i][2],vhi[i][3]}
  #define PIN(x) asm volatile("":"+v"(x))
  #define MX3(a,b,c) __builtin_fmaxf(__builtin_fmaxf((a),(b)),(c))
  #define GAPA(MF,A0,A1,A2,A3,W0,W1,PW) do{ MF; sacc+=A0; sacc+=A1; sacc+=A2; sacc+=A3; PIN(sacc); W0; W1; PIN(PW); SBAR(); }while(0)
  #define EX(v) __builtin_amdgcn_exp2f(v)
  #define GAPB(MF,X,B) do{ MF; X[B]=EX(X[B]); X[B+1]=EX(X[B+1]); X[B+2]=EX(X[B+2]); X[B+3]=EX(X[B+3]); PIN(X); SBAR(); }while(0)
  #define VRD(i) do{ vlo[i]=vtr(vp_+(((i)>>2)*4096+((i)&3)*1024)); vhi[i]=vtr(vp_+(((i)>>2)*4096+((i)&3)*1024+512)); }while(0)
  #define KRD(G,j) do{ if(G){ kload2(kf,kp0+sl_next,j); SBAR(); } }while(0)
  #define STEP(C0,C1,P0,P1,t,GK,GV,GL) do{ SBAR(); \
    const lds_cptr vp_=vp0+sl_prev; \
    VRD(0); SBAR(); float sacc=(P0[0]+P0[1]); \
    GAPA(C0=__builtin_amdgcn_mfma_f32_32x32x16_bf16(kf[0],qr[0],negm,0,0,0), P0[2],P0[3],P0[4],P0[5],     pw0[0]=PKW(P0,0), pw0[1]=PKW(P0,2), pw0); \
    VRD(4); SBAR(); GAPA(C1=__builtin_amdgcn_mfma_f32_32x32x16_bf16(kf[1],qr[0],negm,0,0,0), P0[6],P0[7],P0[8],P0[9],     pw0[2]=PKW(P0,4), pw0[3]=PKW(P0,6), pw0); \
    VRD(1); SBAR(); GAPA(C0=__builtin_amdgcn_mfma_f32_32x32x16_bf16(kf[2],qr[1],C0,0,0,0),   P0[10],P0[11],P0[12],P0[13], pw1[0]=PKW(P0,8), pw1[1]=PKW(P0,10), pw1); \
    VRD(5); SBAR(); GAPA(C1=__builtin_amdgcn_mfma_f32_32x32x16_bf16(kf[3],qr[1],C1,0,0,0),   P0[14],P0[15],P1[0],P1[1],   pw1[2]=PKW(P0,12),pw1[3]=PKW(P0,14), pw1); \
    VRD(2); SBAR(); GAPA(C0=__builtin_amdgcn_mfma_f32_32x32x16_bf16(kf[4],qr[2],C0,0,0,0),   P1[2],P1[3],P1[4],P1[5],     pw2[0]=PKW(P1,0), pw2[1]=PKW(P1,2), pw2); \
    VRD(6); SBAR(); GAPA(C1=__builtin_amdgcn_mfma_f32_32x32x16_bf16(kf[5],qr[2],C1,0,0,0),   P1[6],P1[7],P1[8],P1[9],     pw2[2]=PKW(P1,4), pw2[3]=PKW(P1,6), pw2); \
    VRD(3); SBAR(); GAPA(C0=__builtin_amdgcn_mfma_f32_32x32x16_bf16(kf[6],qr[3],C0,0,0,0),   P1[10],P1[11],P1[12],P1[13], pw3[0]=PKW(P1,8), pw3[1]=PKW(P1,10), pw3); \
    VRD(7); SBAR(); GAPA(C1=__builtin_amdgcn_mfma_f32_32x32x16_bf16(kf[7],qr[3],C1,0,0,0),   P1[14],P1[15],0.f,0.f,       pw3[2]=PKW(P1,12),pw3[3]=PKW(P1,14), pw3); \
    l_reg+=sacc; \
    if(GK){DMA_K((t)+3,sl_cur);} if(GV){DMA_V((t)+1,sl_next);} \
    CMASK(C0,C1,t); \
    { float a=MX3(C0[0],C0[1],C1[0]),b=MX3(C0[2],C0[3],C1[1]); a=MX3(a,C1[2],C1[3]); \
      _Pragma("unroll") for(int r=4;r<16;r+=4){a=MX3(a,C0[r],C0[r+1]);b=MX3(b,C0[r+2],C0[r+3]);a=MX3(a,C1[r],C1[r+1]);b=MX3(b,C1[r+2],C1[r+3]);} \
      float rm=__builtin_fmaxf(a,b); { auto rr=__builtin_amdgcn_permlane32_swap(__float_as_uint(rm),__float_as_uint(rm),false,false); rm=__builtin_fmaxf(__uint_as_float(rr[0]),__uint_as_float(rr[1])); } \
      resc=false; \
      if(__builtin_expect(__any(rm>(float)THRL),0)){ const float dl=__builtin_fmaxf(rm,0.f); mhat+=dl; \
        _Pragma("unroll") for(int r=0;r<16;++r){C0[r]-=dl;C1[r]-=dl;} \
        _Pragma("unroll") for(int r=0;r<16;++r)negm[r]=-mhat; asm volatile("":"+v"(negm)); \
        const float f=__builtin_amdgcn_exp2f(-dl); l_reg*=f; if(hi==0)wsf[r32]=f; resc=true; } } \
    SBAR(); \
    GAPB(o[0]=__builtin_amdgcn_mfma_f32_32x32x16_bf16(PAF(0),VFR(0),o[0],0,0,0), C0,0); \
    GAPB(o[1]=__builtin_amdgcn_mfma_f32_32x32x16_bf16(PAF(0),VFR(4),o[1],0,0,0), C0,4); \
    KRD(GL,0); GAPB(o[0]=__builtin_amdgcn_mfma_f32_32x32x16_bf16(PAF(1),VFR(1),o[0],0,0,0), C0,8); \
    KRD(GL,1); GAPB(o[1]=__builtin_amdgcn_mfma_f32_32x32x16_bf16(PAF(1),VFR(5),o[1],0,0,0), C0,12); \
    KRD(GL,2); GAPB(o[0]=__builtin_amdgcn_mfma_f32_32x32x16_bf16(PAF(2),VFR(2),o[0],0,0,0), C1,0); \
    KRD(GL,3); GAPB(o[1]=__builtin_amdgcn_mfma_f32_32x32x16_bf16(PAF(2),VFR(6),o[1],0,0,0), C1,4); \
    GAPB(o[0]=__builtin_amdgcn_mfma_f32_32x32x16_bf16(PAF(3),VFR(3),o[0],0,0,0), C1,8); \
    GAPB(o[1]=__builtin_amdgcn_mfma_f32_32x32x16_bf16(PAF(3),VFR(7),o[1],0,0,0), C1,12); \
    }while(0)
  int t=1;
  #undef CMASK
  #define CMASK(P0,P1,t) do{}while(0)
  for(;t+5<NT;t+=2){
    STEP(pB0,pB1,pA0,pA1,t,true,true,true);     WAIT_BAR(2); RESC(); ROT();
    STEP(pA0,pA1,pB0,pB1,t+1,true,true,true);   WAIT_BAR(2); RESC(); ROT();
  }
  #undef CMASK
  #define CMASK(P0,P1,t) do{int jb_=(t)-(NT-4); if(jb_>=0)cmask(P0,P1,jb_,qrel,hi);}while(0)
  #define ENDW(tt) do{ if((tt)+3<NT){WAIT_BAR(2);} else if((tt)+2<NT){WAIT_BAR(1);} else {WAIT_BAR(0);} }while(0)
  for(;t+1<NT;t+=2){
    STEP(pB0,pB1,pA0,pA1,t,(t+3<NT),(t+1<NT),(t+1<NT));       ENDW(t);   RESC(); ROT();
    STEP(pA0,pA1,pB0,pB1,t+1,(t+4<NT),(t+2<NT),(t+2<NT));     ENDW(t+1); RESC(); ROT();
  }
  STEP(pB0,pB1,pA0,pA1,NT-1,false,false,false); RESC();
  { float sacc=pB0[0]+pB0[1]; _Pragma("unroll") for(int r=2;r<16;++r)sacc+=pB0[r]; _Pragma("unroll") for(int r=0;r<16;++r)sacc+=pB1[r]; l_reg+=sacc;
    pw0=(u32x4){PKW(pB0,0),PKW(pB0,2),PKW(pB0,4),PKW(pB0,6)};pw1=(u32x4){PKW(pB0,8),PKW(pB0,10),PKW(pB0,12),PKW(pB0,14)};pw2=(u32x4){PKW(pB1,0),PKW(pB1,2),PKW(pB1,4),PKW(pB1,6)};pw3=(u32x4){PKW(pB1,8),PKW(pB1,10),PKW(pB1,12),PKW(pB1,14)};
    SBAR(); pv(o,vb0+sl_cur,PAF(0),PAF(1),PAF(2),PAF(3)); }
  #undef PKW
  #undef PAF
  #undef VFR
  #undef PIN
  #undef MX3
  #undef GAPA
  #undef GAPB
  #undef EX
  #undef VRD
  #undef KRD
  #undef STEP
  #undef ENDW
  {auto rr=__builtin_amdgcn_permlane32_swap(__float_as_uint(l_reg),__float_as_uint(l_reg),false,false);l_reg=__uint_as_float(rr[0])+__uint_as_float(rr[1]);}
  if(hi==0)wsf[32+r32]=l_reg;asm volatile("s_waitcnt lgkmcnt(0)":::"memory");
  float rli[16];
  #pragma unroll
  for(int r=0;r<16;++r)rli[r]=__builtin_amdgcn_rcpf(wsf[32+crow(r,hi)]);
  bf16*Ow=O+(rowbase+q0+wid*QBLK)*OP;
  { bf16*stg=(bf16*)(shm+LDS_OST)+wid*2048;
    #pragma unroll
    for(int r=0;r<16;++r){const int orow=crow(r,hi);
      #pragma unroll
      for(int d0=0;d0<2;++d0)stg[orow*64+d0*32+r32]=__float2bfloat16(o[d0][r]*rli[r]);}
    asm volatile("s_waitcnt lgkmcnt(0)":::"memory");
    #pragma unroll
    for(int i=0;i<4;++i){const int row=i*8+(lane>>3),ch=lane&7; const u32x4 v=*(const u32x4*)(stg+row*64+ch*8); ATTN_STORE16(Ow+(long)row*OP+ch*8,v);} }
  asm volatile("s_waitcnt lgkmcnt(0)\n\ts_barrier":::"memory");
  #undef DMA_K
  #undef DMA_V
  #undef CMASK
  #undef START
  #undef RESC
  #undef ROT
}
constexpr int ATTN_LDS_BYTES=LDS_BYTES;
struct AttnTensors { const bf16* P; bf16* O; };
struct AttnUnit { int bh; int qb; };
struct StaticOrder {
  int vcu;
  __device__ __forceinline__ explicit StaticOrder(int grid,int block):vcu((block%8)*(grid/8)+block/8){}
  __device__ __forceinline__ bool next(int i,AttnUnit&u)const{ if(i>=16)return false; const int s=vcu&7,j=i&3; u.bh=(i>>2)*32+(vcu>>3); u.qb=(j==0)?s:(j==1)?15-s:(j==2)?16+s:31-s; return true; }
};
template<class Sched,int THRL=8> __device__ __forceinline__ void attn_phase(char*lds,const AttnTensors&T,const Sched&S){
  AttnUnit u;
  for(int i=0;S.next(i,u);++i){ const int b=u.bh>>5,v=u.bh&31,hc=v>>1,h=v>>2,vh=v&1;
    attn_unit<THRL>(b,u.qb,T.P+3072+hc*64,T.P+4096+hc*64,T.P+5120+h*128+vh*64,T.O+v*64,lds); }
}
constexpr int SLOTK=8192, SLOTV=16384;
constexpr int L2_K=0, L2_V=3*SLOTK, L2_WS=L2_V+3*SLOTV, L2_OST=L2_WS+NW*64*4, LDS2_BYTES=L2_OST+NW*8192;
template<int THRL> __device__ __forceinline__ void attn_unit2(int b,int qb,const bf16*Q,const bf16*__restrict__ K,const bf16*__restrict__ V,bf16*O,char*shm){
  const int tid=threadIdx.x,lane=tid&63,r32=lane&31,hi=lane>>5; const int wid=__builtin_amdgcn_readfirstlane(tid>>6);
  const long rowbase=(long)b*SEQ; const int q0=qb*QB;
  const bf16*Qw=Q+(rowbase+q0+wid*QBLK)*PP;
  const bf16*Kh=K+rowbase*PP,*Vh=V+rowbase*PP;
  const unsigned lds0=(unsigned)(uintptr_t)shm;
  float*wsf=(float*)(shm+L2_WS)+wid*64;
  const bf16*ksrc=Kh+(long)lane*PP+wid*8;
  const bf16*vsrc=Vh+(long)(16*(wid&3)+(lane>>2))*PP+(wid>>2)*32+(lane&3)*8;
  const unsigned kdst=lds0+L2_K+wid*1024, vdst=lds0+L2_V+wid*1024;
  #define DMA2_K(t,s) glds16(ksrc+(long)(t)*KVBLK*PP,(unsigned)__builtin_amdgcn_readfirstlane(kdst+(s)*SLOTK))
  #define DMA2_V(t,s) do{ glds16(vsrc+(long)(t)*KVBLK*PP,(unsigned)__builtin_amdgcn_readfirstlane(vdst+(s)*SLOTV)); glds16(vsrc+(long)(t)*KVBLK*PP+64,(unsigned)__builtin_amdgcn_readfirstlane(vdst+(s)*SLOTV+8192)); }while(0)
  const int vb0=(int)(lds0+L2_V)+((lane>>4)&1)*32+(lane&3)*8+(4*hi+((lane&15)>>2))*64;
  bf16x8 qr[4];
  #pragma unroll
  for(int d0=0;d0<4;++d0)qr[d0]=*reinterpret_cast<const bf16x8*>(&Qw[(long)r32*PP+d0*16+hi*8]);
  const int NT=(q0+QB)/KVBLK;
  DMA2_K(0,0);DMA2_V(0,0);DMA2_K(1,1);DMA2_V(1,1);
  float mhat=0.f,l_reg=0.f;f32x16 o[4];o[0]=f32x16{};o[1]=f32x16{};o[2]=f32x16{};o[3]=f32x16{};f32x16 negm=f32x16{};asm volatile("":"+v"(negm));
  const int qrel=wid*QBLK+r32;
  int slot=0;
  for(int t=0;t<NT;++t){
    if(t+1<NT){WAIT_BAR(3);}else{WAIT_BAR(0);}
    if(t+2<NT){const int s2=(slot==0)?2:slot-1; DMA2_K(t+2,s2);DMA2_V(t+2,s2);}
    f32x16 p0,p1;
    qkt(p0,p1,shm+L2_K+slot*SLOTK,qr,negm,r32,hi);
    asm volatile("s_nop 15\n\ts_nop 7":"+v"(p0),"+v"(p1));
    if(t>=NT-4)cmask(p0,p1,t-(NT-4),qrel,hi);
    const float rm=rowmax(p0,p1);
    const bool first=(t==0);
    if(first||__any(rm>(float)THRL)){
      const float dl=first?rm:__builtin_fmaxf(rm,0.f); mhat+=dl;
      #pragma unroll
      for(int r=0;r<16;++r){p0[r]-=dl;p1[r]-=dl;}
      #pragma unroll
      for(int r=0;r<16;++r)negm[r]=-mhat;
      asm volatile("":"+v"(negm));
      if(!first){ const float f=__builtin_amdgcn_exp2f(-dl); l_reg*=f; if(hi==0)wsf[r32]=f; asm volatile("s_waitcnt lgkmcnt(0)":::"memory");
        #pragma unroll
        for(int d_=0;d_<4;++d_)
          #pragma unroll
          for(int r=0;r<16;++r)o[d_][r]*=wsf[crow(r,hi)];
        asm volatile("s_waitcnt lgkmcnt(0)":::"memory"); }
    }
    #pragma unroll
    for(int r=0;r<16;++r){p0[r]=__builtin_amdgcn_exp2f(p0[r]);p1[r]=__builtin_amdgcn_exp2f(p1[r]);}
    { float sa=0.f,sb=0.f;
      #pragma unroll
      for(int r=0;r<16;++r){sa+=p0[r];sb+=p1[r];}
      l_reg+=sa+sb; }
    u32x4 pw0,pw1,pw2,pw3;
    pw0=(u32x4){cvtpk_s(p0[0],p0[1]),cvtpk_s(p0[2],p0[3]),cvtpk_s(p0[4],p0[5]),cvtpk_s(p0[6],p0[7])};
    pw1=(u32x4){cvtpk_s(p0[8],p0[9]),cvtpk_s(p0[10],p0[11]),cvtpk_s(p0[12],p0[13]),cvtpk_s(p0[14],p0[15])};
    pw2=(u32x4){cvtpk_s(p1[0],p1[1]),cvtpk_s(p1[2],p1[3]),cvtpk_s(p1[4],p1[5]),cvtpk_s(p1[6],p1[7])};
    pw3=(u32x4){cvtpk_s(p1[8],p1[9]),cvtpk_s(p1[10],p1[11]),cvtpk_s(p1[12],p1[13]),cvtpk_s(p1[14],p1[15])};
    SBAR();
    pv(o,vb0+slot*SLOTV,__builtin_bit_cast(bf16x8,pw0),__builtin_bit_cast(bf16x8,pw1),__builtin_bit_cast(bf16x8,pw2),__builtin_bit_cast(bf16x8,pw3));
    pv(o+2,vb0+slot*SLOTV+8192,__builtin_bit_cast(bf16x8,pw0),__builtin_bit_cast(bf16x8,pw1),__builtin_bit_cast(bf16x8,pw2),__builtin_bit_cast(bf16x8,pw3));
    slot=(slot==2)?0:slot+1;
  }
  {auto rr=__builtin_amdgcn_permlane32_swap(__float_as_uint(l_reg),__float_as_uint(l_reg),false,false);l_reg=__uint_as_float(rr[0])+__uint_as_float(rr[1]);}
  if(hi==0)wsf[32+r32]=l_reg;asm volatile("s_waitcnt lgkmcnt(0)":::"memory");
  float rli[16];
  #pragma unroll
  for(int r=0;r<16;++r)rli[r]=__builtin_amdgcn_rcpf(wsf[32+crow(r,hi)]);
  bf16*Ow=O+(rowbase+q0+wid*QBLK)*OP;
  { bf16*stg=(bf16*)(shm+L2_OST)+wid*4096;
    #pragma unroll
    for(int r=0;r<16;++r){const int orow=crow(r,hi);
      #pragma unroll
      for(int d0=0;d0<4;++d0)stg[orow*128+d0*32+r32]=__float2bfloat16(o[d0][r]*rli[r]);}
    asm volatile("s_waitcnt lgkmcnt(0)":::"memory");
    #pragma unroll
    for(int i=0;i<8;++i){const int row=i*4+(lane>>4),ch=lane&15; const u32x4 v=*(const u32x4*)(stg+row*128+ch*8); ATTN_STORE16(Ow+(long)row*OP+ch*8,v);} }
  asm volatile("s_waitcnt lgkmcnt(0)\n\ts_barrier":::"memory");
  #undef DMA2_K
  #undef DMA2_V
}
struct StaticOrder2 {
  int vcu;
  __device__ __forceinline__ explicit StaticOrder2(int grid,int block):vcu((block%8)*(grid/8)+block/8){}
  __device__ __forceinline__ bool next(int i,AttnUnit&u)const{ if(i>=8)return false; const int s=vcu&7,j=i&3; u.bh=(i>>2)*32+(vcu>>3); u.qb=(j==0)?s:(j==1)?15-s:(j==2)?16+s:31-s; return true; }
};
template<class Sched,int THRL=8> __device__ __forceinline__ void attn_phase2(char*lds,const AttnTensors&T,const Sched&S){
  AttnUnit u;
  for(int i=0;S.next(i,u);++i){ const int b=u.bh>>4,hc=u.bh&15,h=hc>>1;
    attn_unit2<THRL>(b,u.qb,T.P+3072+hc*64,T.P+4096+hc*64,T.P+5120+h*128,T.O+hc*128,lds); }
}

constexpr int NSK=4;
constexpr int L3_K=0, L3_V=NSK*SLOTK, L3_WS=L3_V+3*SLOTV, L3_Q=L3_WS+NW*64*4, LDS3_BYTES=L3_Q+NW*4096;
__device__ __forceinline__ float rowmax_c(const f32x16&p0,const f32x16&p1){
  #define MX3C(a,b,c) __builtin_fmaxf(__builtin_fmaxf((a),(b)),(c))
  float a=MX3C(p0[0],p0[1],p1[0]),b=MX3C(p0[2],p0[3],p1[1]);a=MX3C(a,p1[2],p1[3]);
  #pragma unroll
  for(int r=4;r<16;r+=4){a=MX3C(a,p0[r],p0[r+1]);b=MX3C(b,p0[r+2],p0[r+3]);a=MX3C(a,p1[r],p1[r+1]);b=MX3C(b,p1[r+2],p1[r+3]);}
  #undef MX3C
  const float m=__builtin_fmaxf(a,b);
  auto rr=__builtin_amdgcn_permlane32_swap(__float_as_uint(m),__float_as_uint(m),false,false);
  return __builtin_fmaxf(__uint_as_float(rr[0]),__uint_as_float(rr[1]));
}

__device__ __forceinline__ void qkt4(f32x16&p0,f32x16&p1,lds_cptr kp,lds_cptr qp,const f32x16&negm){
  #define KFR(off) (*(const __attribute__((address_space(3))) bf16x8*)(kp+(off)))
  #define QFR(d0) (*(const __attribute__((address_space(3))) bf16x8*)(qp+(d0)*1024))
  bf16x8 ka=KFR(0),kb=KFR(512),q0=QFR(0),kc=KFR(2048),kd=KFR(2560),q1=QFR(1); SBAR();
  p0=__builtin_amdgcn_mfma_f32_32x32x16_bf16(ka,q0,negm,0,0,0); ka=KFR(4096); SBAR();
  p1=__builtin_amdgcn_mfma_f32_32x32x16_bf16(kb,q0,negm,0,0,0); kb=KFR(4608); q0=QFR(2); SBAR();
  p0=__builtin_amdgcn_mfma_f32_32x32x16_bf16(kc,q1,p0,0,0,0);   kc=KFR(6144); SBAR();
  p1=__builtin_amdgcn_mfma_f32_32x32x16_bf16(kd,q1,p1,0,0,0);   kd=KFR(6656); q1=QFR(3); SBAR();
  p0=__builtin_amdgcn_mfma_f32_32x32x16_bf16(ka,q0,p0,0,0,0); SBAR();
  p1=__builtin_amdgcn_mfma_f32_32x32x16_bf16(kb,q0,p1,0,0,0); SBAR();
  p0=__builtin_amdgcn_mfma_f32_32x32x16_bf16(kc,q1,p0,0,0,0); SBAR();
  p1=__builtin_amdgcn_mfma_f32_32x32x16_bf16(kd,q1,p1,0,0,0); SBAR();
  #undef KFR
  #undef QFR
}
template<int THRL> __device__ __forceinline__ void attn_unit3(int b,int qb,const bf16*Q,const bf16*__restrict__ K,const bf16*__restrict__ V,bf16*O,char*shm){
  const int tid=threadIdx.x,lane=tid&63,r32=lane&31,hi=lane>>5; const int wid=__builtin_amdgcn_readfirstlane(tid>>6);
  const long rowbase=(long)b*SEQ; const int q0=qb*QB;
  const bf16*Qw=Q+(rowbase+q0+wid*QBLK)*PP;
  const bf16*Kh=K+rowbase*PP,*Vh=V+rowbase*PP;
  const unsigned lds0=(unsigned)(uintptr_t)shm;
  float*wsf=(float*)(shm+L3_WS)+wid*64;
  const bf16*ksrc=Kh+(long)lane*PP+wid*8;
  const bf16*vsrc=Vh+(long)(16*(wid&3)+(lane>>2))*PP+(wid>>2)*32+(lane&3)*8;
  const unsigned kdst=lds0+L3_K+wid*1024, vdst=lds0+L3_V+wid*1024;
  #define DMA3_K(t) glds16(ksrc+(long)(t)*KVBLK*PP,(unsigned)__builtin_amdgcn_readfirstlane(kdst+((t)&3)*SLOTK))
  #define DMA3_V(t,s) do{ glds16(vsrc+(long)(t)*KVBLK*PP,(unsigned)__builtin_amdgcn_readfirstlane(vdst+(s)*SLOTV)); glds16(vsrc+(long)(t)*KVBLK*PP+64,(unsigned)__builtin_amdgcn_readfirstlane(vdst+(s)*SLOTV+8192)); }while(0)
  const lds_cptr shm3=(lds_cptr)shm; const lds_cptr kp0=shm3+L3_K+hi*1024+r32*16; const lds_cptr vp0=shm3+L3_V+((lane>>4)&1)*32+(lane&3)*8+(4*hi+((lane&15)>>2))*64;
  const lds_cptr qp=shm3+L3_Q+wid*4096+lane*16;
  { bf16x8 qr[4];
    #pragma unroll
    for(int d0=0;d0<4;++d0)qr[d0]=*reinterpret_cast<const bf16x8*>(&Qw[(long)r32*PP+d0*16+hi*8]);
    #pragma unroll
    for(int d0=0;d0<4;++d0)*(__attribute__((address_space(3))) bf16x8*)((__attribute__((address_space(3))) char*)qp+d0*1024)=qr[d0]; }
  const int NT=(q0+QB)/KVBLK;
  DMA3_K(0);DMA3_V(0,0);DMA3_K(1);DMA3_V(1,1);DMA3_K(2);
  float mhat=0.f;f32x16 lacc=f32x16{};const bf16x8 ones={16256,16256,16256,16256,16256,16256,16256,16256};     f32x16 o[4];o[0]=f32x16{};o[1]=f32x16{};o[2]=f32x16{};o[3]=f32x16{};f32x16 negm=f32x16{};asm volatile("":"+v"(negm));
  const int qrel=wid*QBLK+r32;
  WAIT_BAR(3);
  DMA3_K(3);DMA3_V(2,2);
  f32x16 p0,p1; u32x4 pw0,pw1,pw2,pw3;
  qkt4(p0,p1,kp0,qp,negm);
  if(NT==4)cmask(p0,p1,0,qrel,hi);
  { const float rm=rowmax_c(p0,p1); mhat=rm;
    #pragma unroll
    for(int r=0;r<16;++r){p0[r]=__builtin_amdgcn_exp2f(p0[r]-rm);p1[r]=__builtin_amdgcn_exp2f(p1[r]-rm);}
    #pragma unroll
    for(int r=0;r<16;++r)negm[r]=-mhat;
    asm volatile("":"+v"(negm));
    pw0=(u32x4){cvtpk_s(p0[0],p0[1]),cvtpk_s(p0[2],p0[3]),cvtpk_s(p0[4],p0[5]),cvtpk_s(p0[6],p0[7])};
    pw1=(u32x4){cvtpk_s(p0[8],p0[9]),cvtpk_s(p0[10],p0[11]),cvtpk_s(p0[12],p0[13]),cvtpk_s(p0[14],p0[15])};
    pw2=(u32x4){cvtpk_s(p1[0],p1[1]),cvtpk_s(p1[2],p1[3]),cvtpk_s(p1[4],p1[5]),cvtpk_s(p1[6],p1[7])};
    pw3=(u32x4){cvtpk_s(p1[8],p1[9]),cvtpk_s(p1[10],p1[11]),cvtpk_s(p1[12],p1[13]),cvtpk_s(p1[14],p1[15])}; }
  int vs=0;
  #define VFL(dq,ks) ({ const s16x4 lo_=vtr(vp_+((dq)*4096+(ks)*1024)),hi_=vtr(vp_+((dq)*4096+(ks)*1024+512)); (bf16x8){lo_[0],lo_[1],lo_[2],lo_[3],hi_[0],hi_[1],hi_[2],hi_[3]}; })
  u32x4 n0=(u32x4){0u,0u,0u,0u},n1=n0,n2=n0,n3=n0;
  for(int t2=0;t2<NT;t2+=2){
   { const int t=t2;
    const bool more=(t+1<NT);
    if(t>0){
      if(t+2<NT){WAIT_BAR(3);}else if(more){WAIT_BAR(2);}else{WAIT_BAR(0);}
      if(t+3<NT)DMA3_K(t+3);
      if(t+2<NT){const int s2=(vs==0)?2:vs-1; DMA3_V(t+2,s2);}
    }
    bool resc=false;
    if(more){
      qkt4(p0,p1,kp0+((t+1)&3)*SLOTK,qp,negm);
      if(t+1>=NT-4)cmask(p0,p1,t+1-(NT-4),qrel,hi);
      const float rm=rowmax_c(p0,p1);
      if(__builtin_expect(__any(rm>(float)THRL),0)){ const float dl=__builtin_fmaxf(rm,0.f); mhat+=dl;
        #pragma unroll
        for(int r=0;r<16;++r){p0[r]-=dl;p1[r]-=dl;}
        #pragma unroll
        for(int r=0;r<16;++r)negm[r]=-mhat;
        asm volatile("":"+v"(negm));
        const float f=__builtin_amdgcn_exp2f(-dl); if(hi==0)wsf[r32]=f; resc=true; }
    }
    const lds_cptr vp_=vp0+vs*SLOTV;
    bf16x8 vf0=VFL(0,0),vf1=VFL(1,0),vf2=VFL(2,0),vf3=VFL(3,0);

    SBAR();
    o[0]=__builtin_amdgcn_mfma_f32_32x32x16_bf16(__builtin_bit_cast(bf16x8,pw0),vf0,o[0],0,0,0); vf0=VFL(0,1); asm volatile("":"+v"(p0)); { const float e0=__builtin_amdgcn_exp2f(p0[0]),e1=__builtin_amdgcn_exp2f(p0[1]); n0[0]=cvtpk_s(e0,e1); } asm volatile("":"+v"(n0)); SBAR();
    o[1]=__builtin_amdgcn_mfma_f32_32x32x16_bf16(__builtin_bit_cast(bf16x8,pw0),vf1,o[1],0,0,0); vf1=VFL(1,1); asm volatile("":"+v"(p0)); { const float e0=__builtin_amdgcn_exp2f(p0[2]),e1=__builtin_amdgcn_exp2f(p0[3]); n0[1]=cvtpk_s(e0,e1); } asm volatile("":"+v"(n0)); SBAR();
    o[2]=__builtin_amdgcn_mfma_f32_32x32x16_bf16(__builtin_bit_cast(bf16x8,pw0),vf2,o[2],0,0,0); vf2=VFL(2,1); asm volatile("":"+v"(p0)); { const float e0=__builtin_amdgcn_exp2f(p0[4]),e1=__builtin_amdgcn_exp2f(p0[5]); n0[2]=cvtpk_s(e0,e1); } asm volatile("":"+v"(n0)); SBAR();
    o[3]=__builtin_amdgcn_mfma_f32_32x32x16_bf16(__builtin_bit_cast(bf16x8,pw0),vf3,o[3],0,0,0); vf3=VFL(3,1); asm volatile("":"+v"(p0)); { const float e0=__builtin_amdgcn_exp2f(p0[6]),e1=__builtin_amdgcn_exp2f(p0[7]); n0[3]=cvtpk_s(e0,e1); } asm volatile("":"+v"(n0)); SBAR();
    lacc=__builtin_amdgcn_mfma_f32_32x32x16_bf16(__builtin_bit_cast(bf16x8,pw0),ones,lacc,0,0,0); SBAR();
    o[0]=__builtin_amdgcn_mfma_f32_32x32x16_bf16(__builtin_bit_cast(bf16x8,pw1),vf0,o[0],0,0,0); vf0=VFL(0,2); asm volatile("":"+v"(p0)); { const float e0=__builtin_amdgcn_exp2f(p0[8]),e1=__builtin_amdgcn_exp2f(p0[9]); n1[0]=cvtpk_s(e0,e1); } asm volatile("":"+v"(n1)); SBAR();
    o[1]=__builtin_amdgcn_mfma_f32_32x32x16_bf16(__builtin_bit_cast(bf16x8,pw1),vf1,o[1],0,0,0); vf1=VFL(1,2); asm volatile("":"+v"(p0)); { const float e0=__builtin_amdgcn_exp2f(p0[10]),e1=__builtin_amdgcn_exp2f(p0[11]); n1[1]=cvtpk_s(e0,e1); } asm volatile("":"+v"(n1)); SBAR();
    o[2]=__builtin_amdgcn_mfma_f32_32x32x16_bf16(__builtin_bit_cast(bf16x8,pw1),vf2,o[2],0,0,0); vf2=VFL(2,2); asm volatile("":"+v"(p0)); { const float e0=__builtin_amdgcn_exp2f(p0[12]),e1=__builtin_amdgcn_exp2f(p0[13]); n1[2]=cvtpk_s(e0,e1); } asm volatile("":"+v"(n1)); SBAR();
    o[3]=__builtin_amdgcn_mfma_f32_32x32x16_bf16(__builtin_bit_cast(bf16x8,pw1),vf3,o[3],0,0,0); vf3=VFL(3,2); asm volatile("":"+v"(p0)); { const float e0=__builtin_amdgcn_exp2f(p0[14]),e1=__builtin_amdgcn_exp2f(p0[15]); n1[3]=cvtpk_s(e0,e1); } asm volatile("":"+v"(n1)); SBAR();
    lacc=__builtin_amdgcn_mfma_f32_32x32x16_bf16(__builtin_bit_cast(bf16x8,pw1),ones,lacc,0,0,0); SBAR();
    o[0]=__builtin_amdgcn_mfma_f32_32x32x16_bf16(__builtin_bit_cast(bf16x8,pw2),vf0,o[0],0,0,0); vf0=VFL(0,3); asm volatile("":"+v"(p1)); { const float e0=__builtin_amdgcn_exp2f(p1[0]),e1=__builtin_amdgcn_exp2f(p1[1]); n2[0]=cvtpk_s(e0,e1); } asm volatile("":"+v"(n2)); SBAR();
    o[1]=__builtin_amdgcn_mfma_f32_32x32x16_bf16(__builtin_bit_cast(bf16x8,pw2),vf1,o[1],0,0,0); vf1=VFL(1,3); asm volatile("":"+v"(p1)); { const float e0=__builtin_amdgcn_exp2f(p1[2]),e1=__builtin_amdgcn_exp2f(p1[3]); n2[1]=cvtpk_s(e0,e1); } asm volatile("":"+v"(n2)); SBAR();
    o[2]=__builtin_amdgcn_mfma_f32_32x32x16_bf16(__builtin_bit_cast(bf16x8,pw2),vf2,o[2],0,0,0); vf2=VFL(2,3); asm volatile("":"+v"(p1)); { const float e0=__builtin_amdgcn_exp2f(p1[4]),e1=__builtin_amdgcn_exp2f(p1[5]); n2[2]=cvtpk_s(e0,e1); } asm volatile("":"+v"(n2)); SBAR();
    o[3]=__builtin_amdgcn_mfma_f32_32x32x16_bf16(__builtin_bit_cast(bf16x8,pw2),vf3,o[3],0,0,0); vf3=VFL(3,3); asm volatile("":"+v"(p1)); { const float e0=__builtin_amdgcn_exp2f(p1[6]),e1=__builtin_amdgcn_exp2f(p1[7]); n2[3]=cvtpk_s(e0,e1); } asm volatile("":"+v"(n2)); SBAR();
    lacc=__builtin_amdgcn_mfma_f32_32x32x16_bf16(__builtin_bit_cast(bf16x8,pw2),ones,lacc,0,0,0); SBAR();
    o[0]=__builtin_amdgcn_mfma_f32_32x32x16_bf16(__builtin_bit_cast(bf16x8,pw3),vf0,o[0],0,0,0); asm volatile("":"+v"(p1)); { const float e0=__builtin_amdgcn_exp2f(p1[8]),e1=__builtin_amdgcn_exp2f(p1[9]); n3[0]=cvtpk_s(e0,e1); } asm volatile("":"+v"(n3)); SBAR();
    o[1]=__builtin_amdgcn_mfma_f32_32x32x16_bf16(__builtin_bit_cast(bf16x8,pw3),vf1,o[1],0,0,0); asm volatile("":"+v"(p1)); { const float e0=__builtin_amdgcn_exp2f(p1[10]),e1=__builtin_amdgcn_exp2f(p1[11]); n3[1]=cvtpk_s(e0,e1); } asm volatile("":"+v"(n3)); SBAR();
    o[2]=__builtin_amdgcn_mfma_f32_32x32x16_bf16(__builtin_bit_cast(bf16x8,pw3),vf2,o[2],0,0,0); asm volatile("":"+v"(p1)); { const float e0=__builtin_amdgcn_exp2f(p1[12]),e1=__builtin_amdgcn_exp2f(p1[13]); n3[2]=cvtpk_s(e0,e1); } asm volatile("":"+v"(n3)); SBAR();
    o[3]=__builtin_amdgcn_mfma_f32_32x32x16_bf16(__builtin_bit_cast(bf16x8,pw3),vf3,o[3],0,0,0); asm volatile("":"+v"(p1)); { const float e0=__builtin_amdgcn_exp2f(p1[14]),e1=__builtin_amdgcn_exp2f(p1[15]); n3[3]=cvtpk_s(e0,e1); } asm volatile("":"+v"(n3)); SBAR();
    lacc=__builtin_amdgcn_mfma_f32_32x32x16_bf16(__builtin_bit_cast(bf16x8,pw3),ones,lacc,0,0,0); SBAR();
    if(resc){ asm volatile("s_waitcnt lgkmcnt(0)":::"memory");
      #pragma unroll
      for(int d_=0;d_<4;++d_)
        #pragma unroll
        for(int r=0;r<16;++r)o[d_][r]*=wsf[crow(r,hi)];
      #pragma unroll
      for(int r=0;r<16;++r)lacc[r]*=wsf[crow(r,hi)];
      asm volatile("s_waitcnt lgkmcnt(0)":::"memory"); }
    vs=(vs==2)?0:vs+1;
     }
   { const int t=t2+1;
    const bool more=(t+1<NT);
    if(t>0){
      if(t+2<NT){WAIT_BAR(3);}else if(more){WAIT_BAR(2);}else{WAIT_BAR(0);}
      if(t+3<NT)DMA3_K(t+3);
      if(t+2<NT){const int s2=(vs==0)?2:vs-1; DMA3_V(t+2,s2);}
    }
    bool resc=false;
    if(more){
      qkt4(p0,p1,kp0+((t+1)&3)*SLOTK,qp,negm);
      if(t+1>=NT-4)cmask(p0,p1,t+1-(NT-4),qrel,hi);
      const float rm=rowmax_c(p0,p1);
      if(__builtin_expect(__any(rm>(float)THRL),0)){ const float dl=__builtin_fmaxf(rm,0.f); mhat+=dl;
        #pragma unroll
        for(int r=0;r<16;++r){p0[r]-=dl;p1[r]-=dl;}
        #pragma unroll
        for(int r=0;r<16;++r)negm[r]=-mhat;
        asm volatile("":"+v"(negm));
        const float f=__builtin_amdgcn_exp2f(-dl); if(hi==0)wsf[r32]=f; resc=true; }
    }
    const lds_cptr vp_=vp0+vs*SLOTV;
    bf16x8 vf0=VFL(0,0),vf1=VFL(1,0),vf2=VFL(2,0),vf3=VFL(3,0);

    SBAR();
    o[0]=__builtin_amdgcn_mfma_f32_32x32x16_bf16(__builtin_bit_cast(bf16x8,n0),vf0,o[0],0,0,0); vf0=VFL(0,1); asm volatile("":"+v"(p0)); { const float e0=__builtin_amdgcn_exp2f(p0[0]),e1=__builtin_amdgcn_exp2f(p0[1]); pw0[0]=cvtpk_s(e0,e1); } asm volatile("":"+v"(pw0)); SBAR();
    o[1]=__builtin_amdgcn_mfma_f32_32x32x16_bf16(__builtin_bit_cast(bf16x8,n0),vf1,o[1],0,0,0); vf1=VFL(1,1); asm volatile("":"+v"(p0)); { const float e0=__builtin_amdgcn_exp2f(p0[2]),e1=__builtin_amdgcn_exp2f(p0[3]); pw0[1]=cvtpk_s(e0,e1); } asm volatile("":"+v"(pw0)); SBAR();
    o[2]=__builtin_amdgcn_mfma_f32_32x32x16_bf16(__builtin_bit_cast(bf16x8,n0),vf2,o[2],0,0,0); vf2=VFL(2,1); asm volatile("":"+v"(p0)); { const float e0=__builtin_amdgcn_exp2f(p0[4]),e1=__builtin_amdgcn_exp2f(p0[5]); pw0[2]=cvtpk_s(e0,e1); } asm volatile("":"+v"(pw0)); SBAR();
    o[3]=__builtin_amdgcn_mfma_f32_32x32x16_bf16(__builtin_bit_cast(bf16x8,n0),vf3,o[3],0,0,0); vf3=VFL(3,1); asm volatile("":"+v"(p0)); { const float e0=__builtin_amdgcn_exp2f(p0[6]),e1=__builtin_amdgcn_exp2f(p0[7]); pw0[3]=cvtpk_s(e0,e1); } asm volatile("":"+v"(pw0)); SBAR();
    lacc=__builtin_amdgcn_mfma_f32_32x32x16_bf16(__builtin_bit_cast(bf16x8,n0),ones,lacc,0,0,0); SBAR();
    o[0]=__builtin_amdgcn_mfma_f32_32x32x16_bf16(__builtin_bit_cast(bf16x8,n1),vf0,o[0],0,0,0); vf0=VFL(0,2); asm volatile("":"+v"(p0)); { const float e0=__builtin_amdgcn_exp2f(p0[8]),e1=__builtin_amdgcn_exp2f(p0[9]); pw1[0]=cvtpk_s(e0,e1); } asm volatile("":"+v"(pw1)); SBAR();
    o[1]=__builtin_amdgcn_mfma_f32_32x32x16_bf16(__builtin_bit_cast(bf16x8,n1),vf1,o[1],0,0,0); vf1=VFL(1,2); asm volatile("":"+v"(p0)); { const float e0=__builtin_amdgcn_exp2f(p0[10]),e1=__builtin_amdgcn_exp2f(p0[11]); pw1[1]=cvtpk_s(e0,e1); } asm volatile("":"+v"(pw1)); SBAR();
    o[2]=__builtin_amdgcn_mfma_f32_32x32x16_bf16(__builtin_bit_cast(bf16x8,n1),vf2,o[2],0,0,0); vf2=VFL(2,2); asm volatile("":"+v"(p0)); { const float e0=__builtin_amdgcn_exp2f(p0[12]),e1=__builtin_amdgcn_exp2f(p0[13]); pw1[2]=cvtpk_s(e0,e1); } asm volatile("":"+v"(pw1)); SBAR();
    o[3]=__builtin_amdgcn_mfma_f32_32x32x16_bf16(__builtin_bit_cast(bf16x8,n1),vf3,o[3],0,0,0); vf3=VFL(3,2); asm volatile("":"+v"(p0)); { const float e0=__builtin_amdgcn_exp2f(p0[14]),e1=__builtin_amdgcn_exp2f(p0[15]); pw1[3]=cvtpk_s(e0,e1); } asm volatile("":"+v"(pw1)); SBAR();
    lacc=__builtin_amdgcn_mfma_f32_32x32x16_bf16(__builtin_bit_cast(bf16x8,n1),ones,lacc,0,0,0); SBAR();
    o[0]=__builtin_amdgcn_mfma_f32_32x32x16_bf16(__builtin_bit_cast(bf16x8,n2),vf0,o[0],0,0,0); vf0=VFL(0,3); asm volatile("":"+v"(p1)); { const float e0=__builtin_amdgcn_exp2f(p1[0]),e1=__builtin_amdgcn_exp2f(p1[1]); pw2[0]=cvtpk_s(e0,e1); } asm volatile("":"+v"(pw2)); SBAR();
    o[1]=__builtin_amdgcn_mfma_f32_32x32x16_bf16(__builtin_bit_cast(bf16x8,n2),vf1,o[1],0,0,0); vf1=VFL(1,3); asm volatile("":"+v"(p1)); { const float e0=__builtin_amdgcn_exp2f(p1[2]),e1=__builtin_amdgcn_exp2f(p1[3]); pw2[1]=cvtpk_s(e0,e1); } asm volatile("":"+v"(pw2)); SBAR();
    o[2]=__builtin_amdgcn_mfma_f32_32x32x16_bf16(__builtin_bit_cast(bf16x8,n2),vf2,o[2],0,0,0); vf2=VFL(2,3); asm volatile("":"+v"(p1)); { const float e0=__builtin_amdgcn_exp2f(p1[4]),e1=__builtin_amdgcn_exp2f(p1[5]); pw2[2]=cvtpk_s(e0,e1); } asm volatile("":"+v"(pw2)); SBAR();
    o[3]=__builtin_amdgcn_mfma_f32_32x32x16_bf16(__builtin_bit_cast(bf16x8,n2),vf3,o[3],0,0,0); vf3=VFL(3,3); asm volatile("":"+v"(p1)); { const float e0=__builtin_amdgcn_exp2f(p1[6]),e1=__builtin_amdgcn_exp2f(p1[7]); pw2[3]=cvtpk_s(e0,e1); } asm volatile("":"+v"(pw2)); SBAR();
    lacc=__builtin_amdgcn_mfma_f32_32x32x16_bf16(__builtin_bit_cast(bf16x8,n2),ones,lacc,0,0,0); SBAR();
    o[0]=__builtin_amdgcn_mfma_f32_32x32x16_bf16(__builtin_bit_cast(bf16x8,n3),vf0,o[0],0,0,0); asm volatile("":"+v"(p1)); { const float e0=__builtin_amdgcn_exp2f(p1[8]),e1=__builtin_amdgcn_exp2f(p1[9]); pw3[0]=cvtpk_s(e0,e1); } asm volatile("":"+v"(pw3)); SBAR();
    o[1]=__builtin_amdgcn_mfma_f32_32x32x16_bf16(__builtin_bit_cast(bf16x8,n3),vf1,o[1],0,0,0); asm volatile("":"+v"(p1)); { const float e0=__builtin_amdgcn_exp2f(p1[10]),e1=__builtin_amdgcn_exp2f(p1[11]); pw3[1]=cvtpk_s(e0,e1); } asm volatile("":"+v"(pw3)); SBAR();
    o[2]=__builtin_amdgcn_mfma_f32_32x32x16_bf16(__builtin_bit_cast(bf16x8,n3),vf2,o[2],0,0,0); asm volatile("":"+v"(p1)); { const float e0=__builtin_amdgcn_exp2f(p1[12]),e1=__builtin_amdgcn_exp2f(p1[13]); pw3[2]=cvtpk_s(e0,e1); } asm volatile("":"+v"(pw3)); SBAR();
    o[3]=__builtin_amdgcn_mfma_f32_32x32x16_bf16(__builtin_bit_cast(bf16x8,n3),vf3,o[3],0,0,0); asm volatile("":"+v"(p1)); { const float e0=__builtin_amdgcn_exp2f(p1[14]),e1=__builtin_amdgcn_exp2f(p1[15]); pw3[3]=cvtpk_s(e0,e1); } asm volatile("":"+v"(pw3)); SBAR();
    lacc=__builtin_amdgcn_mfma_f32_32x32x16_bf16(__builtin_bit_cast(bf16x8,n3),ones,lacc,0,0,0); SBAR();
    if(resc){ asm volatile("s_waitcnt lgkmcnt(0)":::"memory");
      #pragma unroll
      for(int d_=0;d_<4;++d_)
        #pragma unroll
        for(int r=0;r<16;++r)o[d_][r]*=wsf[crow(r,hi)];
      #pragma unroll
      for(int r=0;r<16;++r)lacc[r]*=wsf[crow(r,hi)];
      asm volatile("s_waitcnt lgkmcnt(0)":::"memory"); }
    vs=(vs==2)?0:vs+1;
     }
  }
  #undef VFL
  WAIT_BAR(0);
  float rli[16];
  #pragma unroll
  for(int r=0;r<16;++r)rli[r]=__builtin_amdgcn_rcpf(lacc[r]);
  bf16*Ow=O+(rowbase+q0+wid*QBLK)*OP;
  { int ln=lane; asm volatile("":"+v"(ln));
    const int r32e=ln&31,hie=ln>>5;
    bf16*stg=(bf16*)shm+wid*4096;
    bf16*sw=stg+4*hie*128+r32e;
    #pragma unroll
    for(int r=0;r<16;++r){
      #pragma unroll
      for(int d0=0;d0<4;++d0)sw[((r&3)+8*(r>>2))*128+d0*32]=__float2bfloat16(o[d0][r]*rli[r]);}
    asm volatile("s_waitcnt lgkmcnt(0)":::"memory");
    const bf16*sr=stg+(ln>>4)*128+(ln&15)*8; bf16*gw_=Ow+(long)(ln>>4)*OP+(ln&15)*8;
    #pragma unroll
    for(int i=0;i<8;++i){ const u32x4 v=*(const u32x4*)(sr+i*4*128); ATTN_STORE16(gw_+(long)i*4*OP,v);} }
  asm volatile("s_waitcnt lgkmcnt(0)\n\ts_barrier":::"memory");
  #undef DMA3_K
  #undef DMA3_V
}
template<class Sched,int THRL=8> __device__ __forceinline__ void attn_phase3(char*lds,const AttnTensors&T,const Sched&S){
  AttnUnit u;
  for(int i=0;S.next(i,u);++i){ const int b=u.bh>>4,hc=u.bh&15,h=hc>>1;
    attn_unit3<THRL>(b,u.qb,T.P+3072+hc*64,T.P+4096+hc*64,T.P+5120+h*128,T.O+hc*128,lds); }
}
#undef SBAR
#undef WAIT_BAR
}
namespace cg = cooperative_groups;
constexpr int NWAVES = 8;
constexpr int BATCH = 4, SEQ = 8192, DMODEL = 2048, FFN = 5632, INC = 6144;
constexpr int M = BATCH * SEQ;
constexpr float RMS_EPS = 1e-6f;
constexpr size_t MiB = 1u << 20;
constexpr size_t WS_WGU1 = 2 * MiB, WS_WD1 = 46 * MiB, WS_WIN = 68 * MiB, WS_WOUT = 92 * MiB, WS_WGU2 = 100 * MiB, WS_WD2 = 144 * MiB;
constexpr size_t WS_XN = 168 * MiB, WS_O = 296 * MiB, WS_H = 424 * MiB, WS_Y = 808 * MiB, WS_END = 936 * MiB;
constexpr int LDS_BYTES = 147456 + 1024;
constexpr int MISC_OFF = 147456;
constexpr size_t WS_CTL = 0, CTL_ZERO_BYTES = 640 * 1024;
constexpr size_t WS_CNT = 64 * 1024, WS_SSQ3 = 512 * 1024;
constexpr size_t WS_SSQ0 = 128 * 1024, WS_SSQ1 = 256 * 1024, WS_SSQ2 = 384 * 1024;
constexpr int CW_BAR = 1024;
#ifndef REP_ATTN
#define REP_ATTN 1
#endif
#ifndef REP_LIGHT
#define REP_LIGHT 1
#endif
#ifndef REP_P0
#define REP_P0 1
#endif

#define GAS __attribute__((address_space(1)))
#define LAS __attribute__((address_space(3)))
typedef unsigned short bf16;
typedef unsigned v4u __attribute__((ext_vector_type(4)));
typedef float f32x4 __attribute__((ext_vector_type(4)));
#define LDS_WAIT() asm volatile("s_waitcnt lgkmcnt(0)" ::: "memory")
__device__ __forceinline__ unsigned f2bf(float f) { unsigned u = __builtin_bit_cast(unsigned, f); return (u + 0x7fffu + ((u >> 16) & 1u)) >> 16; }
__device__ __forceinline__ unsigned pk2(float lo, float hi) { return f2bf(lo) | (f2bf(hi) << 16); }
__device__ __forceinline__ float bflo(unsigned w) { return __uint_as_float(w << 16); }
__device__ __forceinline__ float bfhi(unsigned w) { return __uint_as_float(w & 0xffff0000u); }
__device__ __forceinline__ float wave_sum(float v) {
#pragma unroll
    for (int o = 1; o < 64; o <<= 1) v += __shfl_xor(v, o);
    return v;
}
__device__ __forceinline__ void p0_transpose_item(const float* W, int K, int N, bf16* WT, int mode, LAS float* scr, int item, int lane, const float* g = nullptr) {
    const int nblk = N / 64, kb = item / nblk, nb = item % nblk, k0 = 64 * kb, n0 = 64 * nb;
    const int drow0 = (mode == 0) ? n0 : (256 * (n0 >> 7) + (n0 & 127) + (mode == 2 ? 128 : 0));
    const int lr = lane >> 4, lc = (lane & 15) * 4;
#pragma unroll 8
    for (int i = 0; i < 16; ++i) { const int kk = 4 * i + lr; const float gk = g ? g[k0 + kk] : 1.0f;
        const f32x4 w = *(const GAS f32x4*)(W + (size_t)(k0 + kk) * N + n0 + lc) * gk; LAS float* d = scr + kk * 65 + lc; d[0] = w.x; d[1] = w.y; d[2] = w.z; d[3] = w.w; }
    LDS_WAIT(); asm volatile("" ::: "memory");
    const int c = lane & 7;
#pragma unroll
    for (int j = 0; j < 8; ++j) { const int n = (lane >> 3) + 8 * j; const LAS float* s = scr + (8 * c) * 65 + n;
        v4u o; o.x = pk2(s[0 * 65], s[1 * 65]); o.y = pk2(s[2 * 65], s[3 * 65]); o.z = pk2(s[4 * 65], s[5 * 65]); o.w = pk2(s[6 * 65], s[7 * 65]);
        *(GAS v4u*)(WT + (size_t)(drow0 + n) * K + k0 + 8 * c) = o; }
    LDS_WAIT(); asm volatile("" ::: "memory");
}
__device__ __forceinline__ void rms_row_to_bf16(const float* xrow, const float* g, bf16* orow, float* ssq_row, int lane) {
    const GAS f32x4* xr = (const GAS f32x4*)xrow + lane; (void)g;
    f32x4 v[8]; float s = 0.f;
#pragma unroll
    for (int j = 0; j < 8; ++j) { v[j] = xr[64 * j]; s += (v[j].x * v[j].x + v[j].y * v[j].y) + (v[j].z * v[j].z + v[j].w * v[j].w); }
    s = wave_sum(s); if (lane == 0) *ssq_row = s;
    GAS unsigned long long* o8 = (GAS unsigned long long*)orow + lane;
#pragma unroll
    for (int j = 0; j < 8; ++j) { const f32x4 y = v[j];
        o8[64 * j] = (unsigned long long)pk2(y.x, y.y) | ((unsigned long long)pk2(y.z, y.w) << 32); }
}
__device__ __forceinline__ void rms_row_f32(const float* xrow, const float* g, float* orow, int lane) {
    const GAS f32x4* xr = (const GAS f32x4*)xrow + lane; const GAS f32x4* gr = (const GAS f32x4*)g + lane;
    f32x4 v[8]; float s = 0.f;
#pragma unroll
    for (int j = 0; j < 8; ++j) { v[j] = xr[64 * j]; s += (v[j].x * v[j].x + v[j].y * v[j].y) + (v[j].z * v[j].z + v[j].w * v[j].w); }
    const float rstd = 1.0f / sqrtf(wave_sum(s) * (1.f / DMODEL) + RMS_EPS);
    GAS f32x4* o = (GAS f32x4*)orow + lane;
#pragma unroll
    for (int j = 0; j < 8; ++j) { const f32x4 gv = gr[64 * j]; o[64 * j] = v[j] * rstd * gv; }
}
__device__ __forceinline__ void mix_row(const bf16* P, const bf16* O, bf16* Y, const float* convw, const float* subln, float lam, int m, int lane) {
    const int t = m & (SEQ - 1);
    const bf16* pr = P + (size_t)m * INC; bf16* yr = Y + (size_t)m * DMODEL;
#pragma unroll
    for (int i = 0; i < 2; ++i) {
        const int j = lane * 8 + 512 * i;
        const v4u bq = *(const GAS v4u*)(pr + j), c0 = *(const GAS v4u*)(pr + 1024 + j), x0 = *(const GAS v4u*)(pr + 2048 + j);
        v4u c1 = (v4u){0u, 0u, 0u, 0u}, x1 = c1, c2 = c1, x2 = c1;
        if (t >= 1) { c1 = *(const GAS v4u*)(pr - INC + 1024 + j); x1 = *(const GAS v4u*)(pr - INC + 2048 + j); }
        if (t >= 2) { c2 = *(const GAS v4u*)(pr - 2 * INC + 1024 + j); x2 = *(const GAS v4u*)(pr - 2 * INC + 2048 + j); }
        const f32x4 wa0 = *(const GAS f32x4*)(convw + j), wa1 = *(const GAS f32x4*)(convw + j + 4);
        const f32x4 wb0 = *(const GAS f32x4*)(convw + 1024 + j), wb1 = *(const GAS f32x4*)(convw + 1024 + j + 4);
        const f32x4 wc0 = *(const GAS f32x4*)(convw + 2048 + j), wc1 = *(const GAS f32x4*)(convw + 2048 + j + 4);
        v4u o;
#define MIXPAIR(q, WA, WB, WC, e0, e1) pk2( \
            bflo(bq[q]) * (WA[e0] * (bflo(c2[q]) * bflo(x2[q])) + WB[e0] * (bflo(c1[q]) * bflo(x1[q])) + WC[e0] * (bflo(c0[q]) * bflo(x0[q]))), \
            bfhi(bq[q]) * (WA[e1] * (bfhi(c2[q]) * bfhi(x2[q])) + WB[e1] * (bfhi(c1[q]) * bfhi(x1[q])) + WC[e1] * (bfhi(c0[q]) * bfhi(x0[q]))))
        o.x = MIXPAIR(0, wa0, wb0, wc0, 0, 1); o.y = MIXPAIR(1, wa0, wb0, wc0, 2, 3); o.z = MIXPAIR(2, wa1, wb1, wc1, 0, 1); o.w = MIXPAIR(3, wa1, wb1, wc1, 2, 3);
#undef MIXPAIR
        *(GAS v4u*)(yr + j) = o;
    }
    {
        const int h = lane >> 3, d0 = (lane & 7) * 16;
        const bf16* o1p = O + (size_t)m * DMODEL + h * 256 + d0; const bf16* o2p = o1p + 128;
        const v4u a0 = *(const GAS v4u*)o1p, a1 = *(const GAS v4u*)(o1p + 8), b0 = *(const GAS v4u*)o2p, b1 = *(const GAS v4u*)(o2p + 8);
        float o[16]; float ss = 0.f;
#pragma unroll
        for (int q = 0; q < 4; ++q) { o[2 * q] = bflo(a0[q]) - lam * bflo(b0[q]); o[2 * q + 1] = bfhi(a0[q]) - lam * bfhi(b0[q]);
            o[8 + 2 * q] = bflo(a1[q]) - lam * bflo(b1[q]); o[8 + 2 * q + 1] = bfhi(a1[q]) - lam * bfhi(b1[q]); }
#pragma unroll
        for (int e = 0; e < 16; ++e) ss += o[e] * o[e];
        ss += __shfl_xor(ss, 1); ss += __shfl_xor(ss, 2); ss += __shfl_xor(ss, 4);
        const float rs = 0.8f / sqrtf(ss * (1.f / 128.f) + RMS_EPS);
        const f32x4 g0 = *(const GAS f32x4*)(subln + d0), g1 = *(const GAS f32x4*)(subln + d0 + 4), g2 = *(const GAS f32x4*)(subln + d0 + 8), g3 = *(const GAS f32x4*)(subln + d0 + 12);
        v4u w0, w1;
        w0.x = pk2(o[0] * rs * g0[0], o[1] * rs * g0[1]); w0.y = pk2(o[2] * rs * g0[2], o[3] * rs * g0[3]); w0.z = pk2(o[4] * rs * g1[0], o[5] * rs * g1[1]); w0.w = pk2(o[6] * rs * g1[2], o[7] * rs * g1[3]);
        w1.x = pk2(o[8] * rs * g2[0], o[9] * rs * g2[1]); w1.y = pk2(o[10] * rs * g2[2], o[11] * rs * g2[3]); w1.z = pk2(o[12] * rs * g3[0], o[13] * rs * g3[1]); w1.w = pk2(o[14] * rs * g3[2], o[15] * rs * g3[3]);
        bf16* yo = yr + 1024 + h * 128 + d0;
        *(GAS v4u*)yo = w0; *(GAS v4u*)(yo + 8) = w1;
    }
}

#define XB_TMO      128
#define XB_XCNT(j)  (256  + 64 * (j))
#define XB_XSUB(j)  (1280 + 64 * (j))
#define XB_XGEN(j)  (2304 + 64 * (j))
#define XB_TOP      3328
#define XB_TOPGEN   3392
#define XCD_BAR_WORDS 3456
#define XB_SPIN_CAP (1u << 18)

__device__ __forceinline__ unsigned xb_ld(unsigned* p)              { return __hip_atomic_load(p, __ATOMIC_RELAXED, __HIP_MEMORY_SCOPE_AGENT); }
__device__ __forceinline__ unsigned xb_add(unsigned* p, unsigned v) { return __hip_atomic_fetch_add(p, v, __ATOMIC_RELAXED, __HIP_MEMORY_SCOPE_AGENT); }
__device__ __forceinline__ unsigned xb_xcc_id() { return (unsigned)__builtin_amdgcn_s_getreg((3 << 11) | 20) & 0xFu; }
#define XB_SPIN(cond, bar) do { unsigned _sp = 0; while (cond) { __builtin_amdgcn_s_sleep(1); \
    if ((++_sp & 255u) == 0u) { if (xb_ld(&(bar)[XB_TMO])) break; if (_sp > XB_SPIN_CAP) { atomicAdd(&(bar)[XB_TMO], 1u); break; } } } } while (0)

struct XcdBarrier {
    unsigned* bar; unsigned x;
    volatile LAS unsigned* st;
};

__device__ __forceinline__ XcdBarrier xcd_barrier_post(unsigned* bar, volatile LAS unsigned* st) {
    XcdBarrier b; b.bar = bar; b.x = xb_xcc_id(); b.st = st;
    if (threadIdx.x == 0) (void)xb_add(&bar[XB_XCNT(b.x)], 1u);
    return b;
}
__device__ __forceinline__ void xcd_barrier_complete(unsigned* bar, unsigned x, unsigned& nloc, unsigned& nx) {
    const unsigned G = gridDim.x * gridDim.y * gridDim.z;
    unsigned sum, cnt, mine, sp = 0u;
    for (;;) {
        sum = 0u; cnt = 0u; mine = 0u;
#pragma unroll
        for (unsigned j = 0; j < 16; ++j) { const unsigned c = xb_ld(&bar[XB_XCNT(j)]); sum += c; cnt += (c > 0u) ? 1u : 0u; mine = (j == x) ? c : mine; }
        if (sum == G) break;
        __builtin_amdgcn_s_sleep(1);
        if ((++sp & 255u) == 0u) { if (xb_ld(&bar[XB_TMO])) break; if (sp > XB_SPIN_CAP) { atomicAdd(&bar[XB_TMO], 1u); break; } }
    }
    nloc = mine > 0u ? mine : 1u; nx = cnt > 0u ? cnt : 1u;
}

__device__ __forceinline__ void xcd_barrier(const XcdBarrier& b) {
    asm volatile("s_waitcnt vmcnt(0)" ::: "memory");
    __syncthreads();
    if (threadIdx.x == 0) {
        unsigned* bar = b.bar;
        __builtin_amdgcn_s_waitcnt(0);
        unsigned nloc = b.st[0], nx = b.st[1];
        if (nloc == 0u) { xcd_barrier_complete(bar, b.x, nloc, nx); b.st[0] = nloc; b.st[1] = nx; }
        const unsigned old = xb_add(&bar[XB_XSUB(b.x)], 1u);
        const unsigned gen = old / nloc;
        if (old + 1u == (gen + 1u) * nloc) {
            __builtin_amdgcn_fence(__ATOMIC_RELEASE, "agent");
            asm volatile("s_waitcnt vmcnt(0)" ::: "memory");
            const unsigned og = xb_add(&bar[XB_TOP], 1u);
            const unsigned tg = og / nx;
            if (og + 1u == (tg + 1u) * nx) xb_add(&bar[XB_TOPGEN], 1u);
            else XB_SPIN(xb_ld(&bar[XB_TOPGEN]) == tg, bar);
            __builtin_amdgcn_fence(__ATOMIC_ACQUIRE, "agent");
            xb_add(&bar[XB_XGEN(b.x)], 1u);
            asm volatile("s_waitcnt vmcnt(0)" ::: "memory");
        } else {
            XB_SPIN(xb_ld(&bar[XB_XGEN(b.x)]) == gen, bar);
            __builtin_amdgcn_fence(__ATOMIC_ACQUIRE, "agent");
            asm volatile("s_waitcnt vmcnt(0)" ::: "memory");
        }
    }
    __syncthreads();
}

struct Args { const float* in[19]; float* out; unsigned char* ws; };
__global__ void __launch_bounds__(NWAVES * 64, 2) mega_fwd(Args args) {
    extern __shared__ __attribute__((aligned(16))) unsigned char lds[];
    cg::grid_group grid = cg::this_grid();
    LAS unsigned char* ldsp = (LAS unsigned char*)lds;
    const int tid = threadIdx.x, wave = __builtin_amdgcn_readfirstlane(tid >> 6);
    const int G = gridDim.x, bx = blockIdx.x;
    const int vcu = (G % 8 == 0) ? (bx % 8) * (G / 8) + bx / 8 : bx;
    const int gw = vcu * NWAVES + wave, NGW = G * NWAVES;
    for (int u = tid; u < (LDS_BYTES - MISC_OFF) / 4; u += NWAVES * 64) ((LAS unsigned*)(ldsp + MISC_OFF))[u] = 0u;
    __syncthreads();
    const XcdBarrier bar = xcd_barrier_post((unsigned*)(args.ws + WS_CTL) + CW_BAR, (volatile LAS unsigned*)(ldsp + MISC_OFF) + 8);
    typedef const Args __attribute__((address_space(4)))* kargp_t;
#define KARG(field) ({ kargp_t _ka = (kargp_t)__builtin_amdgcn_kernarg_segment_ptr(); asm volatile("" : "+s"(_ka)); _ka->field; })
#define IN(i) KARG(in[i])
#define WSP(off) (KARG(ws) + (off))
#define WGU1 ((bf16*)WSP(WS_WGU1))
#define WD1 ((bf16*)WSP(WS_WD1))
#define WIN ((bf16*)WSP(WS_WIN))
#define WOUT ((bf16*)WSP(WS_WOUT))
#define WGU2 ((bf16*)WSP(WS_WGU2))
#define WD2 ((bf16*)WSP(WS_WD2))
#define XN ((bf16*)WSP(WS_XN))
#define OB ((bf16*)WSP(WS_O))
#define HB ((bf16*)WSP(WS_H))
#define PROJ HB
#define YB ((bf16*)WSP(WS_Y))

#define FRESH_LANE() ({ int _l = threadIdx.x & 63; asm volatile("" : "+v"(_l)); _l; })
    for (int rep = 0; rep < REP_P0; ++rep) {
        const int lane = FRESH_LANE();
        LAS float* scr = (LAS float*)(ldsp + wave * 16640);
        constexpr int I_G = (DMODEL / 64) * (FFN / 64), I_D = (FFN / 64) * (DMODEL / 64), I_IN = (DMODEL / 64) * (INC / 64), I_O = (DMODEL / 64) * (DMODEL / 64);
        constexpr int NITEMS = 4 * I_G + 2 * I_D + I_IN + I_O;
        for (int it = gw; it < NITEMS; it += NGW) {
            int r = it;
            if (r < I_G) { p0_transpose_item(IN(2), DMODEL, FFN, WGU1, 1, scr, r, lane, IN(1)); continue; } r -= I_G;
            if (r < I_G) { p0_transpose_item(IN(3), DMODEL, FFN, WGU1, 2, scr, r, lane, IN(1)); continue; } r -= I_G;
            if (r < I_D) { p0_transpose_item(IN(4), FFN, DMODEL, WD1, 0, scr, r, lane); continue; } r -= I_D;
            if (r < I_IN) { p0_transpose_item(IN(6), DMODEL, INC, WIN, 0, scr, r, lane, IN(5)); continue; } r -= I_IN;
            if (r < I_O) { p0_transpose_item(IN(13), DMODEL, DMODEL, WOUT, 0, scr, r, lane); continue; } r -= I_O;
            if (r < I_G) { p0_transpose_item(IN(15), DMODEL, FFN, WGU2, 1, scr, r, lane, IN(14)); continue; } r -= I_G;
            if (r < I_G) { p0_transpose_item(IN(16), DMODEL, FFN, WGU2, 2, scr, r, lane, IN(14)); continue; } r -= I_G;
            p0_transpose_item(IN(17), FFN, DMODEL, WD2, 0, scr, r, lane);
        }
        { const float* xi = IN(0); const float* gn = IN(1); bf16* xn = XN; float* sq = (float*)WSP(WS_SSQ0); for (int m = gw; m < M; m += NGW) rms_row_to_bf16(xi + (size_t)m * DMODEL, gn, xn + (size_t)m * DMODEL, sq + m, lane); }
    }
    grid.sync();
    {
        pg8::Gemm g{XN, WGU1, M, 2 * FFN, DMODEL}; pg8::StaticOrder S; S.init(M, 2 * FFN, G, bx);
        pg8::EpiSwiGLU E{HB, FFN, (const float*)WSP(WS_SSQ0)};
        pg8::gemm_phase<pg8::EpiSwiGLU, pg8::StaticOrder, PG8_ALIGN, PG8_SP2>(ldsp, g, S, E);
    }
    xcd_barrier(bar);
    {
        pg8::Gemm g{HB, WD1, M, DMODEL, FFN}; pg8::StaticOrderW<4> S; S.init(M, DMODEL, G, bx);
        pg8::EpiRes<1> E{XN, XN, DMODEL, 0.5f, (float*)WSP(WS_SSQ1)};
        pg8::gemm_phase<pg8::EpiRes<1>, pg8::StaticOrderW<4>, PG8_ALIGN, PG8_SP2>(ldsp, g, S, E);
    }
    xcd_barrier(bar);
    {
        pg8::Gemm g{XN, WIN, M, INC, DMODEL}; pg8::StaticOrder S; S.init(M, INC, G, bx);
        pg8::EpiProj E{PROJ, INC, 3072, 4096, attn_body::C2, (const float*)WSP(WS_SSQ1)};
        pg8::gemm_phase<pg8::EpiProj, pg8::StaticOrder, PG8_ALIGN, PG8_SP2>(ldsp, g, S, E);
    }
    xcd_barrier(bar);
    {
        const attn_body::AttnTensors AT{(const attn_body::bf16*)PROJ, (attn_body::bf16*)OB};
        static_assert(attn_body::LDS3_BYTES <= MISC_OFF, "attention LDS");
        const attn_body::StaticOrder2 S(G, bx);
        attn_body::attn_phase3<attn_body::StaticOrder2>((char*)lds, AT, S);
    }
    xcd_barrier(bar);
    for (int rep = 0; rep < REP_LIGHT; ++rep) {
        const int lane = FRESH_LANE();
        const float s1 = wave_sum(IN(8)[lane] * IN(9)[lane]), s2 = wave_sum(IN(10)[lane] * IN(11)[lane]);
        const float lam = expf(s1) - expf(s2) + 0.2f;
        const bf16* pj = PROJ; const bf16* ob = OB; bf16* yb = YB; const float* cw = IN(7); const float* sl = IN(12);
        for (int m = gw; m < M; m += NGW) mix_row(pj, ob, yb, cw, sl, lam, m, lane);
    }
    xcd_barrier(bar);
    {
        pg8::Gemm g{YB, WOUT, M, DMODEL, DMODEL}; pg8::StaticOrderW<4> S; S.init(M, DMODEL, G, bx);
        pg8::EpiRes<1> E{XN, OB, DMODEL, 1.0f, (float*)WSP(WS_SSQ2)};
        pg8::gemm_phase<pg8::EpiRes<1>, pg8::StaticOrderW<4>, PG8_ALIGN, PG8_SP2>(ldsp, g, S, E);
    }
    xcd_barrier(bar);
    {
        pg8::Gemm g{OB, WGU2, M, 2 * FFN, DMODEL}; pg8::StaticOrder S; S.init(M, 2 * FFN, G, bx);
        pg8::EpiSwiGLU E{HB, FFN, (const float*)WSP(WS_SSQ2)};
        pg8::gemm_phase<pg8::EpiSwiGLU, pg8::StaticOrder, PG8_ALIGN, PG8_SP2>(ldsp, g, S, E);
    }
    xcd_barrier(bar);
    {
        pg8::Gemm g{HB, WD2, M, DMODEL, FFN}; pg8::StaticOrderW<4> S; S.init(M, DMODEL, G, bx);
        float* outp = KARG(out); pg8::EpiRes<3> E{OB, outp, DMODEL, 0.5f, (float*)WSP(WS_SSQ3), (unsigned*)WSP(WS_CNT), IN(18)};
        pg8::gemm_phase<pg8::EpiRes<3>, pg8::StaticOrderW<4>, PG8_ALIGN, PG8_SP2>(ldsp, g, S, E);
    }
}

#undef KARG
#undef FRESH_LANE
#undef IN
#undef WSP
#undef WGU1
#undef WD1
#undef WIN
#undef WOUT
#undef WGU2
#undef WD2
#undef XN
#undef OB
#undef HB
#undef PROJ
#undef YB
extern "C" void kernel_launch(void* const* d_in, const int* in_sizes, int n_in, void* d_out, int out_size, void* d_ws, size_t ws_size, hipStream_t stream) {
    static int grid = 0;
    if (grid == 0) {
        if (n_in != 19 || in_sizes[0] != M * DMODEL || out_size != M * DMODEL || ws_size < WS_END) { fprintf(stderr, "kernel_launch: unexpected shapes (n_in %d, in0 %d, out %d, ws %zu); nothing launched\n", n_in, n_in > 0 ? in_sizes[0] : -1, out_size, ws_size); grid = -1; return; }
        int dev = 0, cus = 0, per_cu = 0;
        if (hipGetDevice(&dev) != hipSuccess || hipDeviceGetAttribute(&cus, hipDeviceAttributeMultiprocessorCount, dev) != hipSuccess) { grid = -1; return; }
        if (hipFuncSetAttribute((const void*)mega_fwd, hipFuncAttributeMaxDynamicSharedMemorySize, LDS_BYTES) != hipSuccess) { fprintf(stderr, "kernel_launch: hipFuncSetAttribute failed\n"); grid = -1; return; }
        if (hipOccupancyMaxActiveBlocksPerMultiprocessor(&per_cu, (const void*)mega_fwd, NWAVES * 64, LDS_BYTES) != hipSuccess) per_cu = 0;
        (void)hipGetLastError();
        if (cus * per_cu < 256) { fprintf(stderr, "kernel_launch: resident capacity %d x %d < 256 workgroups; nothing launched\n", cus, per_cu); grid = -1; return; }
        grid = 256;
    }
    if (grid < 0) return;
    if (hipMemsetAsync((char*)d_ws + WS_CTL, 0, CTL_ZERO_BYTES, stream) != hipSuccess) { fprintf(stderr, "kernel_launch: hipMemsetAsync failed\n"); return; }
    Args a{};
    for (int i = 0; i < 19; ++i) a.in[i] = (const float*)d_in[i];
    a.out = (float*)d_out; a.ws = (unsigned char*)d_ws;
    void* kargs[] = {&a};
    const hipError_t le = hipLaunchCooperativeKernel((const void*)mega_fwd, dim3(grid), dim3(NWAVES * 64), kargs, LDS_BYTES, stream);
    if (le != hipSuccess) fprintf(stderr, "kernel_launch: cooperative launch failed: %s\n", hipGetErrorName(le));
}
```

```cpp
#include <hip/hip_runtime.h>
#include <hip/hip_cooperative_groups.h>
#include <cstdio>
#include <cstdint>

namespace pg8 {
#define PG8_LAS __attribute__((address_space(3)))
typedef unsigned short bf16_t;
typedef short bf16x8 __attribute__((ext_vector_type(8)));
typedef float f32x4 __attribute__((ext_vector_type(4)));
typedef unsigned u32x4 __attribute__((ext_vector_type(4)));
constexpr int BM = 256, BK = 64, HALF = 128, HTB = HALF * BK * 2  , STAGE_BYTES = 8 * HTB, NXCD = 8, WGM = 8;

__host__ __device__ __forceinline__ int lds_byte(int r, int c) { const int st = (r >> 4) * 2 + (c >> 5), rr = r & 15, cc = c & 31, ob = rr * 64 + cc * 2; return st * 1024 + (ob ^ (((ob >> 9) & 1) << 5)); }
__host__ __device__ __forceinline__ void stage_rc(int b, int& R, int& C) { const int st = b / 1024, sb = b % 1024, swz = sb ^ (((sb >> 9) & 1) << 5); R = (st >> 1) * 16 + swz / 64; C = (st & 1) * 32 + (swz % 64) / 2; }
__host__ __device__ __forceinline__ int perm32(int rho) { const int n = rho >> 4, i = rho & 15; return 8 * (i >> 2) + 4 * n + (i & 3); }

struct Unit { int pm, pn, par; };
struct Gemm { const bf16_t* A; const bf16_t* Bt; int M, N, K; };

struct StaticOrder {
    int nM, nN, nwg, G, c;
    __host__ __device__ void init(int M, int N, int G_, int c_) { nM = M / BM; nN = N / BM; nwg = nM * nN; G = G_; c = c_; }
    __host__ __device__ bool next(int i, Unit& u) const {
        const long L = (long)i * G + c; if (L >= nwg) return false;
        int wgid = (int)L; { const int q = nwg / NXCD, r = nwg % NXCD, xcd = wgid % NXCD, off = wgid / NXCD; wgid = (xcd < r ? xcd * (q + 1) : r * (q + 1) + (xcd - r) * q) + off; }
        const int nig = WGM * nN, gid = wgid / nig, fm = gid * WGM, gsz = (nM - fm) < WGM ? (nM - fm) : WGM;
        u.pm = fm + ((wgid % nig) % gsz); u.pn = (wgid % nig) / gsz; return true;
    }
    __device__ __forceinline__ void a_ready(const Unit&) const {}
    __device__ __forceinline__ void done(const Unit&) const {}
};

__device__ __forceinline__ unsigned cvt_pk_bf16(float lo, float hi) { unsigned r; asm volatile("v_cvt_pk_bf16_f32 %0, %1, %2" : "=v"(r) : "v"(lo), "v"(hi)); return r; }
typedef float f32x2 __attribute__((ext_vector_type(2)));
__device__ __forceinline__ f32x2 gelu_pk(f32x2 v) {
    const f32x2 av = __builtin_elementwise_abs(v), d = av * 0.2316418882f + 1.0f;
    f32x2 t; t.x = __builtin_amdgcn_rcpf(d.x); t.y = __builtin_amdgcn_rcpf(d.y);
    f32x2 q = t * 0.5307027145f + (-0.7265760135f); q = q * t + 0.7107068705f; q = q * t + (-0.142248368f); q = q * t + 0.127414796f; q = q * t;
    const f32x2 s = (v * v) * (-0.72134752044f);
    f32x2 e; e.x = __builtin_amdgcn_exp2f(s.x); e.y = __builtin_amdgcn_exp2f(s.y);
    const f32x2 m = v * (q * e), r = v - m;
    f32x2 o; o.x = v.x < 0.f ? m.x : r.x; o.y = v.y < 0.f ? m.y : r.y; return o;
}

template <int ACT  > struct EpiBf16 {
    static constexpr bool PERM = true, AFTER_DRAIN = false; static_assert(ACT == 0 || ACT == 1, "EpiBf16: ACT is 0 (none) or 1 (gelu_pk)");
    bf16_t* O; int ldc; const float* bias; int split_cols; size_t split_stride; float scale0;
    __device__ __forceinline__ void operator()(const f32x4 (&acc)[2][2][4][2], const Unit& u, int wr, int wc, int fr, int fq) const {
        const int row0 = u.pm * BM + wr * 64 + fr; int colt = u.pn * BM; bf16_t* base = O;
        float sc = 1.f; if (split_cols) { const int t = colt / split_cols; base += (size_t)t * split_stride; colt -= t * split_cols; if (t == 0) sc = scale0; }
        const int col0 = colt + wc * 32 + 8 * fq, bcol0 = u.pn * BM + wc * 32 + 8 * fq;
        f32x4 bv[2][2];
#pragma unroll
        for (int bj = 0; bj < 2; ++bj)
#pragma unroll
            for (int n = 0; n < 2; ++n) bv[bj][n] = bias ? *(const f32x4*)(bias + bcol0 + bj * HALF + 4 * n) : (f32x4){0.f, 0.f, 0.f, 0.f};
#pragma unroll
        for (int ai = 0; ai < 2; ++ai)
#pragma unroll
            for (int m = 0; m < 4; ++m) { bf16_t* rowp = base + (size_t)(row0 + ai * HALF + m * 16) * ldc + col0;
#pragma unroll
                for (int bj = 0; bj < 2; ++bj) { f32x4 v0 = acc[ai][bj][m][0] + bv[bj][0], v1 = acc[ai][bj][m][1] + bv[bj][1];
                    if (ACT == 1) { f32x2 a = gelu_pk((f32x2){v0[0], v0[1]}), b = gelu_pk((f32x2){v0[2], v0[3]}), c = gelu_pk((f32x2){v1[0], v1[1]}), d = gelu_pk((f32x2){v1[2], v1[3]});
                        v0 = (f32x4){a.x, a.y, b.x, b.y}; v1 = (f32x4){c.x, c.y, d.x, d.y}; }
                    v0 = v0 * sc; v1 = v1 * sc; u32x4 w; w.x = cvt_pk_bf16(v0[0], v0[1]); w.y = cvt_pk_bf16(v0[2], v0[3]); w.z = cvt_pk_bf16(v1[0], v1[1]); w.w = cvt_pk_bf16(v1[2], v1[3]);
                    *(u32x4*)(rowp + bj * HALF) = w; } }
    }
};
template <int W> struct StaticOrderW : StaticOrder {
    __host__ __device__ bool next(int i, Unit& u) const {
        const long L = (long)i * G + c; if (L >= nwg) return false;
        int wgid = (int)L; { const int q = nwg / NXCD, r = nwg % NXCD, xcd = wgid % NXCD, off = wgid / NXCD; wgid = (xcd < r ? xcd * (q + 1) : r * (q + 1) + (xcd - r) * q) + off; }
        const int nig = W * nN, gid = wgid / nig, fm = gid * W, gsz = (nM - fm) < W ? (nM - fm) : W;
        u.pm = fm + ((wgid % nig) % gsz); u.pn = (wgid % nig) / gsz; return true;
    }
};
struct EpiSwiGLU {
    static constexpr bool PERM = true, AFTER_DRAIN = false;
    bf16_t* O; int ldc; const float* ssq;
    typedef float f32x2 __attribute__((ext_vector_type(2)));
    __device__ __forceinline__ static unsigned sg2(f32x2 g, f32x2 up, float c, float rs2) {
        const f32x2 m = g * c; f32x2 e; e.x = __builtin_amdgcn_exp2f(m.x); e.y = __builtin_amdgcn_exp2f(m.y);
        const f32x2 d = e + 1.0f; f32x2 r; r.x = __builtin_amdgcn_rcpf(d.x); r.y = __builtin_amdgcn_rcpf(d.y);
        const f32x2 h = (g * up) * rs2 * r; return cvt_pk_bf16(h.x, h.y); }
    __device__ __forceinline__ void operator()(const f32x4 (&acc)[2][2][4][2], const Unit& u, int wr, int wc, int fr, int fq) const {
        const int row0 = u.pm * BM + wr * 64 + fr, col0 = u.pn * HALF + wc * 32 + 8 * fq;
        float rsv[2][4];
#pragma unroll
        for (int ai = 0; ai < 2; ++ai)
#pragma unroll
            for (int m = 0; m < 4; ++m) rsv[ai][m] = ssq[row0 + ai * HALF + m * 16];
        asm volatile("" ::: "memory");
#pragma unroll
        for (int ai = 0; ai < 2; ++ai)
#pragma unroll
            for (int m = 0; m < 4; ++m) {
                bf16_t* rowp = O + (size_t)(row0 + ai * HALF + m * 16) * ldc + col0;
                const float rs = __builtin_amdgcn_rsqf(rsv[ai][m] * (1.0f / 2048.0f) + 1e-6f), c = -1.4426950408889634f * rs, rs2 = rs * rs;
                const f32x4 g0 = acc[ai][0][m][0], g1 = acc[ai][0][m][1], u0 = acc[ai][1][m][0], u1 = acc[ai][1][m][1];
                u32x4 w; w.x = sg2((f32x2){g0[0], g0[1]}, (f32x2){u0[0], u0[1]}, c, rs2); w.y = sg2((f32x2){g0[2], g0[3]}, (f32x2){u0[2], u0[3]}, c, rs2);
                w.z = sg2((f32x2){g1[0], g1[1]}, (f32x2){u1[0], u1[1]}, c, rs2); w.w = sg2((f32x2){g1[2], g1[3]}, (f32x2){u1[2], u1[3]}, c, rs2);
                *(u32x4*)rowp = w; }
    }
};
template <int MODE> struct EpiRes {
    static constexpr bool PERM = true, AFTER_DRAIN = false;
    const void* base; void* out; int ldc; float s; float* ssq; unsigned* cnt; const float* gain;
    __device__ __forceinline__ static f32x4 lo4(unsigned a, unsigned b) { return (f32x4){__uint_as_float(a << 16), __uint_as_float(a & 0xffff0000u), __uint_as_float(b << 16), __uint_as_float(b & 0xffff0000u)}; }
    __device__ __forceinline__ void operator()(const f32x4 (&acc)[2][2][4][2], const Unit& u, int wr, int wc, int fr, int fq) const {
        const int col0 = u.pn * BM + wc * 32 + 8 * fq;
        if constexpr (MODE == 0) {
            const float* bs = (const float*)base; bf16_t* o = (bf16_t*)out;
#pragma unroll
            for (int ai = 0; ai < 2; ++ai) {
                f32x4 pre[4][2][2];
#pragma unroll
                for (int m = 0; m < 4; ++m) { const size_t off = (size_t)(u.pm * BM + ai * HALF + wr * 64 + m * 16 + fr) * ldc + col0;
#pragma unroll
                    for (int bj = 0; bj < 2; ++bj) { pre[m][bj][0] = *(const f32x4*)(bs + off + bj * HALF); pre[m][bj][1] = *(const f32x4*)(bs + off + bj * HALF + 4); } }
                asm volatile("" ::: "memory");
#pragma unroll
                for (int m = 0; m < 4; ++m) { const int row = u.pm * BM + ai * HALF + wr * 64 + m * 16 + fr; const size_t off = (size_t)row * ldc + col0; float ss = 0.f;
#pragma unroll
                    for (int bj = 0; bj < 2; ++bj) { const f32x4 v0 = pre[m][bj][0] + acc[ai][bj][m][0] * s, v1 = pre[m][bj][1] + acc[ai][bj][m][1] * s;
                        ss += (v0[0] * v0[0] + v0[1] * v0[1]) + (v0[2] * v0[2] + v0[3] * v0[3]) + (v1[0] * v1[0] + v1[1] * v1[1]) + (v1[2] * v1[2] + v1[3] * v1[3]);
                        u32x4 w; w.x = cvt_pk_bf16(v0[0], v0[1]); w.y = cvt_pk_bf16(v0[2], v0[3]); w.z = cvt_pk_bf16(v1[0], v1[1]); w.w = cvt_pk_bf16(v1[2], v1[3]);
                        *(u32x4*)(o + off + bj * HALF) = w; }
                    ss += __shfl_xor(ss, 16); ss += __shfl_xor(ss, 32); if (fq == 0) atomicAdd(ssq + row, ss); }
            }
        } else if constexpr (MODE == 3) {
            auto& A = const_cast<f32x4 (&)[2][2][4][2]>(acc);
            const bf16_t* bs = (const bf16_t*)base;
            { u32x4 pre[2][4][2];
#pragma unroll
              for (int ai = 0; ai < 2; ++ai)
#pragma unroll
                for (int m = 0; m < 4; ++m) { const size_t off = (size_t)(u.pm * BM + ai * HALF + wr * 64 + m * 16 + fr) * ldc + col0;
#pragma unroll
                    for (int bj = 0; bj < 2; ++bj) pre[ai][m][bj] = *(const u32x4*)(bs + off + bj * HALF); }
              asm volatile("" ::: "memory");
#pragma unroll
              for (int ai = 0; ai < 2; ++ai)
#pragma unroll
                for (int m = 0; m < 4; ++m) { const int row = u.pm * BM + ai * HALF + wr * 64 + m * 16 + fr; float ss = 0.f;
#pragma unroll
                    for (int bj = 0; bj < 2; ++bj) { const u32x4 pb = pre[ai][m][bj];
                        const f32x4 v0 = lo4(pb.x, pb.y) + acc[ai][bj][m][0] * s, v1 = lo4(pb.z, pb.w) + acc[ai][bj][m][1] * s;
                        ss += (v0[0] * v0[0] + v0[1] * v0[1]) + (v0[2] * v0[2] + v0[3] * v0[3]) + (v1[0] * v1[0] + v1[1] * v1[1]) + (v1[2] * v1[2] + v1[3] * v1[3]);
                        A[ai][bj][m][0] = v0; A[ai][bj][m][1] = v1; }
                    ss += __shfl_xor(ss, 16); ss += __shfl_xor(ss, 32); if (fq == 0) atomicAdd(ssq + row, ss); } }
            asm volatile("s_waitcnt vmcnt(0)" ::: "memory");
            unsigned* c = cnt + 64 * u.pm;
            if ((threadIdx.x & 63) == 0) __hip_atomic_fetch_add(c, 1u, __ATOMIC_RELAXED, __HIP_MEMORY_SCOPE_AGENT);
            { unsigned spins = 0;
              while ((unsigned)__builtin_amdgcn_readfirstlane(__hip_atomic_load(c, __ATOMIC_RELAXED, __HIP_MEMORY_SCOPE_AGENT)) < 64u) { __builtin_amdgcn_s_sleep(4); if (++spins > (1u << 22)) break; } }
            float rsv[2][4];
#pragma unroll
            for (int ai = 0; ai < 2; ++ai)
#pragma unroll
                for (int m = 0; m < 4; ++m) rsv[ai][m] = __hip_atomic_load(ssq + u.pm * BM + ai * HALF + wr * 64 + m * 16 + fr, __ATOMIC_RELAXED, __HIP_MEMORY_SCOPE_AGENT);
            f32x4 gv[2][2];
#pragma unroll
            for (int bj = 0; bj < 2; ++bj)
#pragma unroll
                for (int n = 0; n < 2; ++n) gv[bj][n] = *(const f32x4*)(gain + col0 + bj * HALF + 4 * n);
#pragma unroll
            for (int ai = 0; ai < 2; ++ai)
#pragma unroll
                for (int m = 0; m < 4; ++m) { const size_t off = (size_t)(u.pm * BM + ai * HALF + wr * 64 + m * 16 + fr) * ldc + col0;
                    const float rs = __builtin_amdgcn_rsqf(rsv[ai][m] * (1.0f / 2048.0f) + 1e-6f);
#pragma unroll
                    for (int bj = 0; bj < 2; ++bj) { *(f32x4*)((float*)out + off + bj * HALF) = acc[ai][bj][m][0] * rs * gv[bj][0]; *(f32x4*)((float*)out + off + bj * HALF + 4) = acc[ai][bj][m][1] * rs * gv[bj][1]; } }
        } else {
            const bf16_t* bs = (const bf16_t*)base;
            u32x4 pre[2][4][2];
#pragma unroll
            for (int ai = 0; ai < 2; ++ai)
#pragma unroll
                for (int m = 0; m < 4; ++m) { const size_t off = (size_t)(u.pm * BM + ai * HALF + wr * 64 + m * 16 + fr) * ldc + col0;
#pragma unroll
                    for (int bj = 0; bj < 2; ++bj) pre[ai][m][bj] = *(const u32x4*)(bs + off + bj * HALF); }
            asm volatile("" ::: "memory");
#pragma unroll
            for (int ai = 0; ai < 2; ++ai)
#pragma unroll
                for (int m = 0; m < 4; ++m) { const int row = u.pm * BM + ai * HALF + wr * 64 + m * 16 + fr; const size_t off = (size_t)row * ldc + col0; float ss = 0.f;
#pragma unroll
                    for (int bj = 0; bj < 2; ++bj) { const u32x4 pb = pre[ai][m][bj];
                        const f32x4 v0 = lo4(pb.x, pb.y) + acc[ai][bj][m][0] * s, v1 = lo4(pb.z, pb.w) + acc[ai][bj][m][1] * s;
                        if constexpr (MODE == 1) {
                            ss += (v0[0] * v0[0] + v0[1] * v0[1]) + (v0[2] * v0[2] + v0[3] * v0[3]) + (v1[0] * v1[0] + v1[1] * v1[1]) + (v1[2] * v1[2] + v1[3] * v1[3]);
                            u32x4 w; w.x = cvt_pk_bf16(v0[0], v0[1]); w.y = cvt_pk_bf16(v0[2], v0[3]); w.z = cvt_pk_bf16(v1[0], v1[1]); w.w = cvt_pk_bf16(v1[2], v1[3]);
                            *(u32x4*)((bf16_t*)out + off + bj * HALF) = w;
                        } else { *(f32x4*)((float*)out + off + bj * HALF) = v0; *(f32x4*)((float*)out + off + bj * HALF + 4) = v1; } }
                    if constexpr (MODE == 1) { ss += __shfl_xor(ss, 16); ss += __shfl_xor(ss, 32); if (fq == 0) atomicAdd(ssq + row, ss); } }
        }
    }
};
struct EpiProj {
    static constexpr bool PERM = true, AFTER_DRAIN = false;
    bf16_t* O; int ldc; int q_lo, q_hi; float qscale; const float* ssq;
    __device__ __forceinline__ void operator()(const f32x4 (&acc)[2][2][4][2], const Unit& u, int wr, int wc, int fr, int fq) const {
        const int row0 = u.pm * BM + wr * 64 + fr, colt = u.pn * BM, col0 = colt + wc * 32 + 8 * fq;
        const float sc = (colt >= q_lo && colt < q_hi) ? qscale : 1.0f;
        float rsv[2][4];
#pragma unroll
        for (int ai = 0; ai < 2; ++ai)
#pragma unroll
            for (int m = 0; m < 4; ++m) rsv[ai][m] = ssq[row0 + ai * HALF + m * 16];
        asm volatile("" ::: "memory");
#pragma unroll
        for (int ai = 0; ai < 2; ++ai)
#pragma unroll
            for (int m = 0; m < 4; ++m) { bf16_t* rowp = O + (size_t)(row0 + ai * HALF + m * 16) * ldc + col0;
                const float rs = sc * __builtin_amdgcn_rsqf(rsv[ai][m] * (1.0f / 2048.0f) + 1e-6f);
#pragma unroll
                for (int bj = 0; bj < 2; ++bj) { const f32x4 v0 = acc[ai][bj][m][0] * rs, v1 = acc[ai][bj][m][1] * rs;
                    u32x4 w; w.x = cvt_pk_bf16(v0[0], v0[1]); w.y = cvt_pk_bf16(v0[2], v0[3]); w.z = cvt_pk_bf16(v1[0], v1[1]); w.w = cvt_pk_bf16(v1[2], v1[3]);
                    *(u32x4*)(rowp + bj * HALF) = w; } }
    }
};

template <class Epi, class Sched, bool ALIGN_EPI = false, bool SP2 = false>
__device__ __forceinline__ void gemm_phase(PG8_LAS unsigned char* lds, const Gemm g, const Sched& S, const Epi& E) {
    int tid_ = threadIdx.x; asm volatile("" : "+v"(tid_)); const int tid = tid_, wid = __builtin_amdgcn_readfirstlane(tid >> 6), lane = tid & 63, wr = wid >> 2, wc = wid & 3, fr = lane & 15, fq = lane >> 4;
    const int K = g.K, nt = K / BK;
    unsigned voffA[2], voffB[2];
#pragma unroll
    for (int i = 0; i < 2; ++i) { int R, C; stage_rc(tid * 16 + i * 8192, R, C); const int Rb = Epi::PERM ? ((R & ~31) + perm32(R & 31)) : R;
        voffA[i] = (unsigned)(R * K + C) * 2u; voffB[i] = (unsigned)(Rb * K + C) * 2u; }
    const size_t kstep = (size_t)(BK * 2);
    const size_t hstep = (size_t)HALF * K * 2;
    const size_t tstep = 2 * hstep;
    const unsigned ldsw = (unsigned)wid * 1024u;
    const int aoff = lds_byte(wr * 64 + fr, fq * 8), boff = lds_byte(wc * 32 + fr, fq * 8);
#define PG8_SA(b, h) (((b) * 2 + (h)) * HTB)
#define PG8_SB(b, h) ((4 + (b) * 2 + (h)) * HTB)
#define PG8_STAGE(bufoff, gbase, voff) do { _Pragma("unroll") for (int _i = 0; _i < 2; ++_i) \
        __builtin_amdgcn_global_load_lds((const unsigned*)((const char*)(gbase) + (voff)[_i]), (PG8_LAS unsigned*)(lds + (bufoff) + ldsw + _i * 8192), 16, 0, 0); } while (0)
#define PG8_LDA(dst, b, h) do { _Pragma("unroll") for (int m = 0; m < 4; ++m) _Pragma("unroll") for (int k = 0; k < 2; ++k) dst[m][k] = *(const PG8_LAS bf16x8*)(lds + PG8_SA(b, h) + aoff + m * 2048 + k * 1024); } while (0)
#define PG8_LDB(dst, b, h) do { _Pragma("unroll") for (int n = 0; n < 2; ++n) _Pragma("unroll") for (int k = 0; k < 2; ++k) dst[n][k] = *(const PG8_LAS bf16x8*)(lds + PG8_SB(b, h) + boff + n * 2048 + k * 1024); } while (0)
#define PG8_MMA(ai, bj, At, Bt) do { __builtin_amdgcn_s_setprio(1); _Pragma("unroll") for (int m = 0; m < 4; ++m) _Pragma("unroll") for (int n = 0; n < 2; ++n) _Pragma("unroll") for (int k = 0; k < 2; ++k) \
        acc[ai][bj][m][n] = __builtin_amdgcn_mfma_f32_16x16x32_bf16(Bt[n][k], At[m][k], acc[ai][bj][m][n], 0, 0, 0); __builtin_amdgcn_s_setprio(0); } while (0)
#define PG8_WAIT_V(n) asm volatile("s_waitcnt vmcnt(" #n ")" ::: "memory")
#define PG8_WAIT_L(n) asm volatile("s_waitcnt lgkmcnt(" #n ")" ::: "memory")
#define PG8_BAR __builtin_amdgcn_s_barrier()
#define PG8_SCHED __builtin_amdgcn_sched_barrier(0)
    Unit cur, nxt; int ui = 0;
    if (!S.next(0, cur)) return;
    f32x4 acc[2][2][4][2];
#pragma unroll
    for (int a = 0; a < 2; ++a)
#pragma unroll
        for (int b = 0; b < 2; ++b)
#pragma unroll
            for (int m = 0; m < 4; ++m)
#pragma unroll
                for (int n = 0; n < 2; ++n) acc[a][b][m][n] = (f32x4){0.f, 0.f, 0.f, 0.f};
    bf16x8 At[4][2], B0[2][2], B1[2][2];
    const char* cA = (const char*)g.A + (size_t)cur.pm * tstep; const char* cB = (const char*)g.Bt + (size_t)cur.pn * tstep;
    S.a_ready(cur);
    if constexpr (SP2) {
        PG8_STAGE(PG8_SB(0, 0), cB, voffB); PG8_STAGE(PG8_SB(0, 1), cB + hstep, voffB); PG8_STAGE(PG8_SA(0, 0), cA, voffA); PG8_STAGE(PG8_SA(0, 1), cA + hstep, voffA);
        if (wr == 1) PG8_BAR;
        PG8_WAIT_V(2); PG8_BAR;
        PG8_STAGE(PG8_SB(1, 0), cB + kstep, voffB); PG8_STAGE(PG8_SA(1, 0), cA + kstep, voffA); PG8_STAGE(PG8_SB(1, 1), cB + hstep + kstep, voffB);
        PG8_WAIT_V(6); PG8_BAR;
    } else {
        PG8_STAGE(PG8_SB(0, 0), cB, voffB); PG8_STAGE(PG8_SA(0, 0), cA, voffA); PG8_STAGE(PG8_SB(0, 1), cB + hstep, voffB); PG8_STAGE(PG8_SA(0, 1), cA + hstep, voffA);
        if (wr == 1) PG8_BAR;
        PG8_WAIT_V(4); PG8_BAR;
        PG8_STAGE(PG8_SB(1, 0), cB + kstep, voffB); PG8_STAGE(PG8_SA(1, 0), cA + kstep, voffA); PG8_STAGE(PG8_SB(1, 1), cB + hstep + kstep, voffB);
        PG8_WAIT_V(6); PG8_BAR;
    }
    for (;;) {
        const bool has_next = S.next(ui + 1, nxt);
        const char* nA = has_next ? (const char*)g.A + (size_t)nxt.pm * tstep : cA; const char* nB = has_next ? (const char*)g.Bt + (size_t)nxt.pn * tstep : cB;
        for (int t = 0; t < nt; t += 2) {
            const bool last = (t == nt - 2);
            const char* a1 = cA + (size_t)(t + 1) * kstep;
            const char* a2 = last ? nA : cA + (size_t)(t + 2) * kstep; const char* b2 = last ? nB : cB + (size_t)(t + 2) * kstep;
            const char* a3 = a2 + kstep; const char* b3 = b2 + kstep;
            if (last && has_next) S.a_ready(nxt);
            if constexpr (SP2) {
            PG8_LDB(B0, 0, 0); PG8_LDB(B1, 0, 1); PG8_SCHED; PG8_LDA(At, 0, 0); PG8_STAGE(PG8_SA(1, 1), a1 + hstep, voffA);
            PG8_WAIT_V(8); PG8_WAIT_L(0); PG8_BAR; PG8_MMA(0, 0, At, B0); PG8_MMA(0, 1, At, B1); PG8_BAR; PG8_SCHED;
            PG8_LDA(At, 0, 1); PG8_STAGE(PG8_SB(0, 0), b2, voffB); PG8_STAGE(PG8_SB(0, 1), b2 + hstep, voffB); PG8_STAGE(PG8_SA(0, 0), a2, voffA);
            PG8_WAIT_V(8); PG8_WAIT_L(0); PG8_BAR; PG8_MMA(1, 0, At, B0); PG8_MMA(1, 1, At, B1); PG8_BAR; PG8_SCHED;
            PG8_LDB(B0, 1, 0); PG8_LDB(B1, 1, 1); PG8_SCHED; PG8_LDA(At, 1, 0); PG8_STAGE(PG8_SA(0, 1), a2 + hstep, voffA);
            PG8_WAIT_V(8); PG8_WAIT_L(0); PG8_BAR; PG8_MMA(0, 0, At, B0); PG8_MMA(0, 1, At, B1); PG8_BAR; PG8_SCHED;
            PG8_LDA(At, 1, 1); PG8_STAGE(PG8_SB(1, 0), b3, voffB); PG8_STAGE(PG8_SB(1, 1), b3 + hstep, voffB); PG8_STAGE(PG8_SA(1, 0), a3, voffA);
            PG8_WAIT_V(8); PG8_WAIT_L(0); PG8_BAR; PG8_MMA(1, 0, At, B0); PG8_MMA(1, 1, At, B1); PG8_BAR; PG8_SCHED;
            } else {
            PG8_LDB(B0, 0, 0); PG8_SCHED; PG8_LDA(At, 0, 0); PG8_STAGE(PG8_SA(1, 1), a1 + hstep, voffA);
            PG8_WAIT_L(8); PG8_BAR; PG8_WAIT_L(0); PG8_MMA(0, 0, At, B0); PG8_BAR; PG8_SCHED;
            PG8_LDB(B1, 0, 1); PG8_STAGE(PG8_SB(0, 0), b2, voffB);
            PG8_BAR; PG8_WAIT_L(0); PG8_MMA(0, 1, At, B1); PG8_BAR;
            PG8_LDA(At, 0, 1); PG8_STAGE(PG8_SA(0, 0), a2, voffA);
            PG8_BAR; PG8_WAIT_L(0); PG8_MMA(1, 0, At, B0); PG8_BAR; PG8_SCHED;
            PG8_STAGE(PG8_SB(0, 1), b2 + hstep, voffB);
            PG8_WAIT_V(6); PG8_BAR; PG8_MMA(1, 1, At, B1); PG8_BAR;
            PG8_LDB(B0, 1, 0); PG8_SCHED; PG8_LDA(At, 1, 0); PG8_STAGE(PG8_SA(0, 1), a2 + hstep, voffA);
            PG8_WAIT_L(8); PG8_BAR; PG8_WAIT_L(0); PG8_MMA(0, 0, At, B0); PG8_BAR; PG8_SCHED;
            PG8_LDB(B1, 1, 1); PG8_STAGE(PG8_SB(1, 0), b3, voffB);
            PG8_BAR; PG8_WAIT_L(0); PG8_MMA(0, 1, At, B1); PG8_BAR;
            PG8_LDA(At, 1, 1); PG8_STAGE(PG8_SA(1, 0), a3, voffA);
            PG8_BAR; PG8_WAIT_L(0); PG8_MMA(1, 0, At, B0); PG8_BAR; PG8_SCHED;
            PG8_STAGE(PG8_SB(1, 1), b3 + hstep, voffB);
            PG8_WAIT_V(6); PG8_BAR; PG8_MMA(1, 1, At, B1); PG8_BAR;
            }
        }
        if constexpr (ALIGN_EPI) { if (wr == 0) PG8_BAR; }
        if constexpr (!Epi::AFTER_DRAIN) { E(acc, cur, wr, wc, fr, fq); S.done(cur); }
        if (!has_next) break;
#pragma unroll
        for (int a = 0; a < 2; ++a)
#pragma unroll
            for (int b = 0; b < 2; ++b)
#pragma unroll
                for (int m = 0; m < 4; ++m)
#pragma unroll
                    for (int n = 0; n < 2; ++n) acc[a][b][m][n] = (f32x4){0.f, 0.f, 0.f, 0.f};
        cur = nxt; cA = nA; cB = nB; ++ui;
        if constexpr (ALIGN_EPI) { if (wr == 1) PG8_BAR; }
    }
    PG8_WAIT_V(0);
    if constexpr (!ALIGN_EPI) { if (wr == 0) PG8_BAR; }
    PG8_BAR;
    if constexpr (Epi::AFTER_DRAIN) { E.fused(acc, cur, wr, wc, fr, fq, lds, wid, lane); S.done(cur); }
#undef PG8_SA
#undef PG8_SB
#undef PG8_STAGE
#undef PG8_LDA
#undef PG8_LDB
#undef PG8_MMA
#undef PG8_WAIT_V
#undef PG8_WAIT_L
#undef PG8_BAR
#undef PG8_SCHED
}
}

#ifndef PG8_SP2
#define PG8_SP2 true
#endif
#ifndef PG8_ALIGN
#define PG8_ALIGN true
#endif
#include <hip/hip_bf16.h>
#include <cmath>
namespace attn_body {
using bf16=__hip_bfloat16;
using bf16x8=__attribute__((ext_vector_type(8)))short;
using s16x4=__attribute__((ext_vector_type(4)))short;
using f32x16=__attribute__((ext_vector_type(16)))float;
using u32x4=__attribute__((ext_vector_type(4)))unsigned;
constexpr int BATCH=4,SEQ=8192,D=64,PP=6144,OP=2048;
constexpr int NW=8,QBLK=32,QB=QBLK*NW,KVBLK=64,NQB=SEQ/QB;
constexpr int ATTN_UNIT_ROWS=QB;
__device__ __forceinline__ int crow(int r,int hi){return (r&3)+8*(r>>2)+4*hi;}
#define SBAR() __builtin_amdgcn_sched_barrier(0)
__device__ __forceinline__ void cmask(f32x16&p0,f32x16&p1,int jb,int qrel,int hi){
  const float NEG=-INFINITY; int kb=64*jb+4*hi;
  #pragma unroll
  for(int r=0;r<16;++r){int kv=kb+(r&3)+8*(r>>2); if(kv>qrel)p0[r]=NEG; if(kv+32>qrel)p1[r]=NEG;}
}

constexpr int NSLOT=3, SLOTB=8192;
constexpr int LDS_K=0, LDS_V=NSLOT*SLOTB, LDS_WS=2*NSLOT*SLOTB, LDS_OST=LDS_WS+NW*64*4, LDS_BYTES=LDS_OST+NW*4096;
constexpr float C2=0.125f*1.4426950408889634f;
__device__ __forceinline__ void glds16(const void*gsrc,unsigned lds_dst){unsigned keep;
  asm volatile("s_mov_b32 %0, m0\n\ts_mov_b32 m0, %2\n\ts_nop 0\n\tglobal_load_lds_dwordx4 %1, off\n\ts_mov_b32 m0, %0":"=&s"(keep):"v"(gsrc),"s"(lds_dst):"memory");}
__device__ __forceinline__ float max3f(float a,float b,float c){float r;asm("v_max3_f32 %0, %1, %2, %3":"=v"(r):"v"(a),"v"(b),"v"(c));return r;}
__device__ __forceinline__ float max2f(float a,float b){float r;asm("v_max_f32_e32 %0, %1, %2":"=v"(r):"v"(a),"v"(b));return r;}
__device__ __forceinline__ float fadd_s(float a,float b){float r;asm("v_add_f32_e32 %0, %1, %2":"=v"(r):"v"(a),"v"(b));return r;}
__device__ __forceinline__ float fsub_s(float a,float b){float r;asm("v_sub_f32_e32 %0, %1, %2":"=v"(r):"v"(a),"v"(b));return r;}
typedef float f32x2_t __attribute__((ext_vector_type(2))); typedef __bf16 bf16x2_t __attribute__((ext_vector_type(2)));
__device__ __forceinline__ unsigned cvtpk_s(float lo,float hi){f32x2_t v={lo,hi};bf16x2_t b=__builtin_convertvector(v,bf16x2_t);return __builtin_bit_cast(unsigned,b);}
#define WAIT_BAR(N) asm volatile("s_waitcnt vmcnt(" #N ") lgkmcnt(0)\n\ts_barrier":::"memory")

__device__ __forceinline__ void qkt(f32x16&p0,f32x16&p1,const char*Kslot,const bf16x8*qr,const f32x16&negm,int r32,int hi){
  const char*kb=Kslot+hi*1024+r32*16;
  #pragma unroll
  for(int d0=0;d0<4;++d0){
    const bf16x8 b0=*reinterpret_cast<const bf16x8*>(kb+d0*2048);
    const bf16x8 b1=*reinterpret_cast<const bf16x8*>(kb+d0*2048+512);
    if(d0==0){p0=__builtin_amdgcn_mfma_f32_32x32x16_bf16(b0,qr[0],negm,0,0,0);p1=__builtin_amdgcn_mfma_f32_32x32x16_bf16(b1,qr[0],negm,0,0,0);}
    else{p0=__builtin_amdgcn_mfma_f32_32x32x16_bf16(b0,qr[d0],p0,0,0,0);p1=__builtin_amdgcn_mfma_f32_32x32x16_bf16(b1,qr[d0],p1,0,0,0);}}
}
typedef __attribute__((address_space(3))) const char* lds_cptr;
typedef short v4i16_t __attribute__((ext_vector_type(4)));
__device__ __forceinline__ void kload8(bf16x8*kf,lds_cptr kp){
  kf[0]=*(const __attribute__((address_space(3))) bf16x8*)(kp);      kf[1]=*(const __attribute__((address_space(3))) bf16x8*)(kp+512);
  kf[2]=*(const __attribute__((address_space(3))) bf16x8*)(kp+2048); kf[3]=*(const __attribute__((address_space(3))) bf16x8*)(kp+2560);
  kf[4]=*(const __attribute__((address_space(3))) bf16x8*)(kp+4096); kf[5]=*(const __attribute__((address_space(3))) bf16x8*)(kp+4608);
  kf[6]=*(const __attribute__((address_space(3))) bf16x8*)(kp+6144); kf[7]=*(const __attribute__((address_space(3))) bf16x8*)(kp+6656);
}
__device__ __forceinline__ void kload2(bf16x8*kf,lds_cptr kp,int j){ kf[2*j]=*(const __attribute__((address_space(3))) bf16x8*)(kp+j*2048); kf[2*j+1]=*(const __attribute__((address_space(3))) bf16x8*)(kp+j*2048+512); }
__device__ __forceinline__ s16x4 vtr(lds_cptr p){ return __builtin_bit_cast(s16x4,__builtin_amdgcn_ds_read_tr16_b64_v4i16((__attribute__((address_space(3))) v4i16_t*)p)); }
__device__ __forceinline__ float rowmax(const f32x16&p0,const f32x16&p1){
  float a=max3f(p0[0],p0[1],p1[0]),b=max3f(p0[2],p0[3],p1[1]);a=max3f(a,p1[2],p1[3]);
  #pragma unroll
  for(int r=4;r<16;r+=4){a=max3f(a,p0[r],p0[r+1]);b=max3f(b,p0[r+2],p0[r+3]);a=max3f(a,p1[r],p1[r+1]);b=max3f(b,p1[r+2],p1[r+3]);}
  const float m=max2f(a,b);
  auto rr=__builtin_amdgcn_permlane32_swap(__float_as_uint(m),__float_as_uint(m),false,false);
  return max2f(__uint_as_float(rr[0]),__uint_as_float(rr[1]));
}
__device__ __forceinline__ void pv(f32x16*o,int vb,bf16x8 pa0,bf16x8 pa1,bf16x8 pa2,bf16x8 pa3){
  #pragma unroll
  for(int d0=0;d0<2;++d0){s16x4 lo[4],hi[4];
    #pragma unroll
    for(int ks=0;ks<4;++ks){
      asm volatile("ds_read_b64_tr_b16 %0,%1 offset:%c2":"=&v"(lo[ks]):"v"(vb),"i"(d0*4096+ks*1024):"memory");
      asm volatile("ds_read_b64_tr_b16 %0,%1 offset:%c2":"=&v"(hi[ks]):"v"(vb),"i"(d0*4096+ks*1024+512):"memory");}
    asm volatile("s_waitcnt lgkmcnt(0)":::"memory");SBAR();
    #define PK(k) (bf16x8){lo[k][0],lo[k][1],lo[k][2],lo[k][3],hi[k][0],hi[k][1],hi[k][2],hi[k][3]}
    o[d0]=__builtin_amdgcn_mfma_f32_32x32x16_bf16(pa0,PK(0),o[d0],0,0,0);
    o[d0]=__builtin_amdgcn_mfma_f32_32x32x16_bf16(pa1,PK(1),o[d0],0,0,0);
    o[d0]=__builtin_amdgcn_mfma_f32_32x32x16_bf16(pa2,PK(2),o[d0],0,0,0);
    o[d0]=__builtin_amdgcn_mfma_f32_32x32x16_bf16(pa3,PK(3),o[d0],0,0,0);
    #undef PK
  }
}

#ifndef ATTN_STORE16
#define ATTN_STORE16(p,v) (*(u32x4*)(p)=(v))
#endif
template<int THRL> __device__ __forceinline__ void attn_unit(int b,int qb,const bf16*Q,const bf16*__restrict__ K,const bf16*__restrict__ V,bf16*O,char*shm){
  const int tid=threadIdx.x,lane=tid&63,r32=lane&31,hi=lane>>5; const int wid=__builtin_amdgcn_readfirstlane(tid>>6);
  const long rowbase=(long)b*SEQ; const int q0=qb*QB;
  const bf16*Qw=Q+(rowbase+q0+wid*QBLK)*PP;
  const bf16*Kh=K+rowbase*PP,*Vh=V+rowbase*PP;
  const unsigned lds0=(unsigned)(uintptr_t)shm;
  float*wsf=(float*)(shm+LDS_WS)+wid*64;
  const bf16*ksrc=Kh+(long)lane*PP+wid*8;
  const bf16*vsrc=Vh+(long)(16*(wid&3)+(lane>>2))*PP+(wid>>2)*32+(lane&3)*8;
  const unsigned kdst=lds0+LDS_K+wid*1024, vdst=lds0+LDS_V+wid*1024;
  #define DMA_K(t,slot) glds16(ksrc+(long)(t)*KVBLK*PP,(unsigned)__builtin_amdgcn_readfirstlane(kdst+(slot)))
  #define DMA_V(t,slot) glds16(vsrc+(long)(t)*KVBLK*PP,(unsigned)__builtin_amdgcn_readfirstlane(vdst+(slot)))
  const int vb0=(int)(lds0+LDS_V)+((lane>>4)&1)*32+(lane&3)*8+(4*hi+((lane&15)>>2))*64;
  const char*Kbase=shm+LDS_K; bf16x8 kf[8];
  const lds_cptr shm3=(lds_cptr)shm; const lds_cptr kp0=shm3+LDS_K+hi*1024+r32*16; const lds_cptr vp0=shm3+LDS_V+((lane>>4)&1)*32+(lane&3)*8+(4*hi+((lane&15)>>2))*64;
  const int NT=(q0+QB)/KVBLK;
  DMA_K(0,0);DMA_V(0,0);DMA_K(1,SLOTB);
  bf16x8 qr[4];
  #pragma unroll
  for(int d0=0;d0<4;++d0)qr[d0]=*reinterpret_cast<const bf16x8*>(&Qw[(long)r32*PP+d0*16+hi*8]);
  float mhat=0.f,l_reg=0.f;f32x16 o[2];o[0]=f32x16{};o[1]=f32x16{};f32x16 negm=f32x16{};asm volatile("":"+v"(negm));
  const int qrel=wid*QBLK+r32;
  #define CMASK(P0,P1,t) do{int jb_=(t)-(NT-4); if(jb_>=0)cmask(P0,P1,jb_,qrel,hi);}while(0)
  bool resc=false;
  #define START(P0,P1) do{ const float rm=rowmax(P0,P1); resc=false; \
    { const float dl=rm; mhat=fadd_s(mhat,dl); \
      _Pragma("unroll") for(int r=0;r<16;++r){P0[r]=fsub_s(P0[r],dl);P1[r]=fsub_s(P1[r],dl);} \
      _Pragma("unroll") for(int r=0;r<16;++r)negm[r]=-mhat; asm volatile("":"+v"(negm)); } \
    _Pragma("unroll") for(int r=0;r<16;++r)P0[r]=__builtin_amdgcn_exp2f(P0[r]); }while(0)
  #define RESC() do{ if(resc){ asm volatile("s_waitcnt lgkmcnt(0)":::"memory"); \
      _Pragma("unroll") for(int d_=0;d_<2;++d_) _Pragma("unroll") for(int r=0;r<16;++r)o[d_][r]*=wsf[crow(r,hi)]; } }while(0)
  f32x16 pA0,pA1,pB0,pB1;
  int sl_prev=0,sl_cur=0,sl_next=SLOTB;
  #define ROT() do{sl_prev=sl_cur;sl_cur=sl_next;sl_next=(sl_next==(NSLOT-1)*SLOTB)?0:sl_next+SLOTB;}while(0)
  DMA_K(2,2*SLOTB);
  WAIT_BAR(3);
  qkt(pA0,pA1,Kbase,qr,negm,r32,hi);asm volatile("s_nop 15\n\ts_nop 7":"+v"(pA0),"+v"(pA1));CMASK(pA0,pA1,0);
  START(pA0,pA1);
  _Pragma("unroll") for(int r=0;r<16;++r)pA1[r]=__builtin_amdgcn_exp2f(pA1[r]);
  WAIT_BAR(0);
  DMA_K(3,0);DMA_V(1,SLOTB);
  ROT();
  kload8(kf,kp0+sl_cur);
  WAIT_BAR(2);
  s16x4 vlo[8],vhi[8]; u32x4 pw0,pw1,pw2,pw3;
  #define PKW(P,B) cvtpk_s(P[B],P[B+1])
  #define PAF(k) __builtin_bit_cast(bf16x8,pw##k)
  #define VFR(i) (bf16x8){vlo[i][0],vlo[i][1],vlo[i][2],vlo[i][3],vhi[i][0],vhi[i][1],vhi[i][2],vhi[i][3]}
  #define PIN(x) asm volatile("":"+v"(x))
  #define MX3(a,b,c) __builtin_fmaxf(__builtin_fmaxf((a),(b)),(c))
  #define GAPA(MF,A0,A1,A2,A3,W0,W1,PW) do{ MF; sacc+=A0; sacc+=A1; sacc+=A2; sacc+=A3; PIN(sacc); W0; W1; PIN(PW); SBAR(); }while(0)
  #define EX(v) __builtin_amdgcn_exp2f(v)
  #define GAPB(MF,X,B) do{ MF; X[B]=EX(X[B]); X[B+1]=EX(X[B+1]); X[B+2]=EX(X[B+2]); X[B+3]=EX(X[B+3]); PIN(X); SBAR(); }while(0)
  #define VRD(i) do{ vlo[i]=vtr(vp_+(((i)>>2)*4096+((i)&3)*1024)); vhi[i]=vtr(vp_+(((i)>>2)*4096+((i)&3)*1024+512)); }while(0)
  #define KRD(G,j) do{ if(G){ kload2(kf,kp0+sl_next,j); SBAR(); } }while(0)
  #define STEP(C0,C1,P0,P1,t,GK,GV,GL) do{ SBAR(); \
    const lds_cptr vp_=vp0+sl_prev; \
    VRD(0); SBAR(); float sacc=(P0[0]+P0[1]); \
    GAPA(C0=__builtin_amdgcn_mfma_f32_32x32x16_bf16(kf[0],qr[0],negm,0,0,0), P0[2],P0[3],P0[4],P0[5],     pw0[0]=PKW(P0,0), pw0[1]=PKW(P0,2), pw0); \
    VRD(4); SBAR(); GAPA(C1=__builtin_amdgcn_mfma_f32_32x32x16_bf16(kf[1],qr[0],negm,0,0,0), P0[6],P0[7],P0[8],P0[9],     pw0[2]=PKW(P0,4), pw0[3]=PKW(P0,6), pw0); \
    VRD(1); SBAR(); GAPA(C0=__builtin_amdgcn_mfma_f32_32x32x16_bf16(kf[2],qr[1],C0,0,0,0),   P0[10],P0[11],P0[12],P0[13], pw1[0]=PKW(P0,8), pw1[1]=PKW(P0,10), pw1); \
    VRD(5); SBAR(); GAPA(C1=__builtin_amdgcn_mfma_f32_32x32x16_bf16(kf[3],qr[1],C1,0,0,0),   P0[14],P0[15],P1[0],P1[1],   pw1[2]=PKW(P0,12),pw1[3]=PKW(P0,14), pw1); \
    VRD(2); SBAR(); GAPA(C0=__builtin_amdgcn_mfma_f32_32x32x16_bf16(kf[4],qr[2],C0,0,0,0),   P1[2],P1[3],P1[4],P1[5],     pw2[0]=PKW(P1,0), pw2[1]=PKW(P1,2), pw2); \
    VRD(6); SBAR(); GAPA(C1=__builtin_amdgcn_mfma_f32_32x32x16_bf16(kf[5],qr[2],C1,0,0,0),   P1[6],P1[7],P1[8],P1[9],     pw2[2]=PKW(P1,4), pw2[3]=PKW(P1,6), pw2); \
    VRD(3); SBAR(); GAPA(C0=__builtin_amdgcn_mfma_f32_32x32x16_bf16(kf[6],qr[3],C0,0,0,0),   P1[10],P1[11],P1[12],P1[13], pw3[0]=PKW(P1,8), pw3[1]=PKW(P1,10), pw3); \
    VRD(7); SBAR(); GAPA(C1=__builtin_amdgcn_mfma_f32_32x32x16_bf16(kf[7],qr[3],C1,0,0,0),   P1[14],P1[15],0.f,0.f,       pw3[2]=PKW(P1,12),pw3[3]=PKW(P1,14), pw3); \
    l_reg+=sacc; \
    if(GK){DMA_K((t)+3,sl_cur);} if(GV){DMA_V((t)+1,sl_next);} \
    CMASK(C0,C1,t); \
    { float a=MX3(C0[0],C0[1],C1[0]),b=MX3(C0[2],C0[3],C1[1]); a=MX3(a,C1[2],C1[3]); \
      _Pragma("unroll") for(int r=4;r<16;r+=4){a=MX3(a,C0[r],C0[r+1]);b=MX3(b,C0[r+2],C0[r+3]);a=MX3(a,C1[r],C1[r+1]);b=MX3(b,C1[r+2],C1[r+3]);} \
      float rm=__builtin_fmaxf(a,b); { auto rr=__builtin_amdgcn_permlane32_swap(__float_as_uint(rm),__float_as_uint(rm),false,false); rm=__builtin_fmaxf(__uint_as_float(rr[0]),__uint_as_float(rr[1])); } \
      resc=false; \
      if(__builtin_expect(__any(rm>(float)THRL),0)){ const float dl=__builtin_fmaxf(rm,0.f); mhat+=dl; \
        _Pragma("unroll") for(int r=0;r<16;++r){C0[r]-=dl;C1[r]-=dl;} \
        _Pragma("unroll") for(int r=0;r<16;++r)negm[r]=-mhat; asm volatile("":"+v"(negm)); \
        const float f=__builtin_amdgcn_exp2f(-dl); l_reg*=f; if(hi==0)wsf[r32]=f; resc=true; } } \
    SBAR(); \
    GAPB(o[0]=__builtin_amdgcn_mfma_f32_32x32x16_bf16(PAF(0),VFR(0),o[0],0,0,0), C0,0); \
    GAPB(o[1]=__builtin_amdgcn_mfma_f32_32x32x16_bf16(PAF(0),VFR(4),o[1],0,0,0), C0,4); \
    KRD(GL,0); GAPB(o[0]=__builtin_amdgcn_mfma_f32_32x32x16_bf16(PAF(1),VFR(1),o[0],0,0,0), C0,8); \
    KRD(GL,1); GAPB(o[1]=__builtin_amdgcn_mfma_f32_32x32x16_bf16(PAF(1),VFR(5),o[1],0,0,0), C0,12); \
    KRD(GL,2); GAPB(o[0]=__builtin_amdgcn_mfma_f32_32x32x16_bf16(PAF(2),VFR(2),o[0],0,0,0), C1,0); \
    KRD(GL,3); GAPB(o[1]=__builtin_amdgcn_mfma_f32_32x32x16_bf16(PAF(2),VFR(6),o[1],0,0,0), C1,4); \
    GAPB(o[0]=__builtin_amdgcn_mfma_f32_32x32x16_bf16(PAF(3),VFR(3),o[0],0,0,0), C1,8); \
    GAPB(o[1]=__builtin_amdgcn_mfma_f32_32x32x16_bf16(PAF(3),VFR(7),o[1],0,0,0), C1,12); \
    }while(0)
  int t=1;
  #undef CMASK
  #define CMASK(P0,P1,t) do{}while(0)
  for(;t+5<NT;t+=2){
    STEP(pB0,pB1,pA0,pA1,t,true,true,true);     WAIT_BAR(2); RESC(); ROT();
    STEP(pA0,pA1,pB0,pB1,t+1,true,true,true);   WAIT_BAR(2); RESC(); ROT();
  }
  #undef CMASK
  #define CMASK(P0,P1,t) do{int jb_=(t)-(NT-4); if(jb_>=0)cmask(P0,P1,jb_,qrel,hi);}while(0)
  #define ENDW(tt) do{ if((tt)+3<NT){WAIT_BAR(2);} else if((tt)+2<NT){WAIT_BAR(1);} else {WAIT_BAR(0);} }while(0)
  for(;t+1<NT;t+=2){
    STEP(pB0,pB1,pA0,pA1,t,(t+3<NT),(t+1<NT),(t+1<NT));       ENDW(t);   RESC(); ROT();
    STEP(pA0,pA1,pB0,pB1,t+1,(t+4<NT),(t+2<NT),(t+2<NT));     ENDW(t+1); RESC(); ROT();
  }
  STEP(pB0,pB1,pA0,pA1,NT-1,false,false,false); RESC();
  { float sacc=pB0[0]+pB0[1]; _Pragma("unroll") for(int r=2;r<16;++r)sacc+=pB0[r]; _Pragma("unroll") for(int r=0;r<16;++r)sacc+=pB1[r]; l_reg+=sacc;
    pw0=(u32x4){PKW(pB0,0),PKW(pB0,2),PKW(pB0,4),PKW(pB0,6)};pw1=(u32x4){PKW(pB0,8),PKW(pB0,10),PKW(pB0,12),PKW(pB0,14)};pw2=(u32x4){PKW(pB1,0),PKW(pB1,2),PKW(pB1,4),PKW(pB1,6)};pw3=(u32x4){PKW(pB1,8),PKW(pB1,10),PKW(pB1,12),PKW(pB1,14)};
    SBAR(); pv(o,vb0+sl_cur,PAF(0),PAF(1),PAF(2),PAF(3)); }
  #undef PKW
  #undef PAF
  #undef VFR
  #undef PIN
  #undef MX3
  #undef GAPA
  #undef GAPB
  #undef EX
  #undef VRD
  #undef KRD
  #undef STEP
  #undef ENDW
  {auto rr=__builtin_amdgcn_permlane32_swap(__float_as_uint(l_reg),__float_as_uint(l_reg),false,false);l_reg=__uint_as_float(rr[0])+__uint_as_float(rr[1]);}
  if(hi==0)wsf[32+r32]=l_reg;asm volatile("s_waitcnt lgkmcnt(0)":::"memory");
  float rli[16];
  #pragma unroll
  for(int r=0;r<16;++r)rli[r]=__builtin_amdgcn_rcpf(wsf[32+crow(r,hi)]);
  bf16*Ow=O+(rowbase+q0+wid*QBLK)*OP;
  { bf16*stg=(bf16*)(shm+LDS_OST)+wid*2048;
    #pragma unroll
    for(int r=0;r<16;++r){const int orow=crow(r,hi);
      #pragma unroll
      for(int d0=0;d0<2;++d0)stg[orow*64+d0*32+r32]=__float2bfloat16(o[d0][r]*rli[r]);}
    asm volatile("s_waitcnt lgkmcnt(0)":::"memory");
    #pragma unroll
    for(int i=0;i<4;++i){const int row=i*8+(lane>>3),ch=lane&7; const u32x4 v=*(const u32x4*)(stg+row*64+ch*8); ATTN_STORE16(Ow+(long)row*OP+ch*8,v);} }
  asm volatile("s_waitcnt lgkmcnt(0)\n\ts_barrier":::"memory");
  #undef DMA_K
  #undef DMA_V
  #undef CMASK
  #undef START
  #undef RESC
  #undef ROT
}
constexpr int ATTN_LDS_BYTES=LDS_BYTES;
struct AttnTensors { const bf16* P; bf16* O; };
struct AttnUnit { int bh; int qb; };
struct StaticOrder {
  int vcu;
  __device__ __forceinline__ explicit StaticOrder(int grid,int block):vcu((block%8)*(grid/8)+block/8){}
  __device__ __forceinline__ bool next(int i,AttnUnit&u)const{ if(i>=16)return false; const int s=vcu&7,j=i&3; u.bh=(i>>2)*32+(vcu>>3); u.qb=(j==0)?s:(j==1)?15-s:(j==2)?16+s:31-s; return true; }
};
template<class Sched,int THRL=8> __device__ __forceinline__ void attn_phase(char*lds,const AttnTensors&T,const Sched&S){
  AttnUnit u;
  for(int i=0;S.next(i,u);++i){ const int b=u.bh>>5,v=u.bh&31,hc=v>>1,h=v>>2,vh=v&1;
    attn_unit<THRL>(b,u.qb,T.P+3072+hc*64,T.P+4096+hc*64,T.P+5120+h*128+vh*64,T.O+v*64,lds); }
}
constexpr int SLOTK=8192, SLOTV=16384;
constexpr int L2_K=0, L2_V=3*SLOTK, L2_WS=L2_V+3*SLOTV, L2_OST=L2_WS+NW*64*4, LDS2_BYTES=L2_OST+NW*8192;
template<int THRL> __device__ __forceinline__ void attn_unit2(int b,int qb,const bf16*Q,const bf16*__restrict__ K,const bf16*__restrict__ V,bf16*O,char*shm){
  const int tid=threadIdx.x,lane=tid&63,r32=lane&31,hi=lane>>5; const int wid=__builtin_amdgcn_readfirstlane(tid>>6);
  const long rowbase=(long)b*SEQ; const int q0=qb*QB;
  const bf16*Qw=Q+(rowbase+q0+wid*QBLK)*PP;
  const bf16*Kh=K+rowbase*PP,*Vh=V+rowbase*PP;
  const unsigned lds0=(unsigned)(uintptr_t)shm;
  float*wsf=(float*)(shm+L2_WS)+wid*64;
  const bf16*ksrc=Kh+(long)lane*PP+wid*8;
  const bf16*vsrc=Vh+(long)(16*(wid&3)+(lane>>2))*PP+(wid>>2)*32+(lane&3)*8;
  const unsigned kdst=lds0+L2_K+wid*1024, vdst=lds0+L2_V+wid*1024;
  #define DMA2_K(t,s) glds16(ksrc+(long)(t)*KVBLK*PP,(unsigned)__builtin_amdgcn_readfirstlane(kdst+(s)*SLOTK))
  #define DMA2_V(t,s) do{ glds16(vsrc+(long)(t)*KVBLK*PP,(unsigned)__builtin_amdgcn_readfirstlane(vdst+(s)*SLOTV)); glds16(vsrc+(long)(t)*KVBLK*PP+64,(unsigned)__builtin_amdgcn_readfirstlane(vdst+(s)*SLOTV+8192)); }while(0)
  const int vb0=(int)(lds0+L2_V)+((lane>>4)&1)*32+(lane&3)*8+(4*hi+((lane&15)>>2))*64;
  bf16x8 qr[4];
  #pragma unroll
  for(int d0=0;d0<4;++d0)qr[d0]=*reinterpret_cast<const bf16x8*>(&Qw[(long)r32*PP+d0*16+hi*8]);
  const int NT=(q0+QB)/KVBLK;
  DMA2_K(0,0);DMA2_V(0,0);DMA2_K(1,1);DMA2_V(1,1);
  float mhat=0.f,l_reg=0.f;f32x16 o[4];o[0]=f32x16{};o[1]=f32x16{};o[2]=f32x16{};o[3]=f32x16{};f32x16 negm=f32x16{};asm volatile("":"+v"(negm));
  const int qrel=wid*QBLK+r32;
  int slot=0;
  for(int t=0;t<NT;++t){
    if(t+1<NT){WAIT_BAR(3);}else{WAIT_BAR(0);}
    if(t+2<NT){const int s2=(slot==0)?2:slot-1; DMA2_K(t+2,s2);DMA2_V(t+2,s2);}
    f32x16 p0,p1;
    qkt(p0,p1,shm+L2_K+slot*SLOTK,qr,negm,r32,hi);
    asm volatile("s_nop 15\n\ts_nop 7":"+v"(p0),"+v"(p1));
    if(t>=NT-4)cmask(p0,p1,t-(NT-4),qrel,hi);
    const float rm=rowmax(p0,p1);
    const bool first=(t==0);
    if(first||__any(rm>(float)THRL)){
      const float dl=first?rm:__builtin_fmaxf(rm,0.f); mhat+=dl;
      #pragma unroll
      for(int r=0;r<16;++r){p0[r]-=dl;p1[r]-=dl;}
      #pragma unroll
      for(int r=0;r<16;++r)negm[r]=-mhat;
      asm volatile("":"+v"(negm));
      if(!first){ const float f=__builtin_amdgcn_exp2f(-dl); l_reg*=f; if(hi==0)wsf[r32]=f; asm volatile("s_waitcnt lgkmcnt(0)":::"memory");
        #pragma unroll
        for(int d_=0;d_<4;++d_)
          #pragma unroll
          for(int r=0;r<16;++r)o[d_][r]*=wsf[crow(r,hi)];
        asm volatile("s_waitcnt lgkmcnt(0)":::"memory"); }
    }
    #pragma unroll
    for(int r=0;r<16;++r){p0[r]=__builtin_amdgcn_exp2f(p0[r]);p1[r]=__builtin_amdgcn_exp2f(p1[r]);}
    { float sa=0.f,sb=0.f;
      #pragma unroll
      for(int r=0;r<16;++r){sa+=p0[r];sb+=p1[r];}
      l_reg+=sa+sb; }
    u32x4 pw0,pw1,pw2,pw3;
    pw0=(u32x4){cvtpk_s(p0[0],p0[1]),cvtpk_s(p0[2],p0[3]),cvtpk_s(p0[4],p0[5]),cvtpk_s(p0[6],p0[7])};
    pw1=(u32x4){cvtpk_s(p0[8],p0[9]),cvtpk_s(p0[10],p0[11]),cvtpk_s(p0[12],p0[13]),cvtpk_s(p0[14],p0[15])};
    pw2=(u32x4){cvtpk_s(p1[0],p1[1]),cvtpk_s(p1[2],p1[3]),cvtpk_s(p1[4],p1[5]),cvtpk_s(p1[6],p1[7])};
    pw3=(u32x4){cvtpk_s(p1[8],p1[9]),cvtpk_s(p1[10],p1[11]),cvtpk_s(p1[12],p1[13]),cvtpk_s(p1[14],p1[15])};
    SBAR();
    pv(o,vb0+slot*SLOTV,__builtin_bit_cast(bf16x8,pw0),__builtin_bit_cast(bf16x8,pw1),__builtin_bit_cast(bf16x8,pw2),__builtin_bit_cast(bf16x8,pw3));
    pv(o+2,vb0+slot*SLOTV+8192,__builtin_bit_cast(bf16x8,pw0),__builtin_bit_cast(bf16x8,pw1),__builtin_bit_cast(bf16x8,pw2),__builtin_bit_cast(bf16x8,pw3));
    slot=(slot==2)?0:slot+1;
  }
  {auto rr=__builtin_amdgcn_permlane32_swap(__float_as_uint(l_reg),__float_as_uint(l_reg),false,false);l_reg=__uint_as_float(rr[0])+__uint_as_float(rr[1]);}
  if(hi==0)wsf[32+r32]=l_reg;asm volatile("s_waitcnt lgkmcnt(0)":::"memory");
  float rli[16];
  #pragma unroll
  for(int r=0;r<16;++r)rli[r]=__builtin_amdgcn_rcpf(wsf[32+crow(r,hi)]);
  bf16*Ow=O+(rowbase+q0+wid*QBLK)*OP;
  { bf16*stg=(bf16*)(shm+L2_OST)+wid*4096;
    #pragma unroll
    for(int r=0;r<16;++r){const int orow=crow(r,hi);
      #pragma unroll
      for(int d0=0;d0<4;++d0)stg[orow*128+d0*32+r32]=__float2bfloat16(o[d0][r]*rli[r]);}
    asm volatile("s_waitcnt lgkmcnt(0)":::"memory");
    #pragma unroll
    for(int i=0;i<8;++i){const int row=i*4+(lane>>4),ch=lane&15; const u32x4 v=*(const u32x4*)(stg+row*128+ch*8); ATTN_STORE16(Ow+(long)row*OP+ch*8,v);} }
  asm volatile("s_waitcnt lgkmcnt(0)\n\ts_barrier":::"memory");
  #undef DMA2_K
  #undef DMA2_V
}
struct StaticOrder2 {
  int vcu;
  __device__ __forceinline__ explicit StaticOrder2(int grid,int block):vcu((block%8)*(grid/8)+block/8){}
  __device__ __forceinline__ bool next(int i,AttnUnit&u)const{ if(i>=8)return false; const int s=vcu&7,j=i&3; u.bh=(i>>2)*32+(vcu>>3); u.qb=(j==0)?s:(j==1)?15-s:(j==2)?16+s:31-s; return true; }
};
template<class Sched,int THRL=8> __device__ __forceinline__ void attn_phase2(char*lds,const AttnTensors&T,const Sched&S){
  AttnUnit u;
  for(int i=0;S.next(i,u);++i){ const int b=u.bh>>4,hc=u.bh&15,h=hc>>1;
    attn_unit2<THRL>(b,u.qb,T.P+3072+hc*64,T.P+4096+hc*64,T.P+5120+h*128,T.O+hc*128,lds); }
}

constexpr int NSK=4;
constexpr int L3_K=0, L3_V=NSK*SLOTK, L3_WS=L3_V+3*SLOTV, L3_Q=L3_WS+NW*64*4, LDS3_BYTES=L3_Q+NW*4096;
__device__ __forceinline__ float rowmax_c(const f32x16&p0,const f32x16&p1){
  #define MX3C(a,b,c) __builtin_fmaxf(__builtin_fmaxf((a),(b)),(c))
  float a=MX3C(p0[0],p0[1],p1[0]),b=MX3C(p0[2],p0[3],p1[1]);a=MX3C(a,p1[2],p1[3]);
  #pragma unroll
  for(int r=4;r<16;r+=4){a=MX3C(a,p0[r],p0[r+1]);b=MX3C(b,p0[r+2],p0[r+3]);a=MX3C(a,p1[r],p1[r+1]);b=MX3C(b,p1[r+2],p1[r+3]);}
  #undef MX3C
  const float m=__builtin_fmaxf(a,b);
  auto rr=__builtin_amdgcn_permlane32_swap(__float_as_uint(m),__float_as_uint(m),false,false);
  return __builtin_fmaxf(__uint_as_float(rr[0]),__uint_as_float(rr[1]));
}

__device__ __forceinline__ void qkt4(f32x16&p0,f32x16&p1,lds_cptr kp,lds_cptr qp,const f32x16&negm){
  #define KFR(off) (*(const __attribute__((address_space(3))) bf16x8*)(kp+(off)))
  #define QFR(d0) (*(const __attribute__((address_space(3))) bf16x8*)(qp+(d0)*1024))
  bf16x8 ka=KFR(0),kb=KFR(512),q0=QFR(0),kc=KFR(2048),kd=KFR(2560),q1=QFR(1); SBAR();
  p0=__builtin_amdgcn_mfma_f32_32x32x16_bf16(ka,q0,negm,0,0,0); ka=KFR(4096); SBAR();
  p1=__builtin_amdgcn_mfma_f32_32x32x16_bf16(kb,q0,negm,0,0,0); kb=KFR(4608); q0=QFR(2); SBAR();
  p0=__builtin_amdgcn_mfma_f32_32x32x16_bf16(kc,q1,p0,0,0,0);   kc=KFR(6144); SBAR();
  p1=__builtin_amdgcn_mfma_f32_32x32x16_bf16(kd,q1,p1,0,0,0);   kd=KFR(6656); q1=QFR(3); SBAR();
  p0=__builtin_amdgcn_mfma_f32_32x32x16_bf16(ka,q0,p0,0,0,0); SBAR();
  p1=__builtin_amdgcn_mfma_f32_32x32x16_bf16(kb,q0,p1,0,0,0); SBAR();
  p0=__builtin_amdgcn_mfma_f32_32x32x16_bf16(kc,q1,p0,0,0,0); SBAR();
  p1=__builtin_amdgcn_mfma_f32_32x32x16_bf16(kd,q1,p1,0,0,0); SBAR();
  #undef KFR
  #undef QFR
}
template<int THRL> __device__ __forceinline__ void attn_unit3(int b,int qb,const bf16*Q,const bf16*__restrict__ K,const bf16*__restrict__ V,bf16*O,char*shm){
  const int tid=threadIdx.x,lane=tid&63,r32=lane&31,hi=lane>>5; const int wid=__builtin_amdgcn_readfirstlane(tid>>6);
  const long rowbase=(long)b*SEQ; const int q0=qb*QB;
  const bf16*Qw=Q+(rowbase+q0+wid*QBLK)*PP;
  const bf16*Kh=K+rowbase*PP,*Vh=V+rowbase*PP;
  const unsigned lds0=(unsigned)(uintptr_t)shm;
  float*wsf=(float*)(shm+L3_WS)+wid*64;
  const bf16*ksrc=Kh+(long)lane*PP+wid*8;
  const bf16*vsrc=Vh+(long)(16*(wid&3)+(lane>>2))*PP+(wid>>2)*32+(lane&3)*8;
  const unsigned kdst=lds0+L3_K+wid*1024, vdst=lds0+L3_V+wid*1024;
  #define DMA3_K(t) glds16(ksrc+(long)(t)*KVBLK*PP,(unsigned)__builtin_amdgcn_readfirstlane(kdst+((t)&3)*SLOTK))
  #define DMA3_V(t,s) do{ glds16(vsrc+(long)(t)*KVBLK*PP,(unsigned)__builtin_amdgcn_readfirstlane(vdst+(s)*SLOTV)); glds16(vsrc+(long)(t)*KVBLK*PP+64,(unsigned)__builtin_amdgcn_readfirstlane(vdst+(s)*SLOTV+8192)); }while(0)
  const lds_cptr shm3=(lds_cptr)shm; const lds_cptr kp0=shm3+L3_K+hi*1024+r32*16; const lds_cptr vp0=shm3+L3_V+((lane>>4)&1)*32+(lane&3)*8+(4*hi+((lane&15)>>2))*64;
  const lds_cptr qp=shm3+L3_Q+wid*4096+lane*16;
  { bf16x8 qr[4];
    #pragma unroll
    for(int d0=0;d0<4;++d0)qr[d0]=*reinterpret_cast<const bf16x8*>(&Qw[(long)r32*PP+d0*16+hi*8]);
    #pragma unroll
    for(int d0=0;d0<4;++d0)*(__attribute__((address_space(3))) bf16x8*)((__attribute__((address_space(3))) char*)qp+d0*1024)=qr[d0]; }
  const int NT=(q0+QB)/KVBLK;
  DMA3_K(0);DMA3_V(0,0);DMA3_K(1);DMA3_V(1,1);DMA3_K(2);
  float mhat=0.f;f32x16 lacc=f32x16{};const bf16x8 ones={16256,16256,16256,16256,16256,16256,16256,16256};     f32x16 o[4];o[0]=f32x16{};o[1]=f32x16{};o[2]=f32x16{};o[3]=f32x16{};f32x16 negm=f32x16{};asm volatile("":"+v"(negm));
  const int qrel=wid*QBLK+r32;
  WAIT_BAR(3);
  DMA3_K(3);DMA3_V(2,2);
  f32x16 p0,p1; u32x4 pw0,pw1,pw2,pw3;
  qkt4(p0,p1,kp0,qp,negm);
  if(NT==4)cmask(p0,p1,0,qrel,hi);
  { const float rm=rowmax_c(p0,p1); mhat=rm;
    #pragma unroll
    for(int r=0;r<16;++r){p0[r]=__builtin_amdgcn_exp2f(p0[r]-rm);p1[r]=__builtin_amdgcn_exp2f(p1[r]-rm);}
    #pragma unroll
    for(int r=0;r<16;++r)negm[r]=-mhat;
    asm volatile("":"+v"(negm));
    pw0=(u32x4){cvtpk_s(p0[0],p0[1]),cvtpk_s(p0[2],p0[3]),cvtpk_s(p0[4],p0[5]),cvtpk_s(p0[6],p0[7])};
    pw1=(u32x4){cvtpk_s(p0[8],p0[9]),cvtpk_s(p0[10],p0[11]),cvtpk_s(p0[12],p0[13]),cvtpk_s(p0[14],p0[15])};
    pw2=(u32x4){cvtpk_s(p1[0],p1[1]),cvtpk_s(p1[2],p1[3]),cvtpk_s(p1[4],p1[5]),cvtpk_s(p1[6],p1[7])};
    pw3=(u32x4){cvtpk_s(p1[8],p1[9]),cvtpk_s(p1[10],p1[11]),cvtpk_s(p1[12],p1[13]),cvtpk_s(p1[14],p1[15])}; }
  int vs=0;
  #define VFL(dq,ks) ({ const s16x4 lo_=vtr(vp_+((dq)*4096+(ks)*1024)),hi_=vtr(vp_+((dq)*4096+(ks)*1024+512)); (bf16x8){lo_[0],lo_[1],lo_[2],lo_[3],hi_[0],hi_[1],hi_[2],hi_[3]}; })
  u32x4 n0=(u32x4){0u,0u,0u,0u},n1=n0,n2=n0,n3=n0;
  for(int t2=0;t2<NT;t2+=2){
   { const int t=t2;
    const bool more=(t+1<NT);
    if(t>0){
      if(t+2<NT){WAIT_BAR(3);}else if(more){WAIT_BAR(2);}else{WAIT_BAR(0);}
      if(t+3<NT)DMA3_K(t+3);
      if(t+2<NT){const int s2=(vs==0)?2:vs-1; DMA3_V(t+2,s2);}
    }
    bool resc=false;
    if(more){
      qkt4(p0,p1,kp0+((t+1)&3)*SLOTK,qp,negm);
      if(t+1>=NT-4)cmask(p0,p1,t+1-(NT-4),qrel,hi);
      const float rm=rowmax_c(p0,p1);
      if(__builtin_expect(__any(rm>(float)THRL),0)){ const float dl=__builtin_fmaxf(rm,0.f); mhat+=dl;
        #pragma unroll
        for(int r=0;r<16;++r){p0[r]-=dl;p1[r]-=dl;}
        #pragma unroll
        for(int r=0;r<16;++r)negm[r]=-mhat;
        asm volatile("":"+v"(negm));
        const float f=__builtin_amdgcn_exp2f(-dl); if(hi==0)wsf[r32]=f; resc=true; }
    }
    const lds_cptr vp_=vp0+vs*SLOTV;
    bf16x8 vf0=VFL(0,0),vf1=VFL(1,0),vf2=VFL(2,0),vf3=VFL(3,0);

    SBAR();
    o[0]=__builtin_amdgcn_mfma_f32_32x32x16_bf16(__builtin_bit_cast(bf16x8,pw0),vf0,o[0],0,0,0); vf0=VFL(0,1); asm volatile("":"+v"(p0)); { const float e0=__builtin_amdgcn_exp2f(p0[0]),e1=__builtin_amdgcn_exp2f(p0[1]); n0[0]=cvtpk_s(e0,e1); } asm volatile("":"+v"(n0)); SBAR();
    o[1]=__builtin_amdgcn_mfma_f32_32x32x16_bf16(__builtin_bit_cast(bf16x8,pw0),vf1,o[1],0,0,0); vf1=VFL(1,1); asm volatile("":"+v"(p0)); { const float e0=__builtin_amdgcn_exp2f(p0[2]),e1=__builtin_amdgcn_exp2f(p0[3]); n0[1]=cvtpk_s(e0,e1); } asm volatile("":"+v"(n0)); SBAR();
    o[2]=__builtin_amdgcn_mfma_f32_32x32x16_bf16(__builtin_bit_cast(bf16x8,pw0),vf2,o[2],0,0,0); vf2=VFL(2,1); asm volatile("":"+v"(p0)); { const float e0=__builtin_amdgcn_exp2f(p0[4]),e1=__builtin_amdgcn_exp2f(p0[5]); n0[2]=cvtpk_s(e0,e1); } asm volatile("":"+v"(n0)); SBAR();
    o[3]=__builtin_amdgcn_mfma_f32_32x32x16_bf16(__builtin_bit_cast(bf16x8,pw0),vf3,o[3],0,0,0); vf3=VFL(3,1); asm volatile("":"+v"(p0)); { const float e0=__builtin_amdgcn_exp2f(p0[6]),e1=__builtin_amdgcn_exp2f(p0[7]); n0[3]=cvtpk_s(e0,e1); } asm volatile("":"+v"(n0)); SBAR();
    lacc=__builtin_amdgcn_mfma_f32_32x32x16_bf16(__builtin_bit_cast(bf16x8,pw0),ones,lacc,0,0,0); SBAR();
    o[0]=__builtin_amdgcn_mfma_f32_32x32x16_bf16(__builtin_bit_cast(bf16x8,pw1),vf0,o[0],0,0,0); vf0=VFL(0,2); asm volatile("":"+v"(p0)); { const float e0=__builtin_amdgcn_exp2f(p0[8]),e1=__builtin_amdgcn_exp2f(p0[9]); n1[0]=cvtpk_s(e0,e1); } asm volatile("":"+v"(n1)); SBAR();
    o[1]=__builtin_amdgcn_mfma_f32_32x32x16_bf16(__builtin_bit_cast(bf16x8,pw1),vf1,o[1],0,0,0); vf1=VFL(1,2); asm volatile("":"+v"(p0)); { const float e0=__builtin_amdgcn_exp2f(p0[10]),e1=__builtin_amdgcn_exp2f(p0[11]); n1[1]=cvtpk_s(e0,e1); } asm volatile("":"+v"(n1)); SBAR();
    o[2]=__builtin_amdgcn_mfma_f32_32x32x16_bf16(__builtin_bit_cast(bf16x8,pw1),vf2,o[2],0,0,0); vf2=VFL(2,2); asm volatile("":"+v"(p0)); { const float e0=__builtin_amdgcn_exp2f(p0[12]),e1=__builtin_amdgcn_exp2f(p0[13]); n1[2]=cvtpk_s(e0,e1); } asm volatile("":"+v"(n1)); SBAR();
    o[3]=__builtin_amdgcn_mfma_f32_32x32x16_bf16(__builtin_bit_cast(bf16x8,pw1),vf3,o[3],0,0,0); vf3=VFL(3,2); asm volatile("":"+v"(p0)); { const float e0=__builtin_amdgcn_exp2f(p0[14]),e1=__builtin_amdgcn_exp2f(p0[15]); n1[3]=cvtpk_s(e0,e1); } asm volatile("":"+v"(n1)); SBAR();
    lacc=__builtin_amdgcn_mfma_f32_32x32x16_bf16(__builtin_bit_cast(bf16x8,pw1),ones,lacc,0,0,0); SBAR();
    o[0]=__builtin_amdgcn_mfma_f32_32x32x16_bf16(__builtin_bit_cast(bf16x8,pw2),vf0,o[0],0,0,0); vf0=VFL(0,3); asm volatile("":"+v"(p1)); { const float e0=__builtin_amdgcn_exp2f(p1[0]),e1=__builtin_amdgcn_exp2f(p1[1]); n2[0]=cvtpk_s(e0,e1); } asm volatile("":"+v"(n2)); SBAR();
    o[1]=__builtin_amdgcn_mfma_f32_32x32x16_bf16(__builtin_bit_cast(bf16x8,pw2),vf1,o[1],0,0,0); vf1=VFL(1,3); asm volatile("":"+v"(p1)); { const float e0=__builtin_amdgcn_exp2f(p1[2]),e1=__builtin_amdgcn_exp2f(p1[3]); n2[1]=cvtpk_s(e0,e1); } asm volatile("":"+v"(n2)); SBAR();
    o[2]=__builtin_amdgcn_mfma_f32_32x32x16_bf16(__builtin_bit_cast(bf16x8,pw2),vf2,o[2],0,0,0); vf2=VFL(2,3); asm volatile("":"+v"(p1)); { const float e0=__builtin_amdgcn_exp2f(p1[4]),e1=__builtin_amdgcn_exp2f(p1[5]); n2[2]=cvtpk_s(e0,e1); } asm volatile("":"+v"(n2)); SBAR();
    o[3]=__builtin_amdgcn_mfma_f32_32x32x16_bf16(__builtin_bit_cast(bf16x8,pw2),vf3,o[3],0,0,0); vf3=VFL(3,3); asm volatile("":"+v"(p1)); { const float e0=__builtin_amdgcn_exp2f(p1[6]),e1=__builtin_amdgcn_exp2f(p1[7]); n2[3]=cvtpk_s(e0,e1); } asm volatile("":"+v"(n2)); SBAR();
    lacc=__builtin_amdgcn_mfma_f32_32x32x16_bf16(__builtin_bit_cast(bf16x8,pw2),ones,lacc,0,0,0); SBAR();
    o[0]=__builtin_amdgcn_mfma_f32_32x32x16_bf16(__builtin_bit_cast(bf16x8,pw3),vf0,o[0],0,0,0); asm volatile("":"+v"(p1)); { const float e0=__builtin_amdgcn_exp2f(p1[8]),e1=__builtin_amdgcn_exp2f(p1[9]); n3[0]=cvtpk_s(e0,e1); } asm volatile("":"+v"(n3)); SBAR();
    o[1]=__builtin_amdgcn_mfma_f32_32x32x16_bf16(__builtin_bit_cast(bf16x8,pw3),vf1,o[1],0,0,0); asm volatile("":"+v"(p1)); { const float e0=__builtin_amdgcn_exp2f(p1[10]),e1=__builtin_amdgcn_exp2f(p1[11]); n3[1]=cvtpk_s(e0,e1); } asm volatile("":"+v"(n3)); SBAR();
    o[2]=__builtin_amdgcn_mfma_f32_32x32x16_bf16(__builtin_bit_cast(bf16x8,pw3),vf2,o[2],0,0,0); asm volatile("":"+v"(p1)); { const float e0=__builtin_amdgcn_exp2f(p1[12]),e1=__builtin_amdgcn_exp2f(p1[13]); n3[2]=cvtpk_s(e0,e1); } asm volatile("":"+v"(n3)); SBAR();
    o[3]=__builtin_amdgcn_mfma_f32_32x32x16_bf16(__builtin_bit_cast(bf16x8,pw3),vf3,o[3],0,0,0); asm volatile("":"+v"(p1)); { const float e0=__builtin_amdgcn_exp2f(p1[14]),e1=__builtin_amdgcn_exp2f(p1[15]); n3[3]=cvtpk_s(e0,e1); } asm volatile("":"+v"(n3)); SBAR();
    lacc=__builtin_amdgcn_mfma_f32_32x32x16_bf16(__builtin_bit_cast(bf16x8,pw3),ones,lacc,0,0,0); SBAR();
    if(resc){ asm volatile("s_waitcnt lgkmcnt(0)":::"memory");
      #pragma unroll
      for(int d_=0;d_<4;++d_)
        #pragma unroll
        for(int r=0;r<16;++r)o[d_][r]*=wsf[crow(r,hi)];
      #pragma unroll
      for(int r=0;r<16;++r)lacc[r]*=wsf[crow(r,hi)];
      asm volatile("s_waitcnt lgkmcnt(0)":::"memory"); }
    vs=(vs==2)?0:vs+1;
     }
   { const int t=t2+1;
    const bool more=(t+1<NT);
    if(t>0){
      if(t+2<NT){WAIT_BAR(3);}else if(more){WAIT_BAR(2);}else{WAIT_BAR(0);}
      if(t+3<NT)DMA3_K(t+3);
      if(t+2<NT){const int s2=(vs==0)?2:vs-1; DMA3_V(t+2,s2);}
    }
    bool resc=false;
    if(more){
      qkt4(p0,p1,kp0+((t+1)&3)*SLOTK,qp,negm);
      if(t+1>=NT-4)cmask(p0,p1,t+1-(NT-4),qrel,hi);
      const float rm=rowmax_c(p0,p1);
      if(__builtin_expect(__any(rm>(float)THRL),0)){ const float dl=__builtin_fmaxf(rm,0.f); mhat+=dl;
        #pragma unroll
        for(int r=0;r<16;++r){p0[r]-=dl;p1[r]-=dl;}
        #pragma unroll
        for(int r=0;r<16;++r)negm[r]=-mhat;
        asm volatile("":"+v"(negm));
        const float f=__builtin_amdgcn_exp2f(-dl); if(hi==0)wsf[r32]=f; resc=true; }
    }
    const lds_cptr vp_=vp0+vs*SLOTV;
    bf16x8 vf0=VFL(0,0),vf1=VFL(1,0),vf2=VFL(2,0),vf3=VFL(3,0);

    SBAR();
    o[0]=__builtin_amdgcn_mfma_f32_32x32x16_bf16(__builtin_bit_cast(bf16x8,n0),vf0,o[0],0,0,0); vf0=VFL(0,1); asm volatile("":"+v"(p0)); { const float e0=__builtin_amdgcn_exp2f(p0[0]),e1=__builtin_amdgcn_exp2f(p0[1]); pw0[0]=cvtpk_s(e0,e1); } asm volatile("":"+v"(pw0)); SBAR();
    o[1]=__builtin_amdgcn_mfma_f32_32x32x16_bf16(__builtin_bit_cast(bf16x8,n0),vf1,o[1],0,0,0); vf1=VFL(1,1); asm volatile("":"+v"(p0)); { const float e0=__builtin_amdgcn_exp2f(p0[2]),e1=__builtin_amdgcn_exp2f(p0[3]); pw0[1]=cvtpk_s(e0,e1); } asm volatile("":"+v"(pw0)); SBAR();
    o[2]=__builtin_amdgcn_mfma_f32_32x32x16_bf16(__builtin_bit_cast(bf16x8,n0),vf2,o[2],0,0,0); vf2=VFL(2,1); asm volatile("":"+v"(p0)); { const float e0=__builtin_amdgcn_exp2f(p0[4]),e1=__builtin_amdgcn_exp2f(p0[5]); pw0[2]=cvtpk_s(e0,e1); } asm volatile("":"+v"(pw0)); SBAR();
    o[3]=__builtin_amdgcn_mfma_f32_32x32x16_bf16(__builtin_bit_cast(bf16x8,n0),vf3,o[3],0,0,0); vf3=VFL(3,1); asm volatile("":"+v"(p0)); { const float e0=__builtin_amdgcn_exp2f(p0[6]),e1=__builtin_amdgcn_exp2f(p0[7]); pw0[3]=cvtpk_s(e0,e1); } asm volatile("":"+v"(pw0)); SBAR();
    lacc=__builtin_amdgcn_mfma_f32_32x32x16_bf16(__builtin_bit_cast(bf16x8,n0),ones,lacc,0,0,0); SBAR();
    o[0]=__builtin_amdgcn_mfma_f32_32x32x16_bf16(__builtin_bit_cast(bf16x8,n1),vf0,o[0],0,0,0); vf0=VFL(0,2); asm volatile("":"+v"(p0)); { const float e0=__builtin_amdgcn_exp2f(p0[8]),e1=__builtin_amdgcn_exp2f(p0[9]); pw1[0]=cvtpk_s(e0,e1); } asm volatile("":"+v"(pw1)); SBAR();
    o[1]=__builtin_amdgcn_mfma_f32_32x32x16_bf16(__builtin_bit_cast(bf16x8,n1),vf1,o[1],0,0,0); vf1=VFL(1,2); asm volatile("":"+v"(p0)); { const float e0=__builtin_amdgcn_exp2f(p0[10]),e1=__builtin_amdgcn_exp2f(p0[11]); pw1[1]=cvtpk_s(e0,e1); } asm volatile("":"+v"(pw1)); SBAR();
    o[2]=__builtin_amdgcn_mfma_f32_32x32x16_bf16(__builtin_bit_cast(bf16x8,n1),vf2,o[2],0,0,0); vf2=VFL(2,2); asm volatile("":"+v"(p0)); { const float e0=__builtin_amdgcn_exp2f(p0[12]),e1=__builtin_amdgcn_exp2f(p0[13]); pw1[2]=cvtpk_s(e0,e1); } asm volatile("":"+v"(pw1)); SBAR();
    o[3]=__builtin_amdgcn_mfma_f32_32x32x16_bf16(__builtin_bit_cast(bf16x8,n1),vf3,o[3],0,0,0); vf3=VFL(3,2); asm volatile("":"+v"(p0)); { const float e0=__builtin_amdgcn_exp2f(p0[14]),e1=__builtin_amdgcn_exp2f(p0[15]); pw1[3]=cvtpk_s(e0,e1); } asm volatile("":"+v"(pw1)); SBAR();
    lacc=__builtin_amdgcn_mfma_f32_32x32x16_bf16(__builtin_bit_cast(bf16x8,n1),ones,lacc,0,0,0); SBAR();
    o[0]=__builtin_amdgcn_mfma_f32_32x32x16_bf16(__builtin_bit_cast(bf16x8,n2),vf0,o[0],0,0,0); vf0=VFL(0,3); asm volatile("":"+v"(p1)); { const float e0=__builtin_amdgcn_exp2f(p1[0]),e1=__builtin_amdgcn_exp2f(p1[1]); pw2[0]=cvtpk_s(e0,e1); } asm volatile("":"+v"(pw2)); SBAR();
    o[1]=__builtin_amdgcn_mfma_f32_32x32x16_bf16(__builtin_bit_cast(bf16x8,n2),vf1,o[1],0,0,0); vf1=VFL(1,3); asm volatile("":"+v"(p1)); { const float e0=__builtin_amdgcn_exp2f(p1[2]),e1=__builtin_amdgcn_exp2f(p1[3]); pw2[1]=cvtpk_s(e0,e1); } asm volatile("":"+v"(pw2)); SBAR();
    o[2]=__builtin_amdgcn_mfma_f32_32x32x16_bf16(__builtin_bit_cast(bf16x8,n2),vf2,o[2],0,0,0); vf2=VFL(2,3); asm volatile("":"+v"(p1)); { const float e0=__builtin_amdgcn_exp2f(p1[4]),e1=__builtin_amdgcn_exp2f(p1[5]); pw2[2]=cvtpk_s(e0,e1); } asm volatile("":"+v"(pw2)); SBAR();
    o[3]=__builtin_amdgcn_mfma_f32_32x32x16_bf16(__builtin_bit_cast(bf16x8,n2),vf3,o[3],0,0,0); vf3=VFL(3,3); asm volatile("":"+v"(p1)); { const float e0=__builtin_amdgcn_exp2f(p1[6]),e1=__builtin_amdgcn_exp2f(p1[7]); pw2[3]=cvtpk_s(e0,e1); } asm volatile("":"+v"(pw2)); SBAR();
    lacc=__builtin_amdgcn_mfma_f32_32x32x16_bf16(__builtin_bit_cast(bf16x8,n2),ones,lacc,0,0,0); SBAR();
    o[0]=__builtin_amdgcn_mfma_f32_32x32x16_bf16(__builtin_bit_cast(bf16x8,n3),vf0,o[0],0,0,0); asm volatile("":"+v"(p1)); { const float e0=__builtin_amdgcn_exp2f(p1[8]),e1=__builtin_amdgcn_exp2f(p1[9]); pw3[0]=cvtpk_s(e0,e1); } asm volatile("":"+v"(pw3)); SBAR();
    o[1]=__builtin_amdgcn_mfma_f32_32x32x16_bf16(__builtin_bit_cast(bf16x8,n3),vf1,o[1],0,0,0); asm volatile("":"+v"(p1)); { const float e0=__builtin_amdgcn_exp2f(p1[10]),e1=__builtin_amdgcn_exp2f(p1[11]); pw3[1]=cvtpk_s(e0,e1); } asm volatile("":"+v"(pw3)); SBAR();
    o[2]=__builtin_amdgcn_mfma_f32_32x32x16_bf16(__builtin_bit_cast(bf16x8,n3),vf2,o[2],0,0,0); asm volatile("":"+v"(p1)); { const float e0=__builtin_amdgcn_exp2f(p1[12]),e1=__builtin_amdgcn_exp2f(p1[13]); pw3[2]=cvtpk_s(e0,e1); } asm volatile("":"+v"(pw3)); SBAR();
    o[3]=__builtin_amdgcn_mfma_f32_32x32x16_bf16(__builtin_bit_cast(bf16x8,n3),vf3,o[3],0,0,0); asm volatile("":"+v"(p1)); { const float e0=__builtin_amdgcn_exp2f(p1[14]),e1=__builtin_amdgcn_exp2f(p1[15]); pw3[3]=cvtpk_s(e0,e1); } asm volatile("":"+v"(pw3)); SBAR();
    lacc=__builtin_amdgcn_mfma_f32_32x32x16_bf16(__builtin_bit_cast(bf16x8,n3),ones,lacc,0,0,0); SBAR();
    if(resc){ asm volatile("s_waitcnt lgkmcnt(0)":::"memory");
      #pragma unroll
      for(int d_=0;d_<4;++d_)
        #pragma unroll
        for(int r=0;r<16;++r)o[d_][r]*=wsf[crow(r,hi)];
      #pragma unroll
      for(int r=0;r<16;++r)lacc[r]*=wsf[crow(r,hi)];
      asm volatile("s_waitcnt lgkmcnt(0)":::"memory"); }
    vs=(vs==2)?0:vs+1;
     }
  }
  #undef VFL
  WAIT_BAR(0);
  float rli[16];
  #pragma unroll
  for(int r=0;r<16;++r)rli[r]=__builtin_amdgcn_rcpf(lacc[r]);
  bf16*Ow=O+(rowbase+q0+wid*QBLK)*OP;
  { int ln=lane; asm volatile("":"+v"(ln));
    const int r32e=ln&31,hie=ln>>5;
    bf16*stg=(bf16*)shm+wid*4096;
    bf16*sw=stg+4*hie*128+r32e;
    #pragma unroll
    for(int r=0;r<16;++r){
      #pragma unroll
      for(int d0=0;d0<4;++d0)sw[((r&3)+8*(r>>2))*128+d0*32]=__float2bfloat16(o[d0][r]*rli[r]);}
    asm volatile("s_waitcnt lgkmcnt(0)":::"memory");
    const bf16*sr=stg+(ln>>4)*128+(ln&15)*8; bf16*gw_=Ow+(long)(ln>>4)*OP+(ln&15)*8;
    #pragma unroll
    for(int i=0;i<8;++i){ const u32x4 v=*(const u32x4*)(sr+i*4*128); ATTN_STORE16(gw_+(long)i*4*OP,v);} }
  asm volatile("s_waitcnt lgkmcnt(0)\n\ts_barrier":::"memory");
  #undef DMA3_K
  #undef DMA3_V
}
template<class Sched,int THRL=8> __device__ __forceinline__ void attn_phase3(char*lds,const AttnTensors&T,const Sched&S){
  AttnUnit u;
  for(int i=0;S.next(i,u);++i){ const int b=u.bh>>4,hc=u.bh&15,h=hc>>1;
    attn_unit3<THRL>(b,u.qb,T.P+3072+hc*64,T.P+4096+hc*64,T.P+5120+h*128,T.O+hc*128,lds); }
}
#undef SBAR
#undef WAIT_BAR
}
namespace cg = cooperative_groups;
constexpr int NWAVES = 8;
constexpr int BATCH = 4, SEQ = 8192, DMODEL = 2048, FFN = 5632, INC = 6144;
constexpr int M = BATCH * SEQ;
constexpr float RMS_EPS = 1e-6f;
constexpr size_t MiB = 1u << 20;
constexpr size_t WS_WGU1 = 2 * MiB, WS_WD1 = 46 * MiB, WS_WIN = 68 * MiB, WS_WOUT = 92 * MiB, WS_WGU2 = 100 * MiB, WS_WD2 = 144 * MiB;
constexpr size_t WS_XN = 168 * MiB, WS_O = 296 * MiB, WS_H = 424 * MiB, WS_Y = 808 * MiB, WS_END = 936 * MiB;
constexpr int LDS_BYTES = 147456 + 1024;
constexpr int MISC_OFF = 147456;
constexpr size_t WS_CTL = 0, CTL_ZERO_BYTES = 640 * 1024;
constexpr size_t WS_CNT = 64 * 1024, WS_SSQ3 = 512 * 1024;
constexpr size_t WS_SSQ0 = 128 * 1024, WS_SSQ1 = 256 * 1024, WS_SSQ2 = 384 * 1024;
constexpr int CW_BAR = 1024;
#ifndef REP_ATTN
#define REP_ATTN 1
#endif
#ifndef REP_LIGHT
#define REP_LIGHT 1
#endif
#ifndef REP_P0
#define REP_P0 1
#endif

#define GAS __attribute__((address_space(1)))
#define LAS __attribute__((address_space(3)))
typedef unsigned short bf16;
typedef unsigned v4u __attribute__((ext_vector_type(4)));
typedef float f32x4 __attribute__((ext_vector_type(4)));
#define LDS_WAIT() asm volatile("s_waitcnt lgkmcnt(0)" ::: "memory")
__device__ __forceinline__ unsigned f2bf(float f) { unsigned u = __builtin_bit_cast(unsigned, f); return (u + 0x7fffu + ((u >> 16) & 1u)) >> 16; }
__device__ __forceinline__ unsigned pk2(float lo, float hi) { return f2bf(lo) | (f2bf(hi) << 16); }
__device__ __forceinline__ float bflo(unsigned w) { return __uint_as_float(w << 16); }
__device__ __forceinline__ float bfhi(unsigned w) { return __uint_as_float(w & 0xffff0000u); }
__device__ __forceinline__ float wave_sum(float v) {
#pragma unroll
    for (int o = 1; o < 64; o <<= 1) v += __shfl_xor(v, o);
    return v;
}
__device__ __forceinline__ void p0_transpose_item(const float* W, int K, int N, bf16* WT, int mode, LAS float* scr, int item, int lane, const float* g = nullptr) {
    const int nblk = N / 64, kb = item / nblk, nb = item % nblk, k0 = 64 * kb, n0 = 64 * nb;
    const int drow0 = (mode == 0) ? n0 : (256 * (n0 >> 7) + (n0 & 127) + (mode == 2 ? 128 : 0));
    const int lr = lane >> 4, lc = (lane & 15) * 4;
#pragma unroll 8
    for (int i = 0; i < 16; ++i) { const int kk = 4 * i + lr; const float gk = g ? g[k0 + kk] : 1.0f;
        const f32x4 w = *(const GAS f32x4*)(W + (size_t)(k0 + kk) * N + n0 + lc) * gk; LAS float* d = scr + kk * 65 + lc; d[0] = w.x; d[1] = w.y; d[2] = w.z; d[3] = w.w; }
    LDS_WAIT(); asm volatile("" ::: "memory");
    const int c = lane & 7;
#pragma unroll
    for (int j = 0; j < 8; ++j) { const int n = (lane >> 3) + 8 * j; const LAS float* s = scr + (8 * c) * 65 + n;
        v4u o; o.x = pk2(s[0 * 65], s[1 * 65]); o.y = pk2(s[2 * 65], s[3 * 65]); o.z = pk2(s[4 * 65], s[5 * 65]); o.w = pk2(s[6 * 65], s[7 * 65]);
        *(GAS v4u*)(WT + (size_t)(drow0 + n) * K + k0 + 8 * c) = o; }
    LDS_WAIT(); asm volatile("" ::: "memory");
}
__device__ __forceinline__ void rms_row_to_bf16(const float* xrow, const float* g, bf16* orow, float* ssq_row, int lane) {
    const GAS f32x4* xr = (const GAS f32x4*)xrow + lane; (void)g;
    f32x4 v[8]; float s = 0.f;
#pragma unroll
    for (int j = 0; j < 8; ++j) { v[j] = xr[64 * j]; s += (v[j].x * v[j].x + v[j].y * v[j].y) + (v[j].z * v[j].z + v[j].w * v[j].w); }
    s = wave_sum(s); if (lane == 0) *ssq_row = s;
    GAS unsigned long long* o8 = (GAS unsigned long long*)orow + lane;
#pragma unroll
    for (int j = 0; j < 8; ++j) { const f32x4 y = v[j];
        o8[64 * j] = (unsigned long long)pk2(y.x, y.y) | ((unsigned long long)pk2(y.z, y.w) << 32); }
}
__device__ __forceinline__ void rms_row_f32(const float* xrow, const float* g, float* orow, int lane) {
    const GAS f32x4* xr = (const GAS f32x4*)xrow + lane; const GAS f32x4* gr = (const GAS f32x4*)g + lane;
    f32x4 v[8]; float s = 0.f;
#pragma unroll
    for (int j = 0; j < 8; ++j) { v[j] = xr[64 * j]; s += (v[j].x * v[j].x + v[j].y * v[j].y) + (v[j].z * v[j].z + v[j].w * v[j].w); }
    const float rstd = 1.0f / sqrtf(wave_sum(s) * (1.f / DMODEL) + RMS_EPS);
    GAS f32x4* o = (GAS f32x4*)orow + lane;
#pragma unroll
    for (int j = 0; j < 8; ++j) { const f32x4 gv = gr[64 * j]; o[64 * j] = v[j] * rstd * gv; }
}
__device__ __forceinline__ void mix_row(const bf16* P, const bf16* O, bf16* Y, const float* convw, const float* subln, float lam, int m, int lane) {
    const int t = m & (SEQ - 1);
    const bf16* pr = P + (size_t)m * INC; bf16* yr = Y + (size_t)m * DMODEL;
#pragma unroll
    for (int i = 0; i < 2; ++i) {
        const int j = lane * 8 + 512 * i;
        const v4u bq = *(const GAS v4u*)(pr + j), c0 = *(const GAS v4u*)(pr + 1024 + j), x0 = *(const GAS v4u*)(pr + 2048 + j);
        v4u c1 = (v4u){0u, 0u, 0u, 0u}, x1 = c1, c2 = c1, x2 = c1;
        if (t >= 1) { c1 = *(const GAS v4u*)(pr - INC + 1024 + j); x1 = *(const GAS v4u*)(pr - INC + 2048 + j); }
        if (t >= 2) { c2 = *(const GAS v4u*)(pr - 2 * INC + 1024 + j); x2 = *(const GAS v4u*)(pr - 2 * INC + 2048 + j); }
        const f32x4 wa0 = *(const GAS f32x4*)(convw + j), wa1 = *(const GAS f32x4*)(convw + j + 4);
        const f32x4 wb0 = *(const GAS f32x4*)(convw + 1024 + j), wb1 = *(const GAS f32x4*)(convw + 1024 + j + 4);
        const f32x4 wc0 = *(const GAS f32x4*)(convw + 2048 + j), wc1 = *(const GAS f32x4*)(convw + 2048 + j + 4);
        v4u o;
#define MIXPAIR(q, WA, WB, WC, e0, e1) pk2( \
            bflo(bq[q]) * (WA[e0] * (bflo(c2[q]) * bflo(x2[q])) + WB[e0] * (bflo(c1[q]) * bflo(x1[q])) + WC[e0] * (bflo(c0[q]) * bflo(x0[q]))), \
            bfhi(bq[q]) * (WA[e1] * (bfhi(c2[q]) * bfhi(x2[q])) + WB[e1] * (bfhi(c1[q]) * bfhi(x1[q])) + WC[e1] * (bfhi(c0[q]) * bfhi(x0[q]))))
        o.x = MIXPAIR(0, wa0, wb0, wc0, 0, 1); o.y = MIXPAIR(1, wa0, wb0, wc0, 2, 3); o.z = MIXPAIR(2, wa1, wb1, wc1, 0, 1); o.w = MIXPAIR(3, wa1, wb1, wc1, 2, 3);
#undef MIXPAIR
        *(GAS v4u*)(yr + j) = o;
    }
    {
        const int h = lane >> 3, d0 = (lane & 7) * 16;
        const bf16* o1p = O + (size_t)m * DMODEL + h * 256 + d0; const bf16* o2p = o1p + 128;
        const v4u a0 = *(const GAS v4u*)o1p, a1 = *(const GAS v4u*)(o1p + 8), b0 = *(const GAS v4u*)o2p, b1 = *(const GAS v4u*)(o2p + 8);
        float o[16]; float ss = 0.f;
#pragma unroll
        for (int q = 0; q < 4; ++q) { o[2 * q] = bflo(a0[q]) - lam * bflo(b0[q]); o[2 * q + 1] = bfhi(a0[q]) - lam * bfhi(b0[q]);
            o[8 + 2 * q] = bflo(a1[q]) - lam * bflo(b1[q]); o[8 + 2 * q + 1] = bfhi(a1[q]) - lam * bfhi(b1[q]); }
#pragma unroll
        for (int e = 0; e < 16; ++e) ss += o[e] * o[e];
        ss += __shfl_xor(ss, 1); ss += __shfl_xor(ss, 2); ss += __shfl_xor(ss, 4);
        const float rs = 0.8f / sqrtf(ss * (1.f / 128.f) + RMS_EPS);
        const f32x4 g0 = *(const GAS f32x4*)(subln + d0), g1 = *(const GAS f32x4*)(subln + d0 + 4), g2 = *(const GAS f32x4*)(subln + d0 + 8), g3 = *(const GAS f32x4*)(subln + d0 + 12);
        v4u w0, w1;
        w0.x = pk2(o[0] * rs * g0[0], o[1] * rs * g0[1]); w0.y = pk2(o[2] * rs * g0[2], o[3] * rs * g0[3]); w0.z = pk2(o[4] * rs * g1[0], o[5] * rs * g1[1]); w0.w = pk2(o[6] * rs * g1[2], o[7] * rs * g1[3]);
        w1.x = pk2(o[8] * rs * g2[0], o[9] * rs * g2[1]); w1.y = pk2(o[10] * rs * g2[2], o[11] * rs * g2[3]); w1.z = pk2(o[12] * rs * g3[0], o[13] * rs * g3[1]); w1.w = pk2(o[14] * rs * g3[2], o[15] * rs * g3[3]);
        bf16* yo = yr + 1024 + h * 128 + d0;
        *(GAS v4u*)yo = w0; *(GAS v4u*)(yo + 8) = w1;
    }
}

#define XB_TMO      128
#define XB_XCNT(j)  (256  + 64 * (j))
#define XB_XSUB(j)  (1280 + 64 * (j))
#define XB_XGEN(j)  (2304 + 64 * (j))
#define XB_TOP      3328
#define XB_TOPGEN   3392
#define XCD_BAR_WORDS 3456
#define XB_SPIN_CAP (1u << 18)

__device__ __forceinline__ unsigned xb_ld(unsigned* p)              { return __hip_atomic_load(p, __ATOMIC_RELAXED, __HIP_MEMORY_SCOPE_AGENT); }
__device__ __forceinline__ unsigned xb_add(unsigned* p, unsigned v) { return __hip_atomic_fetch_add(p, v, __ATOMIC_RELAXED, __HIP_MEMORY_SCOPE_AGENT); }
__device__ __forceinline__ unsigned xb_xcc_id() { return (unsigned)__builtin_amdgcn_s_getreg((3 << 11) | 20) & 0xFu; }
#define XB_SPIN(cond, bar) do { unsigned _sp = 0; while (cond) { __builtin_amdgcn_s_sleep(1); \
    if ((++_sp & 255u) == 0u) { if (xb_ld(&(bar)[XB_TMO])) break; if (_sp > XB_SPIN_CAP) { atomicAdd(&(bar)[XB_TMO], 1u); break; } } } } while (0)

struct XcdBarrier {
    unsigned* bar; unsigned x;
    volatile LAS unsigned* st;
};

__device__ __forceinline__ XcdBarrier xcd_barrier_post(unsigned* bar, volatile LAS unsigned* st) {
    XcdBarrier b; b.bar = bar; b.x = xb_xcc_id(); b.st = st;
    if (threadIdx.x == 0) (void)xb_add(&bar[XB_XCNT(b.x)], 1u);
    return b;
}
__device__ __forceinline__ void xcd_barrier_complete(unsigned* bar, unsigned x, unsigned& nloc, unsigned& nx) {
    const unsigned G = gridDim.x * gridDim.y * gridDim.z;
    unsigned sum, cnt, mine, sp = 0u;
    for (;;) {
        sum = 0u; cnt = 0u; mine = 0u;
#pragma unroll
        for (unsigned j = 0; j < 16; ++j) { const unsigned c = xb_ld(&bar[XB_XCNT(j)]); sum += c; cnt += (c > 0u) ? 1u : 0u; mine = (j == x) ? c : mine; }
        if (sum == G) break;
        __builtin_amdgcn_s_sleep(1);
        if ((++sp & 255u) == 0u) { if (xb_ld(&bar[XB_TMO])) break; if (sp > XB_SPIN_CAP) { atomicAdd(&bar[XB_TMO], 1u); break; } }
    }
    nloc = mine > 0u ? mine : 1u; nx = cnt > 0u ? cnt : 1u;
}

__device__ __forceinline__ void xcd_barrier(const XcdBarrier& b) {
    asm volatile("s_waitcnt vmcnt(0)" ::: "memory");
    __syncthreads();
    if (threadIdx.x == 0) {
        unsigned* bar = b.bar;
        __builtin_amdgcn_s_waitcnt(0);
        unsigned nloc = b.st[0], nx = b.st[1];
        if (nloc == 0u) { xcd_barrier_complete(bar, b.x, nloc, nx); b.st[0] = nloc; b.st[1] = nx; }
        const unsigned old = xb_add(&bar[XB_XSUB(b.x)], 1u);
        const unsigned gen = old / nloc;
        if (old + 1u == (gen + 1u) * nloc) {
            __builtin_amdgcn_fence(__ATOMIC_RELEASE, "agent");
            asm volatile("s_waitcnt vmcnt(0)" ::: "memory");
            const unsigned og = xb_add(&bar[XB_TOP], 1u);
            const unsigned tg = og / nx;
            if (og + 1u == (tg + 1u) * nx) xb_add(&bar[XB_TOPGEN], 1u);
            else XB_SPIN(xb_ld(&bar[XB_TOPGEN]) == tg, bar);
            __builtin_amdgcn_fence(__ATOMIC_ACQUIRE, "agent");
            xb_add(&bar[XB_XGEN(b.x)], 1u);
            asm volatile("s_waitcnt vmcnt(0)" ::: "memory");
        } else {
            XB_SPIN(xb_ld(&bar[XB_XGEN(b.x)]) == gen, bar);
            __builtin_amdgcn_fence(__ATOMIC_ACQUIRE, "agent");
            asm volatile("s_waitcnt vmcnt(0)" ::: "memory");
        }
    }
    __syncthreads();
}

__device__ __forceinline__ void mix_block16(const bf16* P, const bf16* O, bf16* Y, const float* convw, const float* subln, float lam, int blk, int lane) {
    const int m0 = blk * 16, t0 = m0 & (SEQ - 1);
    f32x4 wa[2][2], wb[2][2], wc[2][2];
#pragma unroll
    for (int i = 0; i < 2; ++i) { const int j = lane * 8 + 512 * i;
        wa[i][0] = *(const GAS f32x4*)(convw + j); wa[i][1] = *(const GAS f32x4*)(convw + j + 4);
        wb[i][0] = *(const GAS f32x4*)(convw + 1024 + j); wb[i][1] = *(const GAS f32x4*)(convw + 1024 + j + 4);
        wc[i][0] = *(const GAS f32x4*)(convw + 2048 + j); wc[i][1] = *(const GAS f32x4*)(convw + 2048 + j + 4); }
    const int h = lane >> 3, d0 = (lane & 7) * 16;
    const f32x4 g0 = *(const GAS f32x4*)(subln + d0), g1 = *(const GAS f32x4*)(subln + d0 + 4), g2 = *(const GAS f32x4*)(subln + d0 + 8), g3 = *(const GAS f32x4*)(subln + d0 + 12);
    float u1[2][8], u2[2][8];
#pragma unroll
    for (int i = 0; i < 2; ++i) { const int j = lane * 8 + 512 * i;
        v4u c1 = (v4u){0u, 0u, 0u, 0u}, x1 = c1, c2 = c1, x2 = c1;
        if (t0 > 0) { const bf16* pr = P + (size_t)m0 * INC; c1 = *(const GAS v4u*)(pr - INC + 1024 + j); x1 = *(const GAS v4u*)(pr - INC + 2048 + j); c2 = *(const GAS v4u*)(pr - 2 * INC + 1024 + j); x2 = *(const GAS v4u*)(pr - 2 * INC + 2048 + j); }
#pragma unroll
        for (int q = 0; q < 4; ++q) { u1[i][2 * q] = bflo(c1[q]) * bflo(x1[q]); u1[i][2 * q + 1] = bfhi(c1[q]) * bfhi(x1[q]); u2[i][2 * q] = bflo(c2[q]) * bflo(x2[q]); u2[i][2 * q + 1] = bfhi(c2[q]) * bfhi(x2[q]); } }
#pragma unroll 2
    for (int r = 0; r < 16; ++r) {
        const int m = m0 + r;
        const bf16* pr = P + (size_t)m * INC; bf16* yr = Y + (size_t)m * DMODEL;
        const bf16* o1p = O + (size_t)m * DMODEL + h * 256 + d0; const bf16* o2p = o1p + 128;
        const v4u a0 = *(const GAS v4u*)o1p, a1 = *(const GAS v4u*)(o1p + 8), b0 = *(const GAS v4u*)o2p, b1 = *(const GAS v4u*)(o2p + 8);
#pragma unroll
        for (int i = 0; i < 2; ++i) { const int j = lane * 8 + 512 * i;
            const v4u bq = *(const GAS v4u*)(pr + j), c0 = *(const GAS v4u*)(pr + 1024 + j), x0 = *(const GAS v4u*)(pr + 2048 + j);
            float u0[8], y[8];
#pragma unroll
            for (int q = 0; q < 4; ++q) { u0[2 * q] = bflo(c0[q]) * bflo(x0[q]); u0[2 * q + 1] = bfhi(c0[q]) * bfhi(x0[q]); }
#pragma unroll
            for (int e = 0; e < 8; ++e) { const float ta = wa[i][e >> 2][e & 3], tb = wb[i][e >> 2][e & 3], tc = wc[i][e >> 2][e & 3];
                const float bg = (e & 1) ? bfhi(bq[e >> 1]) : bflo(bq[e >> 1]);
                y[e] = bg * (ta * u2[i][e] + tb * u1[i][e] + tc * u0[e]); u2[i][e] = u1[i][e]; u1[i][e] = u0[e]; }
            v4u o; o.x = pk2(y[0], y[1]); o.y = pk2(y[2], y[3]); o.z = pk2(y[4], y[5]); o.w = pk2(y[6], y[7]);
            *(GAS v4u*)(yr + j) = o; }
        float o[16]; float ss = 0.f;
#pragma unroll
        for (int q = 0; q < 4; ++q) { o[2 * q] = bflo(a0[q]) - lam * bflo(b0[q]); o[2 * q + 1] = bfhi(a0[q]) - lam * bfhi(b0[q]);
            o[8 + 2 * q] = bflo(a1[q]) - lam * bflo(b1[q]); o[8 + 2 * q + 1] = bfhi(a1[q]) - lam * bfhi(b1[q]); }
#pragma unroll
        for (int e = 0; e < 16; ++e) ss += o[e] * o[e];
        ss += __shfl_xor(ss, 1); ss += __shfl_xor(ss, 2); ss += __shfl_xor(ss, 4);
        const float rs = 0.8f / sqrtf(ss * (1.f / 128.f) + RMS_EPS);
        v4u w0, w1;
        w0.x = pk2(o[0] * rs * g0[0], o[1] * rs * g0[1]); w0.y = pk2(o[2] * rs * g0[2], o[3] * rs * g0[3]); w0.z = pk2(o[4] * rs * g1[0], o[5] * rs * g1[1]); w0.w = pk2(o[6] * rs * g1[2], o[7] * rs * g1[3]);
        w1.x = pk2(o[8] * rs * g2[0], o[9] * rs * g2[1]); w1.y = pk2(o[10] * rs * g2[2], o[11] * rs * g2[3]); w1.z = pk2(o[12] * rs * g3[0], o[13] * rs * g3[1]); w1.w = pk2(o[14] * rs * g3[2], o[15] * rs * g3[3]);
        bf16* yo = yr + 1024 + h * 128 + d0;
        *(GAS v4u*)yo = w0; *(GAS v4u*)(yo + 8) = w1;
    }
}

struct Args { const float* in[19]; float* out; unsigned char* ws; };
__global__ void __launch_bounds__(NWAVES * 64, 2) mega_fwd(Args args) {
    extern __shared__ __attribute__((aligned(16))) unsigned char lds[];
    cg::grid_group grid = cg::this_grid();
    LAS unsigned char* ldsp = (LAS unsigned char*)lds;
    const int tid = threadIdx.x, wave = __builtin_amdgcn_readfirstlane(tid >> 6);
    const int G = gridDim.x, bx = blockIdx.x;
    const int vcu = (G % 8 == 0) ? (bx % 8) * (G / 8) + bx / 8 : bx;
    const int gw = vcu * NWAVES + wave, NGW = G * NWAVES;
    for (int u = tid; u < (LDS_BYTES - MISC_OFF) / 4; u += NWAVES * 64) ((LAS unsigned*)(ldsp + MISC_OFF))[u] = 0u;
    __syncthreads();
    const XcdBarrier bar = xcd_barrier_post((unsigned*)(args.ws + WS_CTL) + CW_BAR, (volatile LAS unsigned*)(ldsp + MISC_OFF) + 8);
    typedef const Args __attribute__((address_space(4)))* kargp_t;
#define KARG(field) ({ kargp_t _ka = (kargp_t)__builtin_amdgcn_kernarg_segment_ptr(); asm volatile("" : "+s"(_ka)); _ka->field; })
#define IN(i) KARG(in[i])
#define WSP(off) (KARG(ws) + (off))
#define WGU1 ((bf16*)WSP(WS_WGU1))
#define WD1 ((bf16*)WSP(WS_WD1))
#define WIN ((bf16*)WSP(WS_WIN))
#define WOUT ((bf16*)WSP(WS_WOUT))
#define WGU2 ((bf16*)WSP(WS_WGU2))
#define WD2 ((bf16*)WSP(WS_WD2))
#define XN ((bf16*)WSP(WS_XN))
#define OB ((bf16*)WSP(WS_O))
#define HB ((bf16*)WSP(WS_H))
#define PROJ HB
#define YB ((bf16*)WSP(WS_Y))

#define FRESH_LANE() ({ int _l = threadIdx.x & 63; asm volatile("" : "+v"(_l)); _l; })
    for (int rep = 0; rep < REP_P0; ++rep) {
        const int lane = FRESH_LANE();
        LAS float* scr = (LAS float*)(ldsp + wave * 16640);
        constexpr int I_G = (DMODEL / 64) * (FFN / 64), I_D = (FFN / 64) * (DMODEL / 64), I_IN = (DMODEL / 64) * (INC / 64), I_O = (DMODEL / 64) * (DMODEL / 64);
        constexpr int NITEMS = 4 * I_G + 2 * I_D + I_IN + I_O;
        for (int it = gw; it < NITEMS; it += NGW) {
            int r = it;
            if (r < I_G) { p0_transpose_item(IN(2), DMODEL, FFN, WGU1, 1, scr, r, lane, IN(1)); continue; } r -= I_G;
            if (r < I_G) { p0_transpose_item(IN(3), DMODEL, FFN, WGU1, 2, scr, r, lane, IN(1)); continue; } r -= I_G;
            if (r < I_D) { p0_transpose_item(IN(4), FFN, DMODEL, WD1, 0, scr, r, lane); continue; } r -= I_D;
            if (r < I_IN) { p0_transpose_item(IN(6), DMODEL, INC, WIN, 0, scr, r, lane, IN(5)); continue; } r -= I_IN;
            if (r < I_O) { p0_transpose_item(IN(13), DMODEL, DMODEL, WOUT, 0, scr, r, lane); continue; } r -= I_O;
            if (r < I_G) { p0_transpose_item(IN(15), DMODEL, FFN, WGU2, 1, scr, r, lane, IN(14)); continue; } r -= I_G;
            if (r < I_G) { p0_transpose_item(IN(16), DMODEL, FFN, WGU2, 2, scr, r, lane, IN(14)); continue; } r -= I_G;
            p0_transpose_item(IN(17), FFN, DMODEL, WD2, 0, scr, r, lane);
        }
        { const float* xi = IN(0); const float* gn = IN(1); bf16* xn = XN; float* sq = (float*)WSP(WS_SSQ0); for (int m = gw; m < M; m += NGW) rms_row_to_bf16(xi + (size_t)m * DMODEL, gn, xn + (size_t)m * DMODEL, sq + m, lane); }
    }
    grid.sync();
    {
        pg8::Gemm g{XN, WGU1, M, 2 * FFN, DMODEL}; pg8::StaticOrder S; S.init(M, 2 * FFN, G, bx);
        pg8::EpiSwiGLU E{HB, FFN, (const float*)WSP(WS_SSQ0)};
        pg8::gemm_phase<pg8::EpiSwiGLU, pg8::StaticOrder, PG8_ALIGN, PG8_SP2>(ldsp, g, S, E);
    }
    xcd_barrier(bar);
    {
        pg8::Gemm g{HB, WD1, M, DMODEL, FFN}; pg8::StaticOrderW<4> S; S.init(M, DMODEL, G, bx);
        pg8::EpiRes<1> E{XN, XN, DMODEL, 0.5f, (float*)WSP(WS_SSQ1)};
        pg8::gemm_phase<pg8::EpiRes<1>, pg8::StaticOrderW<4>, PG8_ALIGN, PG8_SP2>(ldsp, g, S, E);
    }
    xcd_barrier(bar);
    {
        pg8::Gemm g{XN, WIN, M, INC, DMODEL}; pg8::StaticOrder S; S.init(M, INC, G, bx);
        pg8::EpiProj E{PROJ, INC, 3072, 4096, attn_body::C2, (const float*)WSP(WS_SSQ1)};
        pg8::gemm_phase<pg8::EpiProj, pg8::StaticOrder, PG8_ALIGN, PG8_SP2>(ldsp, g, S, E);
    }
    xcd_barrier(bar);
    {
        const attn_body::AttnTensors AT{(const attn_body::bf16*)PROJ, (attn_body::bf16*)OB};
        static_assert(attn_body::LDS3_BYTES <= MISC_OFF, "attention LDS");
        const attn_body::StaticOrder2 S(G, bx);
        attn_body::attn_phase3<attn_body::StaticOrder2>((char*)lds, AT, S);
    }
    xcd_barrier(bar);
    for (int rep = 0; rep < REP_LIGHT; ++rep) {
        const int lane = FRESH_LANE();
        const float s1 = wave_sum(IN(8)[lane] * IN(9)[lane]), s2 = wave_sum(IN(10)[lane] * IN(11)[lane]);
        const float lam = expf(s1) - expf(s2) + 0.2f;
        const bf16* pj = PROJ; const bf16* ob = OB; bf16* yb = YB; const float* cw = IN(7); const float* sl = IN(12);
        for (int blk = gw; blk < M / 16; blk += NGW) mix_block16(pj, ob, yb, cw, sl, lam, blk, lane);
    }
    xcd_barrier(bar);
    {
        pg8::Gemm g{YB, WOUT, M, DMODEL, DMODEL}; pg8::StaticOrderW<4> S; S.init(M, DMODEL, G, bx);
        pg8::EpiRes<1> E{XN, OB, DMODEL, 1.0f, (float*)WSP(WS_SSQ2)};
        pg8::gemm_phase<pg8::EpiRes<1>, pg8::StaticOrderW<4>, PG8_ALIGN, PG8_SP2>(ldsp, g, S, E);
    }
    xcd_barrier(bar);
    {
        pg8::Gemm g{OB, WGU2, M, 2 * FFN, DMODEL}; pg8::StaticOrder S; S.init(M, 2 * FFN, G, bx);
        pg8::EpiSwiGLU E{HB, FFN, (const float*)WSP(WS_SSQ2)};
        pg8::gemm_phase<pg8::EpiSwiGLU, pg8::StaticOrder, PG8_ALIGN, PG8_SP2>(ldsp, g, S, E);
    }
    xcd_barrier(bar);
    {
        pg8::Gemm g{HB, WD2, M, DMODEL, FFN}; pg8::StaticOrderW<4> S; S.init(M, DMODEL, G, bx);
        float* outp = KARG(out); pg8::EpiRes<3> E{OB, outp, DMODEL, 0.5f, (float*)WSP(WS_SSQ3), (unsigned*)WSP(WS_CNT), IN(18)};
        pg8::gemm_phase<pg8::EpiRes<3>, pg8::StaticOrderW<4>, PG8_ALIGN, PG8_SP2>(ldsp, g, S, E);
    }
}

#undef KARG
#undef FRESH_LANE
#undef IN
#undef WSP
#undef WGU1
#undef WD1
#undef WIN
#undef WOUT
#undef WGU2
#undef WD2
#undef XN
#undef OB
#undef HB
#undef PROJ
#undef YB
extern "C" void kernel_launch(void* const* d_in, const int* in_sizes, int n_in, void* d_out, int out_size, void* d_ws, size_t ws_size, hipStream_t stream) {
    static int grid = 0;
    if (grid == 0) {
        if (n_in != 19 || in_sizes[0] != M * DMODEL || out_size != M * DMODEL || ws_size < WS_END) { fprintf(stderr, "kernel_launch: unexpected shapes (n_in %d, in0 %d, out %d, ws %zu); nothing launched\n", n_in, n_in > 0 ? in_sizes[0] : -1, out_size, ws_size); grid = -1; return; }
        int dev = 0, cus = 0, per_cu = 0;
        if (hipGetDevice(&dev) != hipSuccess || hipDeviceGetAttribute(&cus, hipDeviceAttributeMultiprocessorCount, dev) != hipSuccess) { grid = -1; return; }
        if (hipFuncSetAttribute((const void*)mega_fwd, hipFuncAttributeMaxDynamicSharedMemorySize, LDS_BYTES) != hipSuccess) { fprintf(stderr, "kernel_launch: hipFuncSetAttribute failed\n"); grid = -1; return; }
        if (hipOccupancyMaxActiveBlocksPerMultiprocessor(&per_cu, (const void*)mega_fwd, NWAVES * 64, LDS_BYTES) != hipSuccess) per_cu = 0;
        (void)hipGetLastError();
        if (cus * per_cu < 256) { fprintf(stderr, "kernel_launch: resident capacity %d x %d < 256 workgroups; nothing launched\n", cus, per_cu); grid = -1; return; }
        grid = 256;
    }
    if (grid < 0) return;
    if (hipMemsetAsync((char*)d_ws + WS_CTL, 0, CTL_ZERO_BYTES, stream) != hipSuccess) { fprintf(stderr, "kernel_launch: hipMemsetAsync failed\n"); return; }
    Args a{};
    for (int i = 0; i < 19; ++i) a.in[i] = (const float*)d_in[i];
    a.out = (float*)d_out; a.ws = (unsigned char*)d_ws;
    void* kargs[] = {&a};
    const hipError_t le = hipLaunchCooperativeKernel((const void*)mega_fwd, dim3(grid), dim3(NWAVES * 64), kargs, LDS_BYTES, stream);
    if (le != hipSuccess) fprintf(stderr, "kernel_launch: cooperative launch failed: %s\n", hipGetErrorName(le));
}
```
